# Optimizing an MI355X kernel written in HIP

```python
import jax, jax.numpy as jnp
from jax import lax
import numpy as np

D_MODEL = 1024
BATCH = 32
SEQ = 2048
DEPTH = 2
DEC_BATCH = 32
DEC_SEQ = 64
PAST_LEN = 4096

CHUNK = 64
PE_DIM = 256
HEAD_DIM = 64
ATTN_WIDTH = D_MODEL // 2
N_HEADS = ATTN_WIDTH // HEAD_DIM
N_KV_HEADS = max(1, N_HEADS // 4)
GQA_GROUP = N_HEADS // N_KV_HEADS
POOL_WIDTH = D_MODEL - ATTN_WIDTH
POOL_WINDOWS = (2, 4, 8, 16)
N_POOL_GROUPS = len(POOL_WINDOWS)
POOL_GROUP = POOL_WIDTH // N_POOL_GROUPS
POOL_HIST = max(POOL_WINDOWS) - 1
MIX_WIDTH = ATTN_WIDTH + POOL_WIDTH
WINDOW = 128
WIN_CHUNKS = WINDOW // CHUNK
ROPE_DIM = HEAD_DIM // 4
ROPE_THETA = 500000.0
D_FF = ((8 * D_MODEL // 3 + 255) // 256) * 256
EPS = 1e-6
NEG = -1e30
Q_COLS = N_HEADS * HEAD_DIM
KV_COLS = N_KV_HEADS * HEAD_DIM
IN_COLS = Q_COLS + 2 * KV_COLS + POOL_WIDTH

kernel_name = "hymba_macaron_swa_sink_pool_stream_step"


def rmsnorm(x, g):
    xf = x.astype(jnp.float32)
    y = xf * lax.rsqrt(jnp.mean(xf * xf, axis=-1, keepdims=True) + EPS)
    return (y * g.astype(jnp.float32)).astype(x.dtype)


def swiglu(h, w_in, w_out):
    gate, up = jnp.split(h @ w_in, 2, axis=-1)
    return (jax.nn.silu(gate) * up) @ w_out


def rope_partial(x, pos):
    half = ROPE_DIM // 2
    inv = jnp.power(jnp.float32(ROPE_THETA), -jnp.arange(half, dtype=jnp.float32) / half)
    ang = pos.astype(jnp.float32)[:, None] * inv[None, :]
    cos = jnp.cos(ang)[:, None, :]
    sin = jnp.sin(ang)[:, None, :]
    xf = x.astype(jnp.float32)
    x1, x2, rest = xf[..., :half], xf[..., half:ROPE_DIM], xf[..., ROPE_DIM:]
    out = jnp.concatenate([x1 * cos - x2 * sin, x2 * cos + x1 * sin, rest], axis=-1)
    return out.astype(x.dtype)


def mixer_inputs(h, w_in, q_norm, k_norm, pos):
    B, T, _ = h.shape
    z = h @ w_in
    q, k, v, u = jnp.split(z, [Q_COLS, Q_COLS + KV_COLS, Q_COLS + 2 * KV_COLS], axis=-1)
    q = rope_partial(rmsnorm(q.reshape(B, T, N_HEADS, HEAD_DIM), q_norm), pos)
    k = rope_partial(rmsnorm(k.reshape(B, T, N_KV_HEADS, HEAD_DIM), k_norm), pos)
    v = v.reshape(B, T, N_KV_HEADS, HEAD_DIM)
    return q, k, v, u


def attend(q, k, v, valid, sinks):
    B, N, Lq = q.shape[:3]
    qg = q.reshape(B, N, Lq, N_KV_HEADS, GQA_GROUP, HEAD_DIM)
    s = jnp.einsum('bnqhgd,bnshd->bnhgqs', qg, k).astype(jnp.float32) * (HEAD_DIM ** -0.5)
    s = jnp.where(valid[None, :, None, None, None, :], s, NEG)
    sink = jnp.broadcast_to(sinks.astype(jnp.float32).reshape(1, 1, N_KV_HEADS, GQA_GROUP, 1, 1),
                            s.shape[:-1] + (1,))
    pr = jax.nn.softmax(jnp.concatenate([s, sink], axis=-1), axis=-1)[..., :-1]
    o = jnp.einsum('bnhgqs,bnshd->bnqhgd', pr.astype(v.dtype), v)
    return o.reshape(B, N, Lq, ATTN_WIDTH)


def window_attn_prompt(q, k, v, sinks):
    B, T = q.shape[:2]
    NC = T // CHUNK
    pad = WIN_CHUNKS * CHUNK

    def band(x):
        xp = jnp.pad(x, ((0, 0), (pad, 0), (0, 0), (0, 0)))
        xc = xp.reshape(B, NC + WIN_CHUNKS, CHUNK, N_KV_HEADS, HEAD_DIM)
        return jnp.concatenate([xc[:, j:j + NC] for j in range(WIN_CHUNKS + 1)], axis=2)

    kb, vb = band(k), band(v)
    key_pos = (jnp.arange(NC)[:, None] * CHUNK - pad
               + jnp.arange((WIN_CHUNKS + 1) * CHUNK)[None, :])
    o = attend(q.reshape(B, NC, CHUNK, N_HEADS, HEAD_DIM), kb, vb, key_pos >= 0, sinks)
    return o.reshape(B, T, ATTN_WIDTH)


def window_attn_cached(q, k_all, v_all, sinks):
    B, T = q.shape[:2]
    Lk = k_all.shape[1]
    o = attend(q[:, None], k_all[:, None], v_all[:, None], jnp.ones((1, Lk), dtype=bool), sinks)
    return o.reshape(B, T, ATTN_WIDTH)


def pool_mix(u_ext, pos, w_pool, pool_scale):
    B = u_ext.shape[0]
    T = pos.shape[0]
    uf = u_ext.astype(jnp.float32)
    cs = jnp.concatenate([jnp.zeros_like(uf[:, :1]), lax.cumsum(uf, axis=1)], axis=1)
    end = cs[:, POOL_HIST + 1:]
    means = []
    for gi, w in enumerate(POOL_WINDOWS):
        sl = slice(gi * POOL_GROUP, (gi + 1) * POOL_GROUP)
        start = cs[:, POOL_HIST + 1 - w:POOL_HIST + 1 - w + T, sl]
        cnt = jnp.minimum(pos + 1, w).astype(jnp.float32)[:, None]
        means.append((end[..., sl] - start) / cnt)
    d = (jnp.concatenate(means, axis=-1) - uf[:, POOL_HIST:]).astype(u_ext.dtype)
    d = d.reshape(B, T, N_POOL_GROUPS, POOL_GROUP)
    y = jnp.einsum('btgc,gcd->btgd', d, w_pool).reshape(B, T, POOL_WIDTH)
    return y * pool_scale


def run_layer(x, pe, pos, k_hist, v_hist, u_hist, wts, i):
    x = x + 0.5 * swiglu(rmsnorm(x, wts['norm_ffa'][i]), wts['w_ffa_in'][i], wts['w_ffa_out'][i])
    h = rmsnorm(x, wts['norm_mix'][i])
    q, k, v, u = mixer_inputs(h, wts['w_in'][i], wts['q_norm'][i], wts['k_norm'][i], pos)
    if k_hist is None:
        a = window_attn_prompt(q, k, v, wts['sinks'][i])
        k_all, v_all = k, v
        u_ext = jnp.pad(u, ((0, 0), (POOL_HIST, 0), (0, 0)))
    else:
        k_all = jnp.concatenate([k_hist, k], axis=1)
        v_all = jnp.concatenate([v_hist, v], axis=1)
        a = window_attn_cached(q, k_all, v_all, wts['sinks'][i])
        u_ext = jnp.concatenate([u_hist, u], axis=1)
    m = pool_mix(u_ext, pos, wts['w_pool'][i], wts['pool_scale'][i])
    x = x + jnp.concatenate([a, m], axis=-1) @ wts['w_out'][i]
    x = x + 0.5 * swiglu(rmsnorm(x, wts['norm_ffb'][i]), wts['w_ffb_in'][i], wts['w_ffb_out'][i])
    gate = jax.nn.sigmoid(rmsnorm(x, wts['norm_pe'][i]) @ wts['w_pe_gate'][i])
    x = x + gate * (pe @ wts['w_pe_up'][i])
    return x, k_all[:, -WINDOW:], v_all[:, -WINDOW:], u_ext[:, -POOL_HIST:]


def setup_inputs(seed: int = 0) -> dict:
    key = jax.random.key(seed)
    ks = iter(jax.random.split(key, 32))

    def nrm(shape, scale):
        return jax.random.normal(next(ks), shape, jnp.float32) * scale

    win_rows = min(WINDOW, PAST_LEN)
    return {
        "x_prompt": nrm((BATCH, SEQ, D_MODEL), 1.0),
        "x_sample": nrm((DEC_BATCH, DEC_SEQ, D_MODEL), 1.0),
        "p_prompt": nrm((DEPTH, BATCH, SEQ, PE_DIM), 1.0),
        "p_sample": nrm((DEPTH, DEC_BATCH, DEC_SEQ, PE_DIM), 1.0),
        "cache_k": nrm((DEPTH, DEC_BATCH, win_rows, N_KV_HEADS, HEAD_DIM), 1.0),
        "cache_v": nrm((DEPTH, DEC_BATCH, win_rows, N_KV_HEADS, HEAD_DIM), 1.0),
        "state_pool": nrm((DEPTH, DEC_BATCH, POOL_HIST, POOL_WIDTH), 1.0),
        "norm_ffa": 1.0 + nrm((DEPTH, D_MODEL), 0.05),
        "w_ffa_in": nrm((DEPTH, D_MODEL, 2 * D_FF), D_MODEL ** -0.5),
        "w_ffa_out": nrm((DEPTH, D_FF, D_MODEL), D_FF ** -0.5),
        "norm_mix": 1.0 + nrm((DEPTH, D_MODEL), 0.05),
        "w_in": nrm((DEPTH, D_MODEL, IN_COLS), D_MODEL ** -0.5),
        "q_norm": 1.0 + nrm((DEPTH, HEAD_DIM), 0.05),
        "k_norm": 1.0 + nrm((DEPTH, HEAD_DIM), 0.05),
        "sinks": nrm((DEPTH, N_HEADS), 1.0),
        "w_pool": nrm((DEPTH, N_POOL_GROUPS, POOL_GROUP, POOL_GROUP), POOL_GROUP ** -0.5),
        "pool_scale": 1.0 + nrm((DEPTH, POOL_WIDTH), 0.05),
        "w_out": nrm((DEPTH, MIX_WIDTH, D_MODEL), MIX_WIDTH ** -0.5),
        "norm_ffb": 1.0 + nrm((DEPTH, D_MODEL), 0.05),
        "w_ffb_in": nrm((DEPTH, D_MODEL, 2 * D_FF), D_MODEL ** -0.5),
        "w_ffb_out": nrm((DEPTH, D_FF, D_MODEL), D_FF ** -0.5),
        "norm_pe": 1.0 + nrm((DEPTH, D_MODEL), 0.05),
        "w_pe_gate": nrm((DEPTH, D_MODEL, D_MODEL), D_MODEL ** -0.5),
        "w_pe_up": nrm((DEPTH, PE_DIM, D_MODEL), PE_DIM ** -0.5),
    }


def reference(x_prompt, x_sample, p_prompt, p_sample, cache_k, cache_v, state_pool,
              norm_ffa, w_ffa_in, w_ffa_out, norm_mix, w_in, q_norm, k_norm, sinks,
              w_pool, pool_scale, w_out, norm_ffb, w_ffb_in, w_ffb_out,
              norm_pe, w_pe_gate, w_pe_up):
    wts = dict(norm_ffa=norm_ffa, w_ffa_in=w_ffa_in, w_ffa_out=w_ffa_out,
               norm_mix=norm_mix, w_in=w_in, q_norm=q_norm, k_norm=k_norm, sinks=sinks,
               w_pool=w_pool, pool_scale=pool_scale, w_out=w_out,
               norm_ffb=norm_ffb, w_ffb_in=w_ffb_in, w_ffb_out=w_ffb_out,
               norm_pe=norm_pe, w_pe_gate=w_pe_gate, w_pe_up=w_pe_up)
    pos_p = jnp.arange(x_prompt.shape[1], dtype=jnp.int32)
    pos_s = PAST_LEN + jnp.arange(x_sample.shape[1], dtype=jnp.int32)
    xp, xs = x_prompt, x_sample
    kp, vp, up, ksm, vsm, usm = [], [], [], [], [], []
    for i in range(DEPTH):
        xp, k1, v1, u1 = run_layer(xp, p_prompt[i], pos_p, None, None, None, wts, i)
        xs, k2, v2, u2 = run_layer(xs, p_sample[i], pos_s, cache_k[i], cache_v[i], state_pool[i], wts, i)
        kp.append(k1); vp.append(v1); up.append(u1)
        ksm.append(k2); vsm.append(v2); usm.append(u2)
    return (xp, xs, jnp.stack(kp), jnp.stack(vp), jnp.stack(up),
            jnp.stack(ksm), jnp.stack(vsm), jnp.stack(usm))
```

```cpp
#include <hip/hip_runtime.h>
#include <hip/hip_cooperative_groups.h>
#include <cstdio>
#include <cstdint>
namespace cg = cooperative_groups;
namespace pg8 {
#define PG8_LAS __attribute__((address_space(3)))
typedef unsigned short bf16_t;
typedef short bf16x8 __attribute__((ext_vector_type(8)));
typedef float f32x4 __attribute__((ext_vector_type(4)));
typedef unsigned u32x4 __attribute__((ext_vector_type(4)));
constexpr int BM = 256, BK = 64, HALF = 128, HTB = HALF * BK * 2  , STAGE_BYTES = 8 * HTB, NXCD = 8, WGM = 8;

__host__ __device__ __forceinline__ int lds_byte(int r, int c) { const int st = (r >> 4) * 2 + (c >> 5), rr = r & 15, cc = c & 31, ob = rr * 64 + cc * 2; return st * 1024 + (ob ^ (((ob >> 9) & 1) << 5)); }
__host__ __device__ __forceinline__ void stage_rc(int b, int& R, int& C) { const int st = b / 1024, sb = b % 1024, swz = sb ^ (((sb >> 9) & 1) << 5); R = (st >> 1) * 16 + swz / 64; C = (st & 1) * 32 + (swz % 64) / 2; }
__host__ __device__ __forceinline__ int perm32(int rho) { const int n = rho >> 4, i = rho & 15; return 8 * (i >> 2) + 4 * n + (i & 3); }

struct Unit { int pm, pn; };
struct Gemm { const bf16_t* A; const bf16_t* Bt; int M, N, K; };

struct StaticOrder {
    int nM, nN, nwg, G, c;
    __host__ __device__ void init(int M, int N, int G_, int c_) { nM = M / BM; nN = N / BM; nwg = nM * nN; G = G_; c = c_; }
    __host__ __device__ bool next(int i, Unit& u) const {
        const long L = (long)i * G + c; if (L >= nwg) return false;
        int wgid = (int)L; { const int q = nwg / NXCD, r = nwg % NXCD, xcd = wgid % NXCD, off = wgid / NXCD; wgid = (xcd < r ? xcd * (q + 1) : r * (q + 1) + (xcd - r) * q) + off; }
        const int nig = WGM * nN, gid = wgid / nig, fm = gid * WGM, gsz = (nM - fm) < WGM ? (nM - fm) : WGM;
        u.pm = fm + ((wgid % nig) % gsz); u.pn = (wgid % nig) / gsz; return true;
    }
    __device__ __forceinline__ void a_ready(const Unit&) const {}
    __device__ __forceinline__ void done(const Unit&) const {}
};
__device__ __forceinline__ unsigned cvt_pk_bf16(float lo, float hi) { unsigned r; asm volatile("v_cvt_pk_bf16_f32 %0, %1, %2" : "=v"(r) : "v"(lo), "v"(hi)); return r; }
typedef float f32x2 __attribute__((ext_vector_type(2)));
template <class Epi, class Sched, bool ALIGN_EPI = false, bool SP2 = false>
__device__ __forceinline__ void gemm_phase(PG8_LAS unsigned char* lds, const Gemm g, const Sched& S, const Epi& E) {
    int tid_ = threadIdx.x; asm volatile("" : "+v"(tid_));
    const int tid = tid_, wid = __builtin_amdgcn_readfirstlane(tid >> 6), lane = tid & 63, wr = wid >> 2, wc = wid & 3, fr = lane & 15, fq = lane >> 4;
    const int K = g.K, nt = K / BK;
    unsigned voffA[2], voffB[2];
#pragma unroll
    for (int i = 0; i < 2; ++i) { int R, C; stage_rc(tid * 16 + i * 8192, R, C); const int Rb = Epi::PERM ? ((R & ~31) + perm32(R & 31)) : R;
        voffA[i] = (unsigned)(R * K + C) * 2u; voffB[i] = (unsigned)(Rb * K + C) * 2u; }
    const size_t kstep = (size_t)(BK * 2);
    const size_t hstep = (size_t)HALF * K * 2;
    const size_t tstep = 2 * hstep;
    const unsigned ldsw = (unsigned)wid * 1024u;
    const int aoff = lds_byte(wr * 64 + fr, fq * 8), boff = lds_byte(wc * 32 + fr, fq * 8);
#define PG8_SA(b, h) (((b) * 2 + (h)) * HTB)
#define PG8_SB(b, h) ((4 + (b) * 2 + (h)) * HTB)
#define PG8_STAGE(bufoff, gbase, voff) do { _Pragma("unroll") for (int _i = 0; _i < 2; ++_i) \
        __builtin_amdgcn_global_load_lds((const unsigned*)((const char*)(gbase) + (voff)[_i]), (PG8_LAS unsigned*)(lds + (bufoff) + ldsw + _i * 8192), 16, 0, 0); } while (0)
#define PG8_LDA(dst, b, h) do { _Pragma("unroll") for (int m = 0; m < 4; ++m) _Pragma("unroll") for (int k = 0; k < 2; ++k) dst[m][k] = *(const PG8_LAS bf16x8*)(lds + PG8_SA(b, h) + aoff + m * 2048 + k * 1024); } while (0)
#define PG8_LDB(dst, b, h) do { _Pragma("unroll") for (int n = 0; n < 2; ++n) _Pragma("unroll") for (int k = 0; k < 2; ++k) dst[n][k] = *(const PG8_LAS bf16x8*)(lds + PG8_SB(b, h) + boff + n * 2048 + k * 1024); } while (0)
#define PG8_MMA(ai, bj, At, Bt) do { __builtin_amdgcn_s_setprio(1); _Pragma("unroll") for (int m = 0; m < 4; ++m) _Pragma("unroll") for (int n = 0; n < 2; ++n) _Pragma("unroll") for (int k = 0; k < 2; ++k) \
        acc[ai][bj][m][n] = __builtin_amdgcn_mfma_f32_16x16x32_bf16(Bt[n][k], At[m][k], acc[ai][bj][m][n], 0, 0, 0); __builtin_amdgcn_s_setprio(0); } while (0)
#define PG8_WAIT_V(n) asm volatile("s_waitcnt vmcnt(" #n ")" ::: "memory")
#define PG8_WAIT_L(n) asm volatile("s_waitcnt lgkmcnt(" #n ")" ::: "memory")
#define PG8_BAR __builtin_amdgcn_s_barrier()
#define PG8_SCHED __builtin_amdgcn_sched_barrier(0)
    Unit cur, nxt; int ui = 0;
    if (!S.next(0, cur)) return;
    f32x4 acc[2][2][4][2];
#pragma unroll
    for (int a = 0; a < 2; ++a)
#pragma unroll
        for (int b = 0; b < 2; ++b)
#pragma unroll
            for (int m = 0; m < 4; ++m)
#pragma unroll
                for (int n = 0; n < 2; ++n) acc[a][b][m][n] = (f32x4){0.f, 0.f, 0.f, 0.f};
    bf16x8 At[4][2], B0[2][2], B1[2][2];
    const char* cA = (const char*)g.A + (size_t)cur.pm * tstep; const char* cB = (const char*)g.Bt + (size_t)cur.pn * tstep;
    S.a_ready(cur);
    if constexpr (SP2) {
        PG8_STAGE(PG8_SB(0, 0), cB, voffB); PG8_STAGE(PG8_SB(0, 1), cB + hstep, voffB); PG8_STAGE(PG8_SA(0, 0), cA, voffA); PG8_STAGE(PG8_SA(0, 1), cA + hstep, voffA);
        if (wr == 1) PG8_BAR;
        PG8_WAIT_V(2); PG8_BAR;
        PG8_STAGE(PG8_SB(1, 0), cB + kstep, voffB); PG8_STAGE(PG8_SA(1, 0), cA + kstep, voffA); PG8_STAGE(PG8_SB(1, 1), cB + hstep + kstep, voffB);
        PG8_WAIT_V(6); PG8_BAR;
    } else {
        PG8_STAGE(PG8_SB(0, 0), cB, voffB); PG8_STAGE(PG8_SA(0, 0), cA, voffA); PG8_STAGE(PG8_SB(0, 1), cB + hstep, voffB); PG8_STAGE(PG8_SA(0, 1), cA + hstep, voffA);
        if (wr == 1) PG8_BAR;
        PG8_WAIT_V(4); PG8_BAR;
        PG8_STAGE(PG8_SB(1, 0), cB + kstep, voffB); PG8_STAGE(PG8_SA(1, 0), cA + kstep, voffA); PG8_STAGE(PG8_SB(1, 1), cB + hstep + kstep, voffB);
        PG8_WAIT_V(6); PG8_BAR;
    }
    for (;;) {
        const bool has_next = S.next(ui + 1, nxt);
        const char* nA = has_next ? (const char*)g.A + (size_t)nxt.pm * tstep : cA; const char* nB = has_next ? (const char*)g.Bt + (size_t)nxt.pn * tstep : cB;
        for (int t = 0; t < nt; t += 2) {
            const bool last = (t == nt - 2);
            const char* a1 = cA + (size_t)(t + 1) * kstep;
            const char* a2 = last ? nA : cA + (size_t)(t + 2) * kstep; const char* b2 = last ? nB : cB + (size_t)(t + 2) * kstep;
            const char* a3 = a2 + kstep; const char* b3 = b2 + kstep;
            if (last && has_next) S.a_ready(nxt);
            if constexpr (SP2) {
            PG8_LDB(B0, 0, 0); PG8_LDB(B1, 0, 1); PG8_SCHED; PG8_LDA(At, 0, 0); PG8_STAGE(PG8_SA(1, 1), a1 + hstep, voffA);
            PG8_WAIT_V(8); PG8_WAIT_L(0); PG8_BAR; PG8_MMA(0, 0, At, B0); PG8_MMA(0, 1, At, B1); PG8_BAR; PG8_SCHED;
            PG8_LDA(At, 0, 1); PG8_STAGE(PG8_SB(0, 0), b2, voffB); PG8_STAGE(PG8_SB(0, 1), b2 + hstep, voffB); PG8_STAGE(PG8_SA(0, 0), a2, voffA);
            PG8_WAIT_V(8); PG8_WAIT_L(0); PG8_BAR; PG8_MMA(1, 0, At, B0); PG8_MMA(1, 1, At, B1); PG8_BAR; PG8_SCHED;
            PG8_LDB(B0, 1, 0); PG8_LDB(B1, 1, 1); PG8_SCHED; PG8_LDA(At, 1, 0); PG8_STAGE(PG8_SA(0, 1), a2 + hstep, voffA);
            PG8_WAIT_V(8); PG8_WAIT_L(0); PG8_BAR; PG8_MMA(0, 0, At, B0); PG8_MMA(0, 1, At, B1); PG8_BAR; PG8_SCHED;
            PG8_LDA(At, 1, 1); PG8_STAGE(PG8_SB(1, 0), b3, voffB); PG8_STAGE(PG8_SB(1, 1), b3 + hstep, voffB); PG8_STAGE(PG8_SA(1, 0), a3, voffA);
            PG8_WAIT_V(8); PG8_WAIT_L(0); PG8_BAR; PG8_MMA(1, 0, At, B0); PG8_MMA(1, 1, At, B1); PG8_BAR; PG8_SCHED;
            } else {
            PG8_LDB(B0, 0, 0); PG8_SCHED; PG8_LDA(At, 0, 0); PG8_STAGE(PG8_SA(1, 1), a1 + hstep, voffA);
            PG8_WAIT_L(8); PG8_BAR; PG8_WAIT_L(0); PG8_MMA(0, 0, At, B0); PG8_BAR; PG8_SCHED;
            PG8_LDB(B1, 0, 1); PG8_STAGE(PG8_SB(0, 0), b2, voffB);
            PG8_BAR; PG8_WAIT_L(0); PG8_MMA(0, 1, At, B1); PG8_BAR;
            PG8_LDA(At, 0, 1); PG8_STAGE(PG8_SA(0, 0), a2, voffA);
            PG8_BAR; PG8_WAIT_L(0); PG8_MMA(1, 0, At, B0); PG8_BAR; PG8_SCHED;
            PG8_STAGE(PG8_SB(0, 1), b2 + hstep, voffB);
            PG8_WAIT_V(6); PG8_BAR; PG8_MMA(1, 1, At, B1); PG8_BAR;
            PG8_LDB(B0, 1, 0); PG8_SCHED; PG8_LDA(At, 1, 0); PG8_STAGE(PG8_SA(0, 1), a2 + hstep, voffA);
            PG8_WAIT_L(8); PG8_BAR; PG8_WAIT_L(0); PG8_MMA(0, 0, At, B0); PG8_BAR; PG8_SCHED;
            PG8_LDB(B1, 1, 1); PG8_STAGE(PG8_SB(1, 0), b3, voffB);
            PG8_BAR; PG8_WAIT_L(0); PG8_MMA(0, 1, At, B1); PG8_BAR;
            PG8_LDA(At, 1, 1); PG8_STAGE(PG8_SA(1, 0), a3, voffA);
            PG8_BAR; PG8_WAIT_L(0); PG8_MMA(1, 0, At, B0); PG8_BAR; PG8_SCHED;
            PG8_STAGE(PG8_SB(1, 1), b3 + hstep, voffB);
            PG8_WAIT_V(6); PG8_BAR; PG8_MMA(1, 1, At, B1); PG8_BAR;
            }
        }
        if constexpr (ALIGN_EPI) { if (wr == 0) PG8_BAR; }
        if constexpr (!Epi::AFTER_DRAIN) { E(acc, cur, wr, wc, fr, fq); S.done(cur); }
        if (!has_next) break;
#pragma unroll
        for (int a = 0; a < 2; ++a)
#pragma unroll
            for (int b = 0; b < 2; ++b)
#pragma unroll
                for (int m = 0; m < 4; ++m)
#pragma unroll
                    for (int n = 0; n < 2; ++n) acc[a][b][m][n] = (f32x4){0.f, 0.f, 0.f, 0.f};
        cur = nxt; cA = nA; cB = nB; ++ui;
        if constexpr (ALIGN_EPI) { if (wr == 1) PG8_BAR; }
    }
    PG8_WAIT_V(0);
    if constexpr (!ALIGN_EPI) { if (wr == 0) PG8_BAR; }
    PG8_BAR;
    if constexpr (Epi::AFTER_DRAIN) { E.fused(acc, cur, wr, wc, fr, fq, lds, wid, lane); S.done(cur); }
#undef PG8_SA
#undef PG8_SB
#undef PG8_STAGE
#undef PG8_LDA
#undef PG8_LDB
#undef PG8_MMA
#undef PG8_WAIT_V
#undef PG8_WAIT_L
#undef PG8_BAR
#undef PG8_SCHED
}
}

#define LAS __attribute__((address_space(3)))
using pg8::f32x4; using pg8::u32x4; using pg8::bf16_t; using pg8::bf16x8; using pg8::Unit;
typedef float f32x2 __attribute__((ext_vector_type(2)));
typedef __bf16 bf16x2_t __attribute__((ext_vector_type(2)));
typedef unsigned u32x2 __attribute__((ext_vector_type(2)));
constexpr int DM = 1024, DFF = 2816, NFF2 = 5632, NIN = 1280, PED = 256;
constexpr int MP = 65536, MS = 2048, MT = MP + MS;
constexpr int NB = 32, SEQ = 2048, DSEQ = 64, NLAYER = 2;
constexpr float EPS = 1e-6f, LOG2E = 1.4426950408889634f;
constexpr size_t MiB = 1u << 20;
constexpr size_t WL_FFA_IN = 0, WL_FFA_OUT = 11 * MiB, WL_IN = WL_FFA_OUT + 5 * MiB + MiB / 2, WL_OUT = WL_IN + 2 * MiB + MiB / 2, WL_FFB_IN = WL_OUT + 2 * MiB,
                 WL_FFB_OUT = WL_FFB_IN + 11 * MiB, WL_PEG = WL_FFB_OUT + 5 * MiB + MiB / 2, WL_PEU = WL_PEG + 2 * MiB, WL_POOL = WL_PEU + MiB / 2, WL_STRIDE = 41 * MiB;
static_assert(WL_POOL + 131072 <= WL_STRIDE, "weights map");
constexpr size_t WS_W = 0, WS_XB = 82 * MiB, WS_ACT = 214 * MiB, WS_Z = WS_ACT, WS_MIX = WS_ACT + 165 * MiB, WS_U = WS_ACT, WS_PB = 577 * MiB, WS_SSQ = 643 * MiB, WS_ROPE = 646 * MiB, WS_XB2 = 647 * MiB, WS_END = 779 * MiB;
static_assert((size_t)MT * DM * 2 == 132 * MiB && (size_t)MT * DFF * 2 == 363 * MiB && (size_t)MT * NIN * 2 == 165 * MiB && (size_t)2 * MT * PED * 2 == 66 * MiB, "buffer sizes");
constexpr size_t O_Y = 0, O_KP = (size_t)MT * DM, O_VP = O_KP + 1048576, O_UP = O_VP + 1048576, O_KS = O_UP + 491520, O_VS = O_KS + 1048576, O_US = O_VS + 1048576, O_END = O_US + 491520;

struct Params {
    const float* in[24]; float* out; unsigned char* ws;
};
enum { I_XP = 0, I_XS, I_PP, I_PS, I_CK, I_CV, I_SP, I_NFFA, I_WFFA_IN, I_WFFA_OUT, I_NMIX, I_WIN, I_QN, I_KN, I_SINK, I_WPOOL, I_PSCALE, I_WOUT, I_NFFB, I_WFFB_IN, I_WFFB_OUT, I_NPE, I_WPEG, I_WPEU };

__device__ __forceinline__ unsigned pk2(float lo, float hi) { f32x2 v = {lo, hi}; bf16x2_t b = __builtin_convertvector(v, bf16x2_t); return __builtin_bit_cast(unsigned, b); }
__device__ __forceinline__ float bflo(unsigned w) { return __uint_as_float(w << 16); }
__device__ __forceinline__ float bfhi(unsigned w) { return __uint_as_float(w & 0xffff0000u); }
__device__ __forceinline__ float rstd_of(const float* ssq, int row) { return __builtin_amdgcn_rsqf(ssq[row] * (1.0f / 1024.0f) + EPS); }
__device__ __forceinline__ float silu_f(float g) { return g * __builtin_amdgcn_rcpf(1.0f + __builtin_amdgcn_exp2f(-LOG2E * g)); }
__device__ __forceinline__ float sigm_f(float g) { return __builtin_amdgcn_rcpf(1.0f + __builtin_amdgcn_exp2f(-LOG2E * g)); }
__device__ __forceinline__ float wave_sum(float v) {
#pragma unroll
    for (int o = 1; o < 64; o <<= 1) v += __shfl_xor(v, o);
    return v;
}

struct EpiSwiglu {
    static constexpr bool PERM = true, AFTER_DRAIN = false;
    bf16_t* act; const float* ssq;
    __device__ __forceinline__ void operator()(const f32x4 (&acc)[2][2][4][2], const Unit& u, int wr, int wc, int fr, int fq) const {
        const int row0 = u.pm * 256 + wr * 64 + fr, col0 = u.pn * 128 + wc * 32 + 8 * fq;
#pragma unroll
        for (int ai = 0; ai < 2; ++ai)
#pragma unroll
            for (int m = 0; m < 4; ++m) {
                const int row = row0 + ai * 128 + m * 16; const float rs = rstd_of(ssq, row);
                const f32x4 g0 = acc[ai][0][m][0] * rs, g1 = acc[ai][0][m][1] * rs, u0 = acc[ai][1][m][0] * rs, u1 = acc[ai][1][m][1] * rs;
                u32x4 w;
                w.x = pk2(silu_f(g0[0]) * u0[0], silu_f(g0[1]) * u0[1]); w.y = pk2(silu_f(g0[2]) * u0[2], silu_f(g0[3]) * u0[3]);
                w.z = pk2(silu_f(g1[0]) * u1[0], silu_f(g1[1]) * u1[1]); w.w = pk2(silu_f(g1[2]) * u1[2], silu_f(g1[3]) * u1[3]);
                *(u32x4*)(act + (size_t)row * DFF + col0) = w;
            }
    }
};
struct EpiStore {
    static constexpr bool PERM = true, AFTER_DRAIN = false;
    bf16_t* O; int ldc; const float* ssq;
    __device__ __forceinline__ void operator()(const f32x4 (&acc)[2][2][4][2], const Unit& u, int wr, int wc, int fr, int fq) const {
        const int row0 = u.pm * 256 + wr * 64 + fr, col0 = u.pn * 256 + wc * 32 + 8 * fq;
#pragma unroll
        for (int ai = 0; ai < 2; ++ai)
#pragma unroll
            for (int m = 0; m < 4; ++m) {
                const int row = row0 + ai * 128 + m * 16; const float rs = ssq ? rstd_of(ssq, row) : 1.0f;
#pragma unroll
                for (int bj = 0; bj < 2; ++bj) {
                    const f32x4 v0 = acc[ai][bj][m][0] * rs, v1 = acc[ai][bj][m][1] * rs;
                    u32x4 w; w.x = pk2(v0[0], v0[1]); w.y = pk2(v0[2], v0[3]); w.z = pk2(v1[0], v1[1]); w.w = pk2(v1[2], v1[3]);
                    *(u32x4*)(O + (size_t)row * ldc + col0 + bj * 128) = w;
                }
            }
    }
};
template <int MODE> struct EpiResid {
    static constexpr bool PERM = true, AFTER_DRAIN = false;
    const float* rin_p; const float* rin_s; float* xout; bf16_t* xb; float* ssq_next; float scale; const bf16_t* U; const float* ssq_cur;
    __device__ __forceinline__ void operator()(const f32x4 (&acc)[2][2][4][2], const Unit& u, int wr, int wc, int fr, int fq) const {
        const int row0 = u.pm * 256 + wr * 64 + fr, col0 = u.pn * 256 + wc * 32 + 8 * fq;
        const float* rin = (u.pm < MP / 256) ? rin_p : rin_s;
#pragma unroll
        for (int ai = 0; ai < 2; ++ai)
#pragma unroll
            for (int m = 0; m < 4; ++m) {
                const int row = row0 + ai * 128 + m * 16; const size_t off = (size_t)row * DM + col0;
                const float rs = (MODE == 1) ? rstd_of(ssq_cur, row) : 0.f; float ss = 0.f;
#pragma unroll
                for (int bj = 0; bj < 2; ++bj) {
                    const f32x4 x0 = *(const f32x4*)(rin + off + bj * 128), x1 = *(const f32x4*)(rin + off + bj * 128 + 4);
                    f32x4 a0 = acc[ai][bj][m][0], a1 = acc[ai][bj][m][1];
                    if (MODE == 1) {
                        const u32x4 uu = *(const u32x4*)(U + off + bj * 128);
                        a0[0] = sigm_f(a0[0] * rs) * bflo(uu.x); a0[1] = sigm_f(a0[1] * rs) * bfhi(uu.x); a0[2] = sigm_f(a0[2] * rs) * bflo(uu.y); a0[3] = sigm_f(a0[3] * rs) * bfhi(uu.y);
                        a1[0] = sigm_f(a1[0] * rs) * bflo(uu.z); a1[1] = sigm_f(a1[1] * rs) * bfhi(uu.z); a1[2] = sigm_f(a1[2] * rs) * bflo(uu.w); a1[3] = sigm_f(a1[3] * rs) * bfhi(uu.w);
                    } else { a0 = a0 * scale; a1 = a1 * scale; }
                    const f32x4 v0 = x0 + a0, v1 = x1 + a1;
                    *(f32x4*)(xout + off + bj * 128) = v0; *(f32x4*)(xout + off + bj * 128 + 4) = v1;
                    u32x4 w; w.x = pk2(v0[0], v0[1]); w.y = pk2(v0[2], v0[3]); w.z = pk2(v1[0], v1[1]); w.w = pk2(v1[2], v1[3]);
                    *(u32x4*)(xb + off + bj * 128) = w;
                    ss += (v0[0] * v0[0] + v0[1] * v0[1]) + (v0[2] * v0[2] + v0[3] * v0[3]) + (v1[0] * v1[0] + v1[1] * v1[1]) + (v1[2] * v1[2] + v1[3] * v1[3]);
                }
                ss += __shfl_xor(ss, 16); ss += __shfl_xor(ss, 32);
                if (fq == 0) __hip_atomic_fetch_add(ssq_next + row, ss, __ATOMIC_RELAXED, __HIP_MEMORY_SCOPE_AGENT);
                if (m & 1) asm volatile("" ::: "memory");
            }
    }
};

__device__ __forceinline__ void transpose_item(const float* W, int K, int N, bf16_t* WT, const float* gk, int mode, LAS float* scr, int item, int lane) {
    const int nblk = N / 32, kb = item / nblk, nb = item % nblk, k0 = 64 * kb, n0 = 32 * nb;
    const int sc = (mode == 1) ? (((n0 >> 7) & 1) * DFF + (n0 >> 8) * 128 + (n0 & 127)) : n0;
#pragma unroll 8
    for (int i = 0; i < 32; ++i) { const int kk = 2 * i + (lane >> 5); const float gv = gk ? gk[k0 + kk] : 1.0f; scr[kk * 33 + (lane & 31)] = W[(size_t)(k0 + kk) * N + sc + (lane & 31)] * gv; }
    asm volatile("s_waitcnt lgkmcnt(0)" ::: "memory");
    const int c = lane & 7;
#pragma unroll
    for (int j = 0; j < 4; ++j) { const int n = (lane >> 3) + 8 * j; const LAS float* s = scr + (8 * c) * 33 + n;
        u32x4 o; o.x = pk2(s[0 * 33], s[1 * 33]); o.y = pk2(s[2 * 33], s[3 * 33]); o.z = pk2(s[4 * 33], s[5 * 33]); o.w = pk2(s[6 * 33], s[7 * 33]);
        *(u32x4*)(WT + (size_t)(n0 + n) * K + k0 + 8 * c) = o; }
    asm volatile("s_waitcnt lgkmcnt(0)" ::: "memory");
}
__device__ __forceinline__ float rope_inv(int i) {
    return i == 0 ? 1.0f : i == 1 ? 0.1939227432012558f : i == 2 ? 0.03760603070259094f : i == 3 ? 0.007292664609849453f : i == 4 ? 0.0014142135623842478f : i == 5 ? 0.00027424818836152554f : i == 6 ? 5.3182957344688475e-05f : 1.0313385246263351e-05f;
}
__device__ __forceinline__ void sincos_d(float angf, float& c, float& s) {
    const double a = (double)angf; const double n = __builtin_rint(a * 0.63661977236758134308);
    const double r = __builtin_fma(-n, 1.5707963267948966192, a) - n * 6.123233995736766e-17; const double r2 = r * r;
    double sp = -7.6471637318198164759e-13; sp = sp * r2 + 1.6059043836821614599e-10; sp = sp * r2 - 2.5052108385441718775e-8; sp = sp * r2 + 2.7557319223985890653e-6; sp = sp * r2 - 1.9841269841269841270e-4; sp = sp * r2 + 8.3333333333333333333e-3; sp = sp * r2 - 1.6666666666666666667e-1;
    const double sn = r + r * r2 * sp;
    double cp = 4.7794773323873852974e-14; cp = cp * r2 - 1.1470745597729724714e-11; cp = cp * r2 + 2.0876756987868098979e-9; cp = cp * r2 - 2.7557319223985890653e-7; cp = cp * r2 + 2.4801587301587301587e-5; cp = cp * r2 - 1.3888888888888888889e-3; cp = cp * r2 + 4.1666666666666666667e-2; cp = cp * r2 - 0.5;
    const double cs = 1.0 + r2 * cp;
    const int q = ((int)n) & 3;
    const double cc = (q == 0) ? cs : (q == 1) ? -sn : (q == 2) ? -cs : sn;
    const double ss = (q == 0) ? sn : (q == 1) ? cs : (q == 2) ? -sn : -cs;
    c = (float)cc; s = (float)ss;
}
__device__ __forceinline__ void prologue(const Params& p, LAS unsigned char* L) {
    const int tid = threadIdx.x, lane = tid & 63, wave = __builtin_amdgcn_readfirstlane(tid >> 6);
    const int G = gridDim.x, gw = blockIdx.x * 8 + wave, NGW = G * 8; const int gt = blockIdx.x * 512 + tid, NGT = G * 512;
    LAS float* scr = (LAS float*)(L + wave * 16384);
    unsigned char* ws = p.ws;
    constexpr int I_FI = 16 * 176, I_FO = 44 * 32, I_IN = 16 * 40, I_O = 16 * 32, I_PG = 16 * 32, I_PU = 4 * 32;
    constexpr int PER_LAYER = 2 * I_FI + 2 * I_FO + I_IN + I_O + I_PG + I_PU;
    for (int it = gw; it < NLAYER * PER_LAYER; it += NGW) {
        const int l = it / PER_LAYER; int r = it % PER_LAYER; unsigned char* wl = ws + WS_W + (size_t)l * WL_STRIDE;
        if (r < I_FI) { transpose_item(p.in[I_WFFA_IN] + (size_t)l * DM * NFF2, DM, NFF2, (bf16_t*)(wl + WL_FFA_IN), p.in[I_NFFA] + l * DM, 1, scr, r, lane); continue; } r -= I_FI;
        if (r < I_FI) { transpose_item(p.in[I_WFFB_IN] + (size_t)l * DM * NFF2, DM, NFF2, (bf16_t*)(wl + WL_FFB_IN), p.in[I_NFFB] + l * DM, 1, scr, r, lane); continue; } r -= I_FI;
        if (r < I_FO) { transpose_item(p.in[I_WFFA_OUT] + (size_t)l * DFF * DM, DFF, DM, (bf16_t*)(wl + WL_FFA_OUT), nullptr, 0, scr, r, lane); continue; } r -= I_FO;
        if (r < I_FO) { transpose_item(p.in[I_WFFB_OUT] + (size_t)l * DFF * DM, DFF, DM, (bf16_t*)(wl + WL_FFB_OUT), nullptr, 0, scr, r, lane); continue; } r -= I_FO;
        if (r < I_IN) { transpose_item(p.in[I_WIN] + (size_t)l * DM * NIN, DM, NIN, (bf16_t*)(wl + WL_IN), p.in[I_NMIX] + l * DM, 0, scr, r, lane); continue; } r -= I_IN;
        if (r < I_O) { transpose_item(p.in[I_WOUT] + (size_t)l * DM * DM, DM, DM, (bf16_t*)(wl + WL_OUT), nullptr, 0, scr, r, lane); continue; } r -= I_O;
        if (r < I_PG) { transpose_item(p.in[I_WPEG] + (size_t)l * DM * DM, DM, DM, (bf16_t*)(wl + WL_PEG), p.in[I_NPE] + l * DM, 0, scr, r, lane); continue; } r -= I_PG;
        transpose_item(p.in[I_WPEU] + (size_t)l * PED * DM, PED, DM, (bf16_t*)(wl + WL_PEU), nullptr, 0, scr, r, lane);
    }
    for (int t = gt; t < NLAYER * 4 * 128 * 16; t += NGT) {
        const int ko = t & 15, n = (t >> 4) & 127, g = (t >> 11) & 3, l = t >> 13;
        const float* src = p.in[I_WPOOL] + ((size_t)(l * 4 + g) * 128 + 8 * ko) * 128 + n; const float sc = p.in[I_PSCALE][l * 512 + g * 128 + n];
        u32x4 o; o.x = pk2(src[0] * sc, src[128] * sc); o.y = pk2(src[256] * sc, src[384] * sc); o.z = pk2(src[512] * sc, src[640] * sc); o.w = pk2(src[768] * sc, src[896] * sc);
        *(u32x4*)((bf16_t*)(ws + WS_W + (size_t)l * WL_STRIDE + WL_POOL) + ((size_t)g * 128 + n) * 128 + 8 * ko) = o;
    }
    bf16_t* xb = (bf16_t*)(ws + WS_XB); float* ssq = (float*)(ws + WS_SSQ);
    for (int m = gw; m < MT; m += NGW) {
        const float* xr = (m < MP) ? p.in[I_XP] + (size_t)m * DM : p.in[I_XS] + (size_t)(m - MP) * DM;
        f32x4 v[4]; float s = 0.f;
#pragma unroll
        for (int j = 0; j < 4; ++j) { v[j] = *((const f32x4*)xr + lane + 64 * j); s += (v[j][0] * v[j][0] + v[j][1] * v[j][1]) + (v[j][2] * v[j][2] + v[j][3] * v[j][3]); }
        s = wave_sum(s);
#pragma unroll
        for (int j = 0; j < 4; ++j) { u32x2 o; o.x = pk2(v[j][0], v[j][1]); o.y = pk2(v[j][2], v[j][3]); *((u32x2*)(xb + (size_t)m * DM) + lane + 64 * j) = o; }
        if (lane == 0) ssq[m] = s;
    }
    for (int t = gt; t < 8 * MT / 4; t += NGT) *((f32x4*)(ssq + MT) + t) = (f32x4){0.f, 0.f, 0.f, 0.f};
    bf16_t* pb = (bf16_t*)(ws + WS_PB);
    for (int t = gt; t < NLAYER * MT * 32; t += NGT) {
        const int o8 = t & 31, m = (t >> 5) % MT, l = (t >> 5) / MT;
        const float* src = ((m < MP) ? p.in[I_PP] + ((size_t)l * MP + m) * PED : p.in[I_PS] + ((size_t)l * MS + (m - MP)) * PED) + 8 * o8;
        const f32x4 a = *(const f32x4*)src, b = *(const f32x4*)(src + 4);
        u32x4 o; o.x = pk2(a[0], a[1]); o.y = pk2(a[2], a[3]); o.z = pk2(b[0], b[1]); o.w = pk2(b[2], b[3]);
        *(u32x4*)(pb + ((size_t)l * MT + m) * PED + 8 * o8) = o;
    }
    float* rope = (float*)(ws + WS_ROPE);
    for (int t = gt; t < 2112 * 8; t += NGT) {
        const int i = t & 7, idx = t >> 3, pos = idx < 2048 ? idx : 4096 + idx - 2048;
        const float ang = (float)pos * rope_inv(i); float c, s; sincos_d(ang, c, s);
        rope[idx * 16 + i] = c; rope[idx * 16 + 8 + i] = s;
    }
}

constexpr int KROW = 72, VROW = 200, DROW = 520;
constexpr int LK_OFF = 0, LV_OFF = 2 * 192 * KROW * 2, LMIX_END = LV_OFF + 2 * 64 * VROW * 2;
static_assert(LMIX_END <= 131072 && 64 * DROW * 2 <= 131072, "mixer LDS");
__device__ __forceinline__ bf16x8 pack8(const float* v) { u32x4 w; w.x = pk2(v[0], v[1]); w.y = pk2(v[2], v[3]); w.z = pk2(v[4], v[5]); w.w = pk2(v[6], v[7]); return __builtin_bit_cast(bf16x8, w); }
__device__ __forceinline__ void unpack8(u32x4 w, float* v) { v[0] = bflo(w.x); v[1] = bfhi(w.x); v[2] = bflo(w.y); v[3] = bfhi(w.y); v[4] = bflo(w.z); v[5] = bfhi(w.z); v[6] = bflo(w.w); v[7] = bfhi(w.w); }
__device__ __forceinline__ void loadu(const bf16_t* z, const float* sp, bool is_s, int c, int tok0, int c0, int t, float* u) {
    const int ps = c * 64 + t;
    if (t >= 0 || (!is_s && ps >= 0)) unpack8(*(const u32x4*)(z + (size_t)(tok0 + t) * NIN + 768 + c0), u);
    else if (is_s) { const f32x4 a = *(const f32x4*)(sp + (15 + t) * 512), bb = *(const f32x4*)(sp + (15 + t) * 512 + 4); u[0] = a[0]; u[1] = a[1]; u[2] = a[2]; u[3] = a[3]; u[4] = bb[0]; u[5] = bb[1]; u[6] = bb[2]; u[7] = bb[3]; }
    else {
#pragma unroll
        for (int i = 0; i < 8; ++i) u[i] = 0.f; }
}
__device__ __forceinline__ void mixer_unit(const Params& p, int layer, int cu, LAS unsigned char* L) {
    int tid_ = threadIdx.x; asm volatile("" : "+v"(tid_));
    const int tid = tid_, lane = tid & 63, wave = __builtin_amdgcn_readfirstlane(tid >> 6);
    const bool is_s = cu >= 1024;
    const int b = is_s ? cu - 1024 : (cu >> 5), c = is_s ? 0 : (cu & 31);
    const int tok0 = is_s ? MP + b * 64 : b * SEQ + c * 64;
    const int kstart = is_s ? 0 : (c >= 2 ? 0 : (2 - c) * 64);
    const int pidx0 = is_s ? 2048 : c * 64;
    const bf16_t* z = (const bf16_t*)(p.ws + WS_Z); bf16_t* mix = (bf16_t*)(p.ws + WS_MIX);
    const float* rope = (const float*)(p.ws + WS_ROPE);
    {
        const int sub = tid & 7;
        float kn[8];
#pragma unroll
        for (int i = 0; i < 8; ++i) kn[i] = p.in[I_KN][layer * 64 + sub * 8 + i];
#pragma unroll 1
        for (int pass = 0; pass < 6; ++pass) {
            const int kvh = pass / 3, seg = pass % 3, kk = seg * 64 + (tid >> 3);
            if (seg * 64 < kstart) continue;
            float v[8], vv[8];
            if (is_s && seg < 2) {
                const size_t o = ((((size_t)layer * NB + b) * 128 + kk) * 2 + kvh) * 64 + sub * 8;
                const f32x4 a0 = *(const f32x4*)(p.in[I_CK] + o), a1 = *(const f32x4*)(p.in[I_CK] + o + 4), c0 = *(const f32x4*)(p.in[I_CV] + o), c1 = *(const f32x4*)(p.in[I_CV] + o + 4);
#pragma unroll
                for (int i = 0; i < 4; ++i) { v[i] = a0[i]; v[4 + i] = a1[i]; vv[i] = c0[i]; vv[4 + i] = c1[i]; }
            } else {
                const size_t zr = (size_t)(tok0 + kk - 128) * NIN;
                unpack8(*(const u32x4*)(z + zr + 512 + kvh * 64 + sub * 8), v); unpack8(*(const u32x4*)(z + zr + 640 + kvh * 64 + sub * 8), vv);
                float ss = 0.f;
#pragma unroll
                for (int i = 0; i < 8; ++i) ss += v[i] * v[i];
                ss += __shfl_xor(ss, 1); ss += __shfl_xor(ss, 2); ss += __shfl_xor(ss, 4);
                const float rs = __builtin_amdgcn_rsqf(ss * (1.0f / 64.0f) + EPS);
                const float* rt = rope + (size_t)(pidx0 + kk - 128) * 16;
                const f32x4 c0 = *(const f32x4*)rt, c1 = *(const f32x4*)(rt + 4), s0 = *(const f32x4*)(rt + 8), s1 = *(const f32x4*)(rt + 12);
#pragma unroll
                for (int i = 0; i < 8; ++i) {
                    v[i] = v[i] * rs * kn[i];
                    const float pv = __shfl_xor(v[i], 1); const float cs = i < 4 ? c0[i & 3] : c1[i & 3], sn = i < 4 ? s0[i & 3] : s1[i & 3];
                    if (sub == 0) v[i] = v[i] * cs - pv * sn; else if (sub == 1) v[i] = v[i] * cs + pv * sn;
                }
            }
            *(LAS bf16x8*)(L + LK_OFF + ((kvh * 192 + kk) * KROW + sub * 8) * 2) = pack8(v);
#pragma unroll
            for (int i = 0; i < 8; i += 2) { const unsigned w = pk2(vv[i], vv[i + 1]);
                *(LAS unsigned short*)(L + LV_OFF + ((kvh * 64 + sub * 8 + i) * VROW + kk) * 2) = (unsigned short)(w & 0xffffu);
                *(LAS unsigned short*)(L + LV_OFF + ((kvh * 64 + sub * 8 + i + 1) * VROW + kk) * 2) = (unsigned short)(w >> 16); }
            int orow = -1;
            if (is_s) { if (kk >= 64) orow = kk - 64; } else if (c >= 30 && seg == 2) orow = (c - 30) * 64 + (kk - 128);
            if (orow >= 0) {
                const size_t o = ((((size_t)layer * NB + b) * 128 + orow) * 2 + kvh) * 64 + sub * 8;
                float* ok = p.out + (is_s ? O_KS : O_KP) + o; float* ov = p.out + (is_s ? O_VS : O_VP) + o;
                *(f32x4*)ok = (f32x4){v[0], v[1], v[2], v[3]}; *(f32x4*)(ok + 4) = (f32x4){v[4], v[5], v[6], v[7]};
                *(f32x4*)ov = (f32x4){vv[0], vv[1], vv[2], vv[3]}; *(f32x4*)(ov + 4) = (f32x4){vv[4], vv[5], vv[6], vv[7]};
            }
        }
    }
    __syncthreads();
    {
        const int h = wave, kvh = h >> 2, q16 = lane & 15, quad = lane >> 4;
        const float sinkv = p.in[I_SINK][layer * 8 + h] * LOG2E;
        float gq0[8], gq1[8];
#pragma unroll
        for (int i = 0; i < 8; ++i) { gq0[i] = p.in[I_QN][layer * 64 + 8 * quad + i]; gq1[i] = p.in[I_QN][layer * 64 + 32 + 8 * quad + i]; }
        const LAS unsigned char* Kb = L + LK_OFF + ((kvh * 192 + q16) * KROW + 8 * quad) * 2;
        const LAS unsigned char* Vb = L + LV_OFF + ((kvh * 64 + q16) * VROW + 4 * quad) * 2;
#pragma unroll 1
        for (int qb = 0; qb < 4; ++qb) {
            const int row = tok0 + 16 * qb + q16;
            float v0[8], v1[8];
            unpack8(*(const u32x4*)(z + (size_t)row * NIN + h * 64 + 8 * quad), v0); unpack8(*(const u32x4*)(z + (size_t)row * NIN + h * 64 + 32 + 8 * quad), v1);
            float ss = 0.f;
#pragma unroll
            for (int i = 0; i < 8; ++i) ss += v0[i] * v0[i] + v1[i] * v1[i];
            ss += __shfl_xor(ss, 16); ss += __shfl_xor(ss, 32);
            const float rs = __builtin_amdgcn_rsqf(ss * (1.0f / 64.0f) + EPS);
            const float* rt = rope + (size_t)(pidx0 + 16 * qb + q16) * 16;
            const f32x4 c0 = *(const f32x4*)rt, c1 = *(const f32x4*)(rt + 4), s0 = *(const f32x4*)(rt + 8), s1 = *(const f32x4*)(rt + 12);
            constexpr float QS = 0.125f * LOG2E;
#pragma unroll
            for (int i = 0; i < 8; ++i) {
                v0[i] = v0[i] * rs * gq0[i]; v1[i] = v1[i] * rs * gq1[i] * QS;
                const float pv = __shfl_xor(v0[i], 16); const float cs = i < 4 ? c0[i & 3] : c1[i & 3], sn = i < 4 ? s0[i & 3] : s1[i & 3];
                if (quad == 0) v0[i] = v0[i] * cs - pv * sn; else if (quad == 1) v0[i] = v0[i] * cs + pv * sn;
                v0[i] *= QS;
            }
            const bf16x8 qf0 = pack8(v0), qf1 = pack8(v1);
            f32x4 s[12];
#pragma unroll
            for (int kt = 0; kt < 12; ++kt) {
                if (16 * kt >= kstart) {
                    const bf16x8 k0 = *(const LAS bf16x8*)(Kb + kt * 16 * KROW * 2), k1 = *(const LAS bf16x8*)(Kb + kt * 16 * KROW * 2 + 64);
                    s[kt] = __builtin_amdgcn_mfma_f32_16x16x32_bf16(k0, qf0, (f32x4){0.f, 0.f, 0.f, 0.f}, 0, 0, 0);
                    s[kt] = __builtin_amdgcn_mfma_f32_16x16x32_bf16(k1, qf1, s[kt], 0, 0, 0);
                } else s[kt] = (f32x4){-1e30f, -1e30f, -1e30f, -1e30f};
            }
            float mx = sinkv;
#pragma unroll
            for (int kt = 0; kt < 12; ++kt) mx = fmaxf(fmaxf(mx, fmaxf(s[kt][0], s[kt][1])), fmaxf(s[kt][2], s[kt][3]));
            mx = fmaxf(mx, __shfl_xor(mx, 16)); mx = fmaxf(mx, __shfl_xor(mx, 32));
            float l = 0.f;
#pragma unroll
            for (int kt = 0; kt < 12; ++kt)
#pragma unroll
                for (int j = 0; j < 4; ++j) { s[kt][j] = __builtin_amdgcn_exp2f(s[kt][j] - mx); l += s[kt][j]; }
            l += __shfl_xor(l, 16); l += __shfl_xor(l, 32);
            l += __builtin_amdgcn_exp2f(sinkv - mx);
            f32x4 o[4];
#pragma unroll
            for (int dt = 0; dt < 4; ++dt) o[dt] = (f32x4){0.f, 0.f, 0.f, 0.f};
#pragma unroll
            for (int si = 0; si < 6; ++si) {
                if (32 * si >= kstart) {
                    u32x4 pw; pw.x = pk2(s[2 * si][0], s[2 * si][1]); pw.y = pk2(s[2 * si][2], s[2 * si][3]); pw.z = pk2(s[2 * si + 1][0], s[2 * si + 1][1]); pw.w = pk2(s[2 * si + 1][2], s[2 * si + 1][3]);
                    const bf16x8 pf = __builtin_bit_cast(bf16x8, pw);
#pragma unroll
                    for (int dt = 0; dt < 4; ++dt) {
                        const u32x2 a = *(const LAS u32x2*)(Vb + (dt * 16 * VROW + 32 * si) * 2), bq = *(const LAS u32x2*)(Vb + (dt * 16 * VROW + 32 * si + 16) * 2);
                        const u32x4 vw = {a.x, a.y, bq.x, bq.y};
                        o[dt] = __builtin_amdgcn_mfma_f32_16x16x32_bf16(__builtin_bit_cast(bf16x8, vw), pf, o[dt], 0, 0, 0);
                    }
                }
            }
            const float inv = 1.0f / l;
#pragma unroll
            for (int dt = 0; dt < 4; ++dt) { u32x2 w; w.x = pk2(o[dt][0] * inv, o[dt][1] * inv); w.y = pk2(o[dt][2] * inv, o[dt][3] * inv);
                *(u32x2*)(mix + (size_t)row * DM + h * 64 + 16 * dt + 4 * quad) = w; }
        }
    }
    __syncthreads();
    {
        const int oct = tid & 63, tg = tid >> 6, c0 = 8 * oct, g = oct >> 4, w = 2 << g, t0 = 8 * tg;
        const float* sp = p.in[I_SP] + ((size_t)layer * NB + b) * 15 * 512 + c0;
        float sum[8];
#pragma unroll
        for (int i = 0; i < 8; ++i) sum[i] = 0.f;
#pragma unroll 1
        for (int j = 1; j < 16; ++j) if (j < w) { float u[8]; loadu(z, sp, is_s, c, tok0, c0, t0 - j, u);
#pragma unroll
            for (int i = 0; i < 8; ++i) sum[i] += u[i]; }
#pragma unroll 1
        for (int ti = 0; ti < 8; ++ti) {
            const int t = t0 + ti; float u[8]; loadu(z, sp, is_s, c, tok0, c0, t, u);
            const int cnt = is_s ? w : min(c * 64 + t + 1, w); const float rc = 1.0f / (float)cnt;
            float d[8];
#pragma unroll
            for (int i = 0; i < 8; ++i) { sum[i] += u[i]; d[i] = sum[i] * rc - u[i]; }
            *(LAS bf16x8*)(L + (t * DROW + c0) * 2) = pack8(d);
            if (t >= 49 && (is_s || c == 31)) { float* o = p.out + (is_s ? O_US : O_UP) + (((size_t)layer * NB + b) * 15 + (t - 49)) * 512 + c0;
                *(f32x4*)o = (f32x4){u[0], u[1], u[2], u[3]}; *(f32x4*)(o + 4) = (f32x4){u[4], u[5], u[6], u[7]}; }
            float ul[8]; loadu(z, sp, is_s, c, tok0, c0, t - w + 1, ul);
#pragma unroll
            for (int i = 0; i < 8; ++i) sum[i] -= ul[i];
        }
    }
    __syncthreads();
    {
        const int g = wave >> 1, th = wave & 1, q16 = lane & 15, quad = lane >> 4;
        bf16x8 dfr[2][4];
#pragma unroll
        for (int tb = 0; tb < 2; ++tb)
#pragma unroll
            for (int ks = 0; ks < 4; ++ks) dfr[tb][ks] = *(const LAS bf16x8*)(L + ((32 * th + 16 * tb + q16) * DROW + 128 * g + 32 * ks + 8 * quad) * 2);
        const bf16_t* wp = (const bf16_t*)(p.ws + WS_W + (size_t)layer * WL_STRIDE + WL_POOL) + (size_t)g * 128 * 128;
#pragma unroll 2
        for (int nt = 0; nt < 8; ++nt) {
            bf16x8 wf[4];
#pragma unroll
            for (int ks = 0; ks < 4; ++ks) wf[ks] = *(const bf16x8*)(wp + (16 * nt + q16) * 128 + 32 * ks + 8 * quad);
#pragma unroll
            for (int tb = 0; tb < 2; ++tb) {
                f32x4 o = (f32x4){0.f, 0.f, 0.f, 0.f};
#pragma unroll
                for (int ks = 0; ks < 4; ++ks) o = __builtin_amdgcn_mfma_f32_16x16x32_bf16(wf[ks], dfr[tb][ks], o, 0, 0, 0);
                u32x2 ww; ww.x = pk2(o[0], o[1]); ww.y = pk2(o[2], o[3]);
                *(u32x2*)(mix + (size_t)(tok0 + 32 * th + 16 * tb + q16) * DM + 512 + 128 * g + 16 * nt + 4 * quad) = ww;
            }
        }
    }
    __syncthreads();
}

constexpr int LDS_BYTES = 131072 + 4096;
__global__ void __launch_bounds__(512, 2) hymba_fwd(Params p) {
    extern __shared__ __attribute__((aligned(16))) unsigned char lds_raw[];
    LAS unsigned char* L = (LAS unsigned char*)lds_raw;
    cg::grid_group grid = cg::this_grid();
#define PHASE_VARS size_t oz_ = 0; int ly = layer; asm volatile("" : "+s"(oz_), "+s"(ly)); unsigned char* ws = p.ws + oz_; bf16_t* xb = (bf16_t*)(ws + WS_XB); bf16_t* act = (bf16_t*)(ws + WS_ACT); bf16_t* zb = (bf16_t*)(ws + WS_Z); bf16_t* mixb = (bf16_t*)(ws + WS_MIX); bf16_t* ub = (bf16_t*)(ws + WS_U); \
        float* xres = p.out + O_Y; unsigned char* wl = ws + WS_W + (size_t)ly * WL_STRIDE; float* sq = (float*)(ws + WS_SSQ) + (size_t)ly * 4 * MT; (void)xb; (void)act; (void)zb; (void)mixb; (void)ub; (void)xres; (void)wl; (void)sq;
    const int G = gridDim.x, c = blockIdx.x;
    prologue(p, L);
    grid.sync();
#pragma unroll 1
    for (int layer = 0; layer < NLAYER; ++layer) {
        { PHASE_VARS pg8::Gemm g{ly == 0 ? xb : (const bf16_t*)(ws + WS_XB2), (const bf16_t*)(wl + WL_FFA_IN), MT, NFF2, DM}; pg8::StaticOrder S; S.init(MT, NFF2, G, c); EpiSwiglu E{act, sq};
          pg8::gemm_phase<EpiSwiglu, pg8::StaticOrder, true, true>(L, g, S, E); }
        grid.sync();
        { PHASE_VARS pg8::Gemm g{act, (const bf16_t*)(wl + WL_FFA_OUT), MT, DM, DFF}; pg8::StaticOrder S; S.init(MT, DM, G, c);
          EpiResid<0> E{ly == 0 ? p.in[I_XP] : xres, ly == 0 ? p.in[I_XS] - (size_t)MP * DM : xres, xres, xb, sq + MT, 0.5f, nullptr, nullptr};
          pg8::gemm_phase<EpiResid<0>, pg8::StaticOrder, true, true>(L, g, S, E); }
        grid.sync();
        { PHASE_VARS pg8::Gemm g{xb, (const bf16_t*)(wl + WL_IN), MT, NIN, DM}; pg8::StaticOrder S; S.init(MT, NIN, G, c); EpiStore E{zb, NIN, sq + MT};
          pg8::gemm_phase<EpiStore, pg8::StaticOrder, true, true>(L, g, S, E); }
        grid.sync();
#pragma unroll 1
        for (int cu = c; cu < 1056; cu += G) mixer_unit(p, layer, cu, L);
        grid.sync();
        { PHASE_VARS pg8::Gemm g{mixb, (const bf16_t*)(wl + WL_OUT), MT, DM, DM}; pg8::StaticOrder S; S.init(MT, DM, G, c);
          EpiResid<0> E{xres, xres, xres, xb, sq + 2 * MT, 1.0f, nullptr, nullptr};
          pg8::gemm_phase<EpiResid<0>, pg8::StaticOrder, true, true>(L, g, S, E); }
        grid.sync();
        { PHASE_VARS pg8::Gemm g{xb, (const bf16_t*)(wl + WL_FFB_IN), MT, NFF2, DM}; pg8::StaticOrder S; S.init(MT, NFF2, G, c); EpiSwiglu E{act, sq + 2 * MT};
          pg8::gemm_phase<EpiSwiglu, pg8::StaticOrder, true, true>(L, g, S, E); }
        grid.sync();
        { PHASE_VARS pg8::Gemm g{act, (const bf16_t*)(wl + WL_FFB_OUT), MT, DM, DFF}; pg8::StaticOrder S; S.init(MT, DM, G, c);
          EpiResid<0> E{xres, xres, xres, xb, sq + 3 * MT, 0.5f, nullptr, nullptr};
          pg8::gemm_phase<EpiResid<0>, pg8::StaticOrder, true, true>(L, g, S, E); }
        grid.sync();
        { PHASE_VARS pg8::Gemm g{(const bf16_t*)(ws + WS_PB) + (size_t)ly * MT * PED, (const bf16_t*)(wl + WL_PEU), MT, DM, PED}; pg8::StaticOrder S; S.init(MT, DM, G, c); EpiStore E{ub, DM, nullptr};
          pg8::gemm_phase<EpiStore, pg8::StaticOrder, true, true>(L, g, S, E); }
        { PHASE_VARS pg8::Gemm g{xb, (const bf16_t*)(wl + WL_PEG), MT, DM, DM}; pg8::StaticOrder S; S.init(MT, DM, G, c);
          EpiResid<1> E{xres, xres, xres, (bf16_t*)(ws + WS_XB2), sq + 4 * MT, 1.0f, ub, sq + 3 * MT};
          pg8::gemm_phase<EpiResid<1>, pg8::StaticOrder, true, true>(L, g, S, E); }
        if (layer + 1 < NLAYER) grid.sync();
    }
}

extern "C" void kernel_launch(void* const* d_in, const int* in_sizes, int n_in, void* d_out, int out_size, void* d_ws, size_t ws_size, hipStream_t stream) {
    static int grid = 0;
    if (grid == 0) {
        if (n_in != 24 || in_sizes[0] != MP * DM || (size_t)out_size != O_END || ws_size < WS_END) { fprintf(stderr, "kernel_launch: unexpected shapes (n_in %d, in0 %d, out %d, ws %zu)\n", n_in, n_in > 0 ? in_sizes[0] : -1, out_size, ws_size); grid = -1; return; }
        int dev = 0, cus = 0, per_cu = 0;
        if (hipGetDevice(&dev) != hipSuccess || hipDeviceGetAttribute(&cus, hipDeviceAttributeMultiprocessorCount, dev) != hipSuccess) { grid = -1; return; }
        if (hipFuncSetAttribute((const void*)hymba_fwd, hipFuncAttributeMaxDynamicSharedMemorySize, LDS_BYTES) != hipSuccess) { fprintf(stderr, "kernel_launch: hipFuncSetAttribute failed\n"); grid = -1; return; }
        if (hipOccupancyMaxActiveBlocksPerMultiprocessor(&per_cu, (const void*)hymba_fwd, 512, LDS_BYTES) != hipSuccess || per_cu < 1) { fprintf(stderr, "kernel_launch: occupancy query says %d\n", per_cu); per_cu = 1; }
        (void)hipGetLastError();
        grid = cus * 1;
    }
    if (grid < 0) return;
    Params p{};
    for (int i = 0; i < 24; ++i) p.in[i] = (const float*)d_in[i];
    p.out = (float*)d_out; p.ws = (unsigned char*)d_ws;
    void* args[] = {&p};
    hipError_t e = hipLaunchCooperativeKernel((const void*)hymba_fwd, dim3(grid), dim3(512), args, LDS_BYTES, stream);
    if (e != hipSuccess) fprintf(stderr, "kernel_launch: cooperative launch failed: %s (grid %d)\n", hipGetErrorString(e), grid);
}
```

```cpp
#include <hip/hip_runtime.h>
#include <hip/hip_cooperative_groups.h>
#include <cstdio>
#include <cstdint>
namespace cg = cooperative_groups;
namespace pg8 {
#define PG8_LAS __attribute__((address_space(3)))
typedef unsigned short bf16_t;
typedef short bf16x8 __attribute__((ext_vector_type(8)));
typedef float f32x4 __attribute__((ext_vector_type(4)));
typedef unsigned u32x4 __attribute__((ext_vector_type(4)));
constexpr int BM = 256, BK = 64, HALF = 128, HTB = HALF * BK * 2  , STAGE_BYTES = 8 * HTB, NXCD = 8, WGM = 8;

__host__ __device__ __forceinline__ int lds_byte(int r, int c) { const int st = (r >> 4) * 2 + (c >> 5), rr = r & 15, cc = c & 31, ob = rr * 64 + cc * 2; return st * 1024 + (ob ^ (((ob >> 9) & 1) << 5)); }
__host__ __device__ __forceinline__ void stage_rc(int b, int& R, int& C) { const int st = b / 1024, sb = b % 1024, swz = sb ^ (((sb >> 9) & 1) << 5); R = (st >> 1) * 16 + swz / 64; C = (st & 1) * 32 + (swz % 64) / 2; }
__host__ __device__ __forceinline__ int perm32(int rho) { const int n = rho >> 4, i = rho & 15; return 8 * (i >> 2) + 4 * n + (i & 3); }

struct Unit { int pm, pn; };
struct Gemm { const bf16_t* A; const bf16_t* Bt; int M, N, K; };

struct StaticOrder {
    int nM, nN, nwg, G, c;
    __host__ __device__ void init(int M, int N, int G_, int c_) { nM = M / BM; nN = N / BM; nwg = nM * nN; G = G_; c = c_; }
    __host__ __device__ bool next(int i, Unit& u) const {
        const long L = (long)i * G + c; if (L >= nwg) return false;
        int wgid = (int)L; { const int q = nwg / NXCD, r = nwg % NXCD, xcd = wgid % NXCD, off = wgid / NXCD; wgid = (xcd < r ? xcd * (q + 1) : r * (q + 1) + (xcd - r) * q) + off; }
        const int nig = WGM * nN, gid = wgid / nig, fm = gid * WGM, gsz = (nM - fm) < WGM ? (nM - fm) : WGM;
        u.pm = fm + ((wgid % nig) % gsz); u.pn = (wgid % nig) / gsz; return true;
    }
    __device__ __forceinline__ void a_ready(const Unit&) const {}
    __device__ __forceinline__ void done(const Unit&) const {}
};
__device__ __forceinline__ unsigned cvt_pk_bf16(float lo, float hi) { unsigned r; asm volatile("v_cvt_pk_bf16_f32 %0, %1, %2" : "=v"(r) : "v"(lo), "v"(hi)); return r; }
typedef float f32x2 __attribute__((ext_vector_type(2)));
template <class Epi, class Sched, bool ALIGN_EPI = false, bool SP2 = false>
__device__ __forceinline__ void gemm_phase(PG8_LAS unsigned char* lds, const Gemm g, const Sched& S, const Epi& E) {
    int tid_ = threadIdx.x; asm volatile("" : "+v"(tid_));
    const int tid = tid_, wid = __builtin_amdgcn_readfirstlane(tid >> 6), lane = tid & 63, wr = wid >> 2, wc = wid & 3, fr = lane & 15, fq = lane >> 4;
    const int K = g.K, nt = K / BK;
    unsigned voffA[2], voffB[2];
#pragma unroll
    for (int i = 0; i < 2; ++i) { int R, C; stage_rc(tid * 16 + i * 8192, R, C); const int Rb = Epi::PERM ? ((R & ~31) + perm32(R & 31)) : R;
        voffA[i] = (unsigned)(R * K + C) * 2u; voffB[i] = (unsigned)(Rb * K + C) * 2u; }
    const size_t kstep = (size_t)(BK * 2);
    const size_t hstep = (size_t)HALF * K * 2;
    const size_t tstep = 2 * hstep;
    const unsigned ldsw = (unsigned)wid * 1024u;
    const int aoff = lds_byte(wr * 64 + fr, fq * 8), boff = lds_byte(wc * 32 + fr, fq * 8);
#define PG8_SA(b, h) (((b) * 2 + (h)) * HTB)
#define PG8_SB(b, h) ((4 + (b) * 2 + (h)) * HTB)
#define PG8_STAGE(bufoff, gbase, voff) do { _Pragma("unroll") for (int _i = 0; _i < 2; ++_i) \
        __builtin_amdgcn_global_load_lds((const unsigned*)((const char*)(gbase) + (voff)[_i]), (PG8_LAS unsigned*)(lds + (bufoff) + ldsw + _i * 8192), 16, 0, 0); } while (0)
#define PG8_LDA(dst, b, h) do { _Pragma("unroll") for (int m = 0; m < 4; ++m) _Pragma("unroll") for (int k = 0; k < 2; ++k) dst[m][k] = *(const PG8_LAS bf16x8*)(lds + PG8_SA(b, h) + aoff + m * 2048 + k * 1024); } while (0)
#define PG8_LDB(dst, b, h) do { _Pragma("unroll") for (int n = 0; n < 2; ++n) _Pragma("unroll") for (int k = 0; k < 2; ++k) dst[n][k] = *(const PG8_LAS bf16x8*)(lds + PG8_SB(b, h) + boff + n * 2048 + k * 1024); } while (0)
#define PG8_MMA(ai, bj, At, Bt) do { __builtin_amdgcn_s_setprio(1); _Pragma("unroll") for (int m = 0; m < 4; ++m) _Pragma("unroll") for (int n = 0; n < 2; ++n) _Pragma("unroll") for (int k = 0; k < 2; ++k) \
        acc[ai][bj][m][n] = __builtin_amdgcn_mfma_f32_16x16x32_bf16(Bt[n][k], At[m][k], acc[ai][bj][m][n], 0, 0, 0); __builtin_amdgcn_s_setprio(0); } while (0)
#define PG8_WAIT_V(n) asm volatile("s_waitcnt vmcnt(" #n ")" ::: "memory")
#define PG8_WAIT_L(n) asm volatile("s_waitcnt lgkmcnt(" #n ")" ::: "memory")
#define PG8_BAR __builtin_amdgcn_s_barrier()
#define PG8_SCHED __builtin_amdgcn_sched_barrier(0)
    Unit cur, nxt; int ui = 0;
    if (!S.next(0, cur)) return;
    f32x4 acc[2][2][4][2];
#pragma unroll
    for (int a = 0; a < 2; ++a)
#pragma unroll
        for (int b = 0; b < 2; ++b)
#pragma unroll
            for (int m = 0; m < 4; ++m)
#pragma unroll
                for (int n = 0; n < 2; ++n) acc[a][b][m][n] = (f32x4){0.f, 0.f, 0.f, 0.f};
    bf16x8 At[4][2], B0[2][2], B1[2][2];
    const char* cA = (const char*)g.A + (size_t)cur.pm * tstep; const char* cB = (const char*)g.Bt + (size_t)cur.pn * tstep;
    S.a_ready(cur);
    if constexpr (SP2) {
        PG8_STAGE(PG8_SB(0, 0), cB, voffB); PG8_STAGE(PG8_SB(0, 1), cB + hstep, voffB); PG8_STAGE(PG8_SA(0, 0), cA, voffA); PG8_STAGE(PG8_SA(0, 1), cA + hstep, voffA);
        if (wr == 1) PG8_BAR;
        PG8_WAIT_V(2); PG8_BAR;
        PG8_STAGE(PG8_SB(1, 0), cB + kstep, voffB); PG8_STAGE(PG8_SA(1, 0), cA + kstep, voffA); PG8_STAGE(PG8_SB(1, 1), cB + hstep + kstep, voffB);
        PG8_WAIT_V(6); PG8_BAR;
    } else {
        PG8_STAGE(PG8_SB(0, 0), cB, voffB); PG8_STAGE(PG8_SA(0, 0), cA, voffA); PG8_STAGE(PG8_SB(0, 1), cB + hstep, voffB); PG8_STAGE(PG8_SA(0, 1), cA + hstep, voffA);
        if (wr == 1) PG8_BAR;
        PG8_WAIT_V(4); PG8_BAR;
        PG8_STAGE(PG8_SB(1, 0), cB + kstep, voffB); PG8_STAGE(PG8_SA(1, 0), cA + kstep, voffA); PG8_STAGE(PG8_SB(1, 1), cB + hstep + kstep, voffB);
        PG8_WAIT_V(6); PG8_BAR;
    }
    for (;;) {
        const bool has_next = S.next(ui + 1, nxt);
        const char* nA = has_next ? (const char*)g.A + (size_t)nxt.pm * tstep : cA; const char* nB = has_next ? (const char*)g.Bt + (size_t)nxt.pn * tstep : cB;
        for (int t = 0; t < nt; t += 2) {
            const bool last = (t == nt - 2);
            const char* a1 = cA + (size_t)(t + 1) * kstep;
            const char* a2 = last ? nA : cA + (size_t)(t + 2) * kstep; const char* b2 = last ? nB : cB + (size_t)(t + 2) * kstep;
            const char* a3 = a2 + kstep; const char* b3 = b2 + kstep;
            if (last && has_next) S.a_ready(nxt);
            if constexpr (SP2) {
            PG8_LDB(B0, 0, 0); PG8_LDB(B1, 0, 1); PG8_SCHED; PG8_LDA(At, 0, 0); PG8_STAGE(PG8_SA(1, 1), a1 + hstep, voffA);
            PG8_WAIT_V(8); PG8_WAIT_L(0); PG8_BAR; PG8_MMA(0, 0, At, B0); PG8_MMA(0, 1, At, B1); PG8_BAR; PG8_SCHED;
            PG8_LDA(At, 0, 1); PG8_STAGE(PG8_SB(0, 0), b2, voffB); PG8_STAGE(PG8_SB(0, 1), b2 + hstep, voffB); PG8_STAGE(PG8_SA(0, 0), a2, voffA);
            PG8_WAIT_V(8); PG8_WAIT_L(0); PG8_BAR; PG8_MMA(1, 0, At, B0); PG8_MMA(1, 1, At, B1); PG8_BAR; PG8_SCHED;
            PG8_LDB(B0, 1, 0); PG8_LDB(B1, 1, 1); PG8_SCHED; PG8_LDA(At, 1, 0); PG8_STAGE(PG8_SA(0, 1), a2 + hstep, voffA);
            PG8_WAIT_V(8); PG8_WAIT_L(0); PG8_BAR; PG8_MMA(0, 0, At, B0); PG8_MMA(0, 1, At, B1); PG8_BAR; PG8_SCHED;
            PG8_LDA(At, 1, 1); PG8_STAGE(PG8_SB(1, 0), b3, voffB); PG8_STAGE(PG8_SB(1, 1), b3 + hstep, voffB); PG8_STAGE(PG8_SA(1, 0), a3, voffA);
            PG8_WAIT_V(8); PG8_WAIT_L(0); PG8_BAR; PG8_MMA(1, 0, At, B0); PG8_MMA(1, 1, At, B1); PG8_BAR; PG8_SCHED;
            } else {
            PG8_LDB(B0, 0, 0); PG8_SCHED; PG8_LDA(At, 0, 0); PG8_STAGE(PG8_SA(1, 1), a1 + hstep, voffA);
            PG8_WAIT_L(8); PG8_BAR; PG8_WAIT_L(0); PG8_MMA(0, 0, At, B0); PG8_BAR; PG8_SCHED;
            PG8_LDB(B1, 0, 1); PG8_STAGE(PG8_SB(0, 0), b2, voffB);
            PG8_BAR; PG8_WAIT_L(0); PG8_MMA(0, 1, At, B1); PG8_BAR;
            PG8_LDA(At, 0, 1); PG8_STAGE(PG8_SA(0, 0), a2, voffA);
            PG8_BAR; PG8_WAIT_L(0); PG8_MMA(1, 0, At, B0); PG8_BAR; PG8_SCHED;
            PG8_STAGE(PG8_SB(0, 1), b2 + hstep, voffB);
            PG8_WAIT_V(6); PG8_BAR; PG8_MMA(1, 1, At, B1); PG8_BAR;
            PG8_LDB(B0, 1, 0); PG8_SCHED; PG8_LDA(At, 1, 0); PG8_STAGE(PG8_SA(0, 1), a2 + hstep, voffA);
            PG8_WAIT_L(8); PG8_BAR; PG8_WAIT_L(0); PG8_MMA(0, 0, At, B0); PG8_BAR; PG8_SCHED;
            PG8_LDB(B1, 1, 1); PG8_STAGE(PG8_SB(1, 0), b3, voffB);
            PG8_BAR; PG8_WAIT_L(0); PG8_MMA(0, 1, At, B1); PG8_BAR;
            PG8_LDA(At, 1, 1); PG8_STAGE(PG8_SA(1, 0), a3, voffA);
            PG8_BAR; PG8_WAIT_L(0); PG8_MMA(1, 0, At, B0); PG8_BAR; PG8_SCHED;
            PG8_STAGE(PG8_SB(1, 1), b3 + hstep, voffB);
            PG8_WAIT_V(6); PG8_BAR; PG8_MMA(1, 1, At, B1); PG8_BAR;
            }
        }
        if constexpr (ALIGN_EPI) { if (wr == 0) PG8_BAR; }
        if constexpr (!Epi::AFTER_DRAIN) { E(acc, cur, wr, wc, fr, fq); S.done(cur); }
        if (!has_next) break;
#pragma unroll
        for (int a = 0; a < 2; ++a)
#pragma unroll
            for (int b = 0; b < 2; ++b)
#pragma unroll
                for (int m = 0; m < 4; ++m)
#pragma unroll
                    for (int n = 0; n < 2; ++n) acc[a][b][m][n] = (f32x4){0.f, 0.f, 0.f, 0.f};
        cur = nxt; cA = nA; cB = nB; ++ui;
        if constexpr (ALIGN_EPI) { if (wr == 1) PG8_BAR; }
    }
    PG8_WAIT_V(0);
    if constexpr (!ALIGN_EPI) { if (wr == 0) PG8_BAR; }
    PG8_BAR;
    if constexpr (Epi::AFTER_DRAIN) { E.fused(acc, cur, wr, wc, fr, fq, lds, wid, lane); S.done(cur); }
#undef PG8_SA
#undef PG8_SB
#undef PG8_STAGE
#undef PG8_LDA
#undef PG8_LDB
#undef PG8_MMA
#undef PG8_WAIT_V
#undef PG8_WAIT_L
#undef PG8_BAR
#undef PG8_SCHED
}
}

#define LAS __attribute__((address_space(3)))
using pg8::f32x4; using pg8::u32x4; using pg8::bf16_t; using pg8::bf16x8; using pg8::Unit;
typedef float f32x2 __attribute__((ext_vector_type(2)));
typedef __bf16 bf16x2_t __attribute__((ext_vector_type(2)));
typedef unsigned u32x2 __attribute__((ext_vector_type(2)));
constexpr int DM = 1024, DFF = 2816, NFF2 = 5632, NIN = 1280, PED = 256;
constexpr int MP = 65536, MS = 2048, MT = MP + MS;
constexpr int NB = 32, SEQ = 2048, DSEQ = 64, NLAYER = 2;
constexpr float EPS = 1e-6f, LOG2E = 1.4426950408889634f;
constexpr size_t MiB = 1u << 20;
constexpr size_t WL_FFA_IN = 0, WL_FFA_OUT = 11 * MiB, WL_IN = WL_FFA_OUT + 5 * MiB + MiB / 2, WL_OUT = WL_IN + 2 * MiB + MiB / 2, WL_FFB_IN = WL_OUT + 2 * MiB,
                 WL_FFB_OUT = WL_FFB_IN + 11 * MiB, WL_PEG = WL_FFB_OUT + 5 * MiB + MiB / 2, WL_PEU = WL_PEG + 2 * MiB, WL_POOL = WL_PEU + MiB / 2, WL_STRIDE = 41 * MiB;
static_assert(WL_POOL + 131072 <= WL_STRIDE, "weights map");
constexpr size_t WS_W = 0, WS_XB = 82 * MiB, WS_ACT = 214 * MiB, WS_Z = WS_ACT, WS_MIX = WS_ACT + 165 * MiB, WS_U = WS_ACT, WS_PB = 577 * MiB, WS_SSQ = 643 * MiB, WS_ROPE = 646 * MiB, WS_XB2 = 647 * MiB, WS_END = 779 * MiB;
static_assert((size_t)MT * DM * 2 == 132 * MiB && (size_t)MT * DFF * 2 == 363 * MiB && (size_t)MT * NIN * 2 == 165 * MiB && (size_t)2 * MT * PED * 2 == 66 * MiB, "buffer sizes");
constexpr size_t O_Y = 0, O_KP = (size_t)MT * DM, O_VP = O_KP + 1048576, O_UP = O_VP + 1048576, O_KS = O_UP + 491520, O_VS = O_KS + 1048576, O_US = O_VS + 1048576, O_END = O_US + 491520;

struct Params {
    const float* in[24]; float* out; unsigned char* ws;
};
enum { I_XP = 0, I_XS, I_PP, I_PS, I_CK, I_CV, I_SP, I_NFFA, I_WFFA_IN, I_WFFA_OUT, I_NMIX, I_WIN, I_QN, I_KN, I_SINK, I_WPOOL, I_PSCALE, I_WOUT, I_NFFB, I_WFFB_IN, I_WFFB_OUT, I_NPE, I_WPEG, I_WPEU };

__device__ __forceinline__ unsigned pk2(float lo, float hi) { f32x2 v = {lo, hi}; bf16x2_t b = __builtin_convertvector(v, bf16x2_t); return __builtin_bit_cast(unsigned, b); }
__device__ __forceinline__ float bflo(unsigned w) { return __uint_as_float(w << 16); }
__device__ __forceinline__ float bfhi(unsigned w) { return __uint_as_float(w & 0xffff0000u); }
__device__ __forceinline__ float rstd_of(const float* ssq, int row) { return __builtin_amdgcn_rsqf(ssq[row] * (1.0f / 1024.0f) + EPS); }
__device__ __forceinline__ float silu_f(float g) { return g * __builtin_amdgcn_rcpf(1.0f + __builtin_amdgcn_exp2f(-LOG2E * g)); }
__device__ __forceinline__ float sigm_f(float g) { return __builtin_amdgcn_rcpf(1.0f + __builtin_amdgcn_exp2f(-LOG2E * g)); }
__device__ __forceinline__ float wave_sum(float v) {
#pragma unroll
    for (int o = 1; o < 64; o <<= 1) v += __shfl_xor(v, o);
    return v;
}

struct EpiSwiglu {
    static constexpr bool PERM = true, AFTER_DRAIN = false;
    bf16_t* act; const float* ssq;
    __device__ __forceinline__ void operator()(const f32x4 (&acc)[2][2][4][2], const Unit& u, int wr, int wc, int fr, int fq) const {
        const int row0 = u.pm * 256 + wr * 64 + fr, col0 = u.pn * 128 + wc * 32 + 8 * fq;
#pragma unroll
        for (int ai = 0; ai < 2; ++ai)
#pragma unroll
            for (int m = 0; m < 4; ++m) {
                const int row = row0 + ai * 128 + m * 16; const float rs = rstd_of(ssq, row);
                const f32x4 g0 = acc[ai][0][m][0] * rs, g1 = acc[ai][0][m][1] * rs, u0 = acc[ai][1][m][0] * rs, u1 = acc[ai][1][m][1] * rs;
                u32x4 w;
                w.x = pk2(silu_f(g0[0]) * u0[0], silu_f(g0[1]) * u0[1]); w.y = pk2(silu_f(g0[2]) * u0[2], silu_f(g0[3]) * u0[3]);
                w.z = pk2(silu_f(g1[0]) * u1[0], silu_f(g1[1]) * u1[1]); w.w = pk2(silu_f(g1[2]) * u1[2], silu_f(g1[3]) * u1[3]);
                *(u32x4*)(act + (size_t)row * DFF + col0) = w;
            }
    }
};
struct EpiStore {
    static constexpr bool PERM = true, AFTER_DRAIN = false;
    bf16_t* O; int ldc; const float* ssq;
    __device__ __forceinline__ void operator()(const f32x4 (&acc)[2][2][4][2], const Unit& u, int wr, int wc, int fr, int fq) const {
        const int row0 = u.pm * 256 + wr * 64 + fr, col0 = u.pn * 256 + wc * 32 + 8 * fq;
#pragma unroll
        for (int ai = 0; ai < 2; ++ai)
#pragma unroll
            for (int m = 0; m < 4; ++m) {
                const int row = row0 + ai * 128 + m * 16; const float rs = ssq ? rstd_of(ssq, row) : 1.0f;
#pragma unroll
                for (int bj = 0; bj < 2; ++bj) {
                    const f32x4 v0 = acc[ai][bj][m][0] * rs, v1 = acc[ai][bj][m][1] * rs;
                    u32x4 w; w.x = pk2(v0[0], v0[1]); w.y = pk2(v0[2], v0[3]); w.z = pk2(v1[0], v1[1]); w.w = pk2(v1[2], v1[3]);
                    *(u32x4*)(O + (size_t)row * ldc + col0 + bj * 128) = w;
                }
            }
    }
};
template <int MODE> struct EpiResid {
    static constexpr bool PERM = true, AFTER_DRAIN = false;
    const bf16_t* xi; bf16_t* xo; float* yout; float* ssq_next; float scale; const bf16_t* U; const float* ssq_cur;
    __device__ __forceinline__ void operator()(const f32x4 (&acc)[2][2][4][2], const Unit& u, int wr, int wc, int fr, int fq) const {
        const int row0 = u.pm * 256 + wr * 64 + fr, col0 = u.pn * 256 + wc * 32 + 8 * fq;
#pragma unroll
        for (int ai = 0; ai < 2; ++ai)
#pragma unroll
            for (int m = 0; m < 4; ++m) {
                const int row = row0 + ai * 128 + m * 16; const size_t off = (size_t)row * DM + col0;
                const float rs = (MODE == 1) ? rstd_of(ssq_cur, row) : 0.f; float ss = 0.f;
#pragma unroll
                for (int bj = 0; bj < 2; ++bj) {
                    const u32x4 xw = *(const u32x4*)(xi + off + bj * 128);
                    f32x4 a0 = acc[ai][bj][m][0], a1 = acc[ai][bj][m][1];
                    if (MODE == 1) {
                        const u32x4 uu = *(const u32x4*)(U + off + bj * 128);
                        a0[0] = sigm_f(a0[0] * rs) * bflo(uu.x); a0[1] = sigm_f(a0[1] * rs) * bfhi(uu.x); a0[2] = sigm_f(a0[2] * rs) * bflo(uu.y); a0[3] = sigm_f(a0[3] * rs) * bfhi(uu.y);
                        a1[0] = sigm_f(a1[0] * rs) * bflo(uu.z); a1[1] = sigm_f(a1[1] * rs) * bfhi(uu.z); a1[2] = sigm_f(a1[2] * rs) * bflo(uu.w); a1[3] = sigm_f(a1[3] * rs) * bfhi(uu.w);
                    } else { a0 = a0 * scale; a1 = a1 * scale; }
                    const f32x4 v0 = (f32x4){bflo(xw.x), bfhi(xw.x), bflo(xw.y), bfhi(xw.y)} + a0, v1 = (f32x4){bflo(xw.z), bfhi(xw.z), bflo(xw.w), bfhi(xw.w)} + a1;
                    if (yout) { *(f32x4*)(yout + off + bj * 128) = v0; *(f32x4*)(yout + off + bj * 128 + 4) = v1; }
                    else {
                        u32x4 w; w.x = pk2(v0[0], v0[1]); w.y = pk2(v0[2], v0[3]); w.z = pk2(v1[0], v1[1]); w.w = pk2(v1[2], v1[3]);
                        *(u32x4*)(xo + off + bj * 128) = w;
                        ss += (v0[0] * v0[0] + v0[1] * v0[1]) + (v0[2] * v0[2] + v0[3] * v0[3]) + (v1[0] * v1[0] + v1[1] * v1[1]) + (v1[2] * v1[2] + v1[3] * v1[3]);
                    }
                }
                if (!yout) { ss += __shfl_xor(ss, 16); ss += __shfl_xor(ss, 32);
                    if (fq == 0) __hip_atomic_fetch_add(ssq_next + row, ss, __ATOMIC_RELAXED, __HIP_MEMORY_SCOPE_AGENT); }
                if (m & 1) asm volatile("" ::: "memory");
            }
    }
};

__device__ __forceinline__ void transpose_item(const float* W, int K, int N, bf16_t* WT, const float* gk, int mode, LAS float* scr, int item, int lane) {
    const int nblk = N / 32, kb = item / nblk, nb = item % nblk, k0 = 64 * kb, n0 = 32 * nb;
    const int sc = (mode == 1) ? (((n0 >> 7) & 1) * DFF + (n0 >> 8) * 128 + (n0 & 127)) : n0;
#pragma unroll 8
    for (int i = 0; i < 32; ++i) { const int kk = 2 * i + (lane >> 5); const float gv = gk ? gk[k0 + kk] : 1.0f; scr[kk * 33 + (lane & 31)] = W[(size_t)(k0 + kk) * N + sc + (lane & 31)] * gv; }
    asm volatile("s_waitcnt lgkmcnt(0)" ::: "memory");
    const int c = lane & 7;
#pragma unroll
    for (int j = 0; j < 4; ++j) { const int n = (lane >> 3) + 8 * j; const LAS float* s = scr + (8 * c) * 33 + n;
        u32x4 o; o.x = pk2(s[0 * 33], s[1 * 33]); o.y = pk2(s[2 * 33], s[3 * 33]); o.z = pk2(s[4 * 33], s[5 * 33]); o.w = pk2(s[6 * 33], s[7 * 33]);
        *(u32x4*)(WT + (size_t)(n0 + n) * K + k0 + 8 * c) = o; }
    asm volatile("s_waitcnt lgkmcnt(0)" ::: "memory");
}
__device__ __forceinline__ float rope_inv(int i) {
    return i == 0 ? 1.0f : i == 1 ? 0.1939227432012558f : i == 2 ? 0.03760603070259094f : i == 3 ? 0.007292664609849453f : i == 4 ? 0.0014142135623842478f : i == 5 ? 0.00027424818836152554f : i == 6 ? 5.3182957344688475e-05f : 1.0313385246263351e-05f;
}
__device__ __forceinline__ void sincos_d(float angf, float& c, float& s) {
    const double a = (double)angf; const double n = __builtin_rint(a * 0.63661977236758134308);
    const double r = __builtin_fma(-n, 1.5707963267948966192, a) - n * 6.123233995736766e-17; const double r2 = r * r;
    double sp = -7.6471637318198164759e-13; sp = sp * r2 + 1.6059043836821614599e-10; sp = sp * r2 - 2.5052108385441718775e-8; sp = sp * r2 + 2.7557319223985890653e-6; sp = sp * r2 - 1.9841269841269841270e-4; sp = sp * r2 + 8.3333333333333333333e-3; sp = sp * r2 - 1.6666666666666666667e-1;
    const double sn = r + r * r2 * sp;
    double cp = 4.7794773323873852974e-14; cp = cp * r2 - 1.1470745597729724714e-11; cp = cp * r2 + 2.0876756987868098979e-9; cp = cp * r2 - 2.7557319223985890653e-7; cp = cp * r2 + 2.4801587301587301587e-5; cp = cp * r2 - 1.3888888888888888889e-3; cp = cp * r2 + 4.1666666666666666667e-2; cp = cp * r2 - 0.5;
    const double cs = 1.0 + r2 * cp;
    const int q = ((int)n) & 3;
    const double cc = (q == 0) ? cs : (q == 1) ? -sn : (q == 2) ? -cs : sn;
    const double ss = (q == 0) ? sn : (q == 1) ? cs : (q == 2) ? -sn : -cs;
    c = (float)cc; s = (float)ss;
}
__device__ __forceinline__ void prologue(const Params& p, LAS unsigned char* L) {
    const int tid = threadIdx.x, lane = tid & 63, wave = __builtin_amdgcn_readfirstlane(tid >> 6);
    const int G = gridDim.x, gw = blockIdx.x * 8 + wave, NGW = G * 8; const int gt = blockIdx.x * 512 + tid, NGT = G * 512;
    LAS float* scr = (LAS float*)(L + wave * 16384);
    unsigned char* ws = p.ws;
    constexpr int I_FI = 16 * 176, I_FO = 44 * 32, I_IN = 16 * 40, I_O = 16 * 32, I_PG = 16 * 32, I_PU = 4 * 32;
    constexpr int PER_LAYER = 2 * I_FI + 2 * I_FO + I_IN + I_O + I_PG + I_PU;
    for (int it = gw; it < NLAYER * PER_LAYER; it += NGW) {
        const int l = it / PER_LAYER; int r = it % PER_LAYER; unsigned char* wl = ws + WS_W + (size_t)l * WL_STRIDE;
        if (r < I_FI) { transpose_item(p.in[I_WFFA_IN] + (size_t)l * DM * NFF2, DM, NFF2, (bf16_t*)(wl + WL_FFA_IN), p.in[I_NFFA] + l * DM, 1, scr, r, lane); continue; } r -= I_FI;
        if (r < I_FI) { transpose_item(p.in[I_WFFB_IN] + (size_t)l * DM * NFF2, DM, NFF2, (bf16_t*)(wl + WL_FFB_IN), p.in[I_NFFB] + l * DM, 1, scr, r, lane); continue; } r -= I_FI;
        if (r < I_FO) { transpose_item(p.in[I_WFFA_OUT] + (size_t)l * DFF * DM, DFF, DM, (bf16_t*)(wl + WL_FFA_OUT), nullptr, 0, scr, r, lane); continue; } r -= I_FO;
        if (r < I_FO) { transpose_item(p.in[I_WFFB_OUT] + (size_t)l * DFF * DM, DFF, DM, (bf16_t*)(wl + WL_FFB_OUT), nullptr, 0, scr, r, lane); continue; } r -= I_FO;
        if (r < I_IN) { transpose_item(p.in[I_WIN] + (size_t)l * DM * NIN, DM, NIN, (bf16_t*)(wl + WL_IN), p.in[I_NMIX] + l * DM, 0, scr, r, lane); continue; } r -= I_IN;
        if (r < I_O) { transpose_item(p.in[I_WOUT] + (size_t)l * DM * DM, DM, DM, (bf16_t*)(wl + WL_OUT), nullptr, 0, scr, r, lane); continue; } r -= I_O;
        if (r < I_PG) { transpose_item(p.in[I_WPEG] + (size_t)l * DM * DM, DM, DM, (bf16_t*)(wl + WL_PEG), p.in[I_NPE] + l * DM, 0, scr, r, lane); continue; } r -= I_PG;
        transpose_item(p.in[I_WPEU] + (size_t)l * PED * DM, PED, DM, (bf16_t*)(wl + WL_PEU), nullptr, 0, scr, r, lane);
    }
    for (int t = gt; t < NLAYER * 4 * 128 * 16; t += NGT) {
        const int ko = t & 15, n = (t >> 4) & 127, g = (t >> 11) & 3, l = t >> 13;
        const float* src = p.in[I_WPOOL] + ((size_t)(l * 4 + g) * 128 + 8 * ko) * 128 + n; const float sc = p.in[I_PSCALE][l * 512 + g * 128 + n];
        u32x4 o; o.x = pk2(src[0] * sc, src[128] * sc); o.y = pk2(src[256] * sc, src[384] * sc); o.z = pk2(src[512] * sc, src[640] * sc); o.w = pk2(src[768] * sc, src[896] * sc);
        *(u32x4*)((bf16_t*)(ws + WS_W + (size_t)l * WL_STRIDE + WL_POOL) + ((size_t)g * 128 + n) * 128 + 8 * ko) = o;
    }
    bf16_t* xb = (bf16_t*)(ws + WS_XB); float* ssq = (float*)(ws + WS_SSQ);
    for (int m = gw; m < MT; m += NGW) {
        const float* xr = (m < MP) ? p.in[I_XP] + (size_t)m * DM : p.in[I_XS] + (size_t)(m - MP) * DM;
        f32x4 v[4]; float s = 0.f;
#pragma unroll
        for (int j = 0; j < 4; ++j) { v[j] = *((const f32x4*)xr + lane + 64 * j); s += (v[j][0] * v[j][0] + v[j][1] * v[j][1]) + (v[j][2] * v[j][2] + v[j][3] * v[j][3]); }
        s = wave_sum(s);
#pragma unroll
        for (int j = 0; j < 4; ++j) { u32x2 o; o.x = pk2(v[j][0], v[j][1]); o.y = pk2(v[j][2], v[j][3]); *((u32x2*)(xb + (size_t)m * DM) + lane + 64 * j) = o; }
        if (lane == 0) ssq[m] = s;
    }
    for (int t = gt; t < 8 * MT / 4; t += NGT) *((f32x4*)(ssq + MT) + t) = (f32x4){0.f, 0.f, 0.f, 0.f};
    bf16_t* pb = (bf16_t*)(ws + WS_PB);
    for (int t = gt; t < NLAYER * MT * 32; t += NGT) {
        const int o8 = t & 31, m = (t >> 5) % MT, l = (t >> 5) / MT;
        const float* src = ((m < MP) ? p.in[I_PP] + ((size_t)l * MP + m) * PED : p.in[I_PS] + ((size_t)l * MS + (m - MP)) * PED) + 8 * o8;
        const f32x4 a = *(const f32x4*)src, b = *(const f32x4*)(src + 4);
        u32x4 o; o.x = pk2(a[0], a[1]); o.y = pk2(a[2], a[3]); o.z = pk2(b[0], b[1]); o.w = pk2(b[2], b[3]);
        *(u32x4*)(pb + ((size_t)l * MT + m) * PED + 8 * o8) = o;
    }
    float* rope = (float*)(ws + WS_ROPE);
    for (int t = gt; t < 2112 * 8; t += NGT) {
        const int i = t & 7, idx = t >> 3, pos = idx < 2048 ? idx : 4096 + idx - 2048;
        const float ang = (float)pos * rope_inv(i); float c, s; sincos_d(ang, c, s);
        rope[idx * 16 + i] = c; rope[idx * 16 + 8 + i] = s;
    }
}

constexpr int KROW = 72, VROW = 200, DROW = 520;
constexpr int LK_OFF = 0, LV_OFF = 2 * 192 * KROW * 2, LMIX_END = LV_OFF + 2 * 64 * VROW * 2;
static_assert(LMIX_END <= 131072 && 64 * DROW * 2 <= 131072, "mixer LDS");
__device__ __forceinline__ bf16x8 pack8(const float* v) { u32x4 w; w.x = pk2(v[0], v[1]); w.y = pk2(v[2], v[3]); w.z = pk2(v[4], v[5]); w.w = pk2(v[6], v[7]); return __builtin_bit_cast(bf16x8, w); }
__device__ __forceinline__ void unpack8(u32x4 w, float* v) { v[0] = bflo(w.x); v[1] = bfhi(w.x); v[2] = bflo(w.y); v[3] = bfhi(w.y); v[4] = bflo(w.z); v[5] = bfhi(w.z); v[6] = bflo(w.w); v[7] = bfhi(w.w); }
__device__ __forceinline__ void loadu(const bf16_t* z, const float* sp, bool is_s, int c, int tok0, int c0, int t, float* u) {
    const int ps = c * 64 + t;
    if (t >= 0 || (!is_s && ps >= 0)) unpack8(*(const u32x4*)(z + (size_t)(tok0 + t) * NIN + 768 + c0), u);
    else if (is_s) { const f32x4 a = *(const f32x4*)(sp + (15 + t) * 512), bb = *(const f32x4*)(sp + (15 + t) * 512 + 4); u[0] = a[0]; u[1] = a[1]; u[2] = a[2]; u[3] = a[3]; u[4] = bb[0]; u[5] = bb[1]; u[6] = bb[2]; u[7] = bb[3]; }
    else {
#pragma unroll
        for (int i = 0; i < 8; ++i) u[i] = 0.f; }
}
__device__ __forceinline__ void mixer_unit(const Params& p, int layer, int cu, LAS unsigned char* L) {
    int tid_ = threadIdx.x; asm volatile("" : "+v"(tid_));
    const int tid = tid_, lane = tid & 63, wave = __builtin_amdgcn_readfirstlane(tid >> 6);
    const bool is_s = cu >= 1024;
    const int b = is_s ? cu - 1024 : (cu >> 5), c = is_s ? 0 : (cu & 31);
    const int tok0 = is_s ? MP + b * 64 : b * SEQ + c * 64;
    const int kstart = is_s ? 0 : (c >= 2 ? 0 : (2 - c) * 64);
    const int pidx0 = is_s ? 2048 : c * 64;
    const bf16_t* z = (const bf16_t*)(p.ws + WS_Z); bf16_t* mix = (bf16_t*)(p.ws + WS_MIX);
    const float* rope = (const float*)(p.ws + WS_ROPE);
    {
        const int sub = tid & 7;
        float kn[8];
#pragma unroll
        for (int i = 0; i < 8; ++i) kn[i] = p.in[I_KN][layer * 64 + sub * 8 + i];
#pragma unroll 1
        for (int pass = 0; pass < 6; ++pass) {
            const int kvh = pass / 3, seg = pass % 3, kk = seg * 64 + (tid >> 3);
            if (seg * 64 < kstart) continue;
            float v[8], vv[8];
            if (is_s && seg < 2) {
                const size_t o = ((((size_t)layer * NB + b) * 128 + kk) * 2 + kvh) * 64 + sub * 8;
                const f32x4 a0 = *(const f32x4*)(p.in[I_CK] + o), a1 = *(const f32x4*)(p.in[I_CK] + o + 4), c0 = *(const f32x4*)(p.in[I_CV] + o), c1 = *(const f32x4*)(p.in[I_CV] + o + 4);
#pragma unroll
                for (int i = 0; i < 4; ++i) { v[i] = a0[i]; v[4 + i] = a1[i]; vv[i] = c0[i]; vv[4 + i] = c1[i]; }
            } else {
                const size_t zr = (size_t)(tok0 + kk - 128) * NIN;
                unpack8(*(const u32x4*)(z + zr + 512 + kvh * 64 + sub * 8), v); unpack8(*(const u32x4*)(z + zr + 640 + kvh * 64 + sub * 8), vv);
                float ss = 0.f;
#pragma unroll
                for (int i = 0; i < 8; ++i) ss += v[i] * v[i];
                ss += __shfl_xor(ss, 1); ss += __shfl_xor(ss, 2); ss += __shfl_xor(ss, 4);
                const float rs = __builtin_amdgcn_rsqf(ss * (1.0f / 64.0f) + EPS);
                const float* rt = rope + (size_t)(pidx0 + kk - 128) * 16;
                const f32x4 c0 = *(const f32x4*)rt, c1 = *(const f32x4*)(rt + 4), s0 = *(const f32x4*)(rt + 8), s1 = *(const f32x4*)(rt + 12);
#pragma unroll
                for (int i = 0; i < 8; ++i) {
                    v[i] = v[i] * rs * kn[i];
                    const float pv = __shfl_xor(v[i], 1); const float cs = i < 4 ? c0[i & 3] : c1[i & 3], sn = i < 4 ? s0[i & 3] : s1[i & 3];
                    if (sub == 0) v[i] = v[i] * cs - pv * sn; else if (sub == 1) v[i] = v[i] * cs + pv * sn;
                }
            }
            *(LAS bf16x8*)(L + LK_OFF + ((kvh * 192 + kk) * KROW + sub * 8) * 2) = pack8(v);
#pragma unroll
            for (int i = 0; i < 8; i += 2) { const unsigned w = pk2(vv[i], vv[i + 1]);
                *(LAS unsigned short*)(L + LV_OFF + ((kvh * 64 + sub * 8 + i) * VROW + kk) * 2) = (unsigned short)(w & 0xffffu);
                *(LAS unsigned short*)(L + LV_OFF + ((kvh * 64 + sub * 8 + i + 1) * VROW + kk) * 2) = (unsigned short)(w >> 16); }
            int orow = -1;
            if (is_s) { if (kk >= 64) orow = kk - 64; } else if (c >= 30 && seg == 2) orow = (c - 30) * 64 + (kk - 128);
            if (orow >= 0) {
                const size_t o = ((((size_t)layer * NB + b) * 128 + orow) * 2 + kvh) * 64 + sub * 8;
                float* ok = p.out + (is_s ? O_KS : O_KP) + o; float* ov = p.out + (is_s ? O_VS : O_VP) + o;
                *(f32x4*)ok = (f32x4){v[0], v[1], v[2], v[3]}; *(f32x4*)(ok + 4) = (f32x4){v[4], v[5], v[6], v[7]};
                *(f32x4*)ov = (f32x4){vv[0], vv[1], vv[2], vv[3]}; *(f32x4*)(ov + 4) = (f32x4){vv[4], vv[5], vv[6], vv[7]};
            }
        }
    }
    __syncthreads();
    {
        const int h = wave, kvh = h >> 2, q16 = lane & 15, quad = lane >> 4;
        const float sinkv = p.in[I_SINK][layer * 8 + h] * LOG2E;
        float gq0[8], gq1[8];
#pragma unroll
        for (int i = 0; i < 8; ++i) { gq0[i] = p.in[I_QN][layer * 64 + 8 * quad + i]; gq1[i] = p.in[I_QN][layer * 64 + 32 + 8 * quad + i]; }
        const LAS unsigned char* Kb = L + LK_OFF + ((kvh * 192 + q16) * KROW + 8 * quad) * 2;
        const LAS unsigned char* Vb = L + LV_OFF + ((kvh * 64 + q16) * VROW + 4 * quad) * 2;
#pragma unroll 1
        for (int qb = 0; qb < 4; ++qb) {
            const int row = tok0 + 16 * qb + q16;
            float v0[8], v1[8];
            unpack8(*(const u32x4*)(z + (size_t)row * NIN + h * 64 + 8 * quad), v0); unpack8(*(const u32x4*)(z + (size_t)row * NIN + h * 64 + 32 + 8 * quad), v1);
            float ss = 0.f;
#pragma unroll
            for (int i = 0; i < 8; ++i) ss += v0[i] * v0[i] + v1[i] * v1[i];
            ss += __shfl_xor(ss, 16); ss += __shfl_xor(ss, 32);
            const float rs = __builtin_amdgcn_rsqf(ss * (1.0f / 64.0f) + EPS);
            const float* rt = rope + (size_t)(pidx0 + 16 * qb + q16) * 16;
            const f32x4 c0 = *(const f32x4*)rt, c1 = *(const f32x4*)(rt + 4), s0 = *(const f32x4*)(rt + 8), s1 = *(const f32x4*)(rt + 12);
            constexpr float QS = 0.125f * LOG2E;
#pragma unroll
            for (int i = 0; i < 8; ++i) {
                v0[i] = v0[i] * rs * gq0[i]; v1[i] = v1[i] * rs * gq1[i] * QS;
                const float pv = __shfl_xor(v0[i], 16); const float cs = i < 4 ? c0[i & 3] : c1[i & 3], sn = i < 4 ? s0[i & 3] : s1[i & 3];
                if (quad == 0) v0[i] = v0[i] * cs - pv * sn; else if (quad == 1) v0[i] = v0[i] * cs + pv * sn;
                v0[i] *= QS;
            }
            const bf16x8 qf0 = pack8(v0), qf1 = pack8(v1);
            f32x4 s[12];
#pragma unroll
            for (int kt = 0; kt < 12; ++kt) {
                if (16 * kt >= kstart) {
                    const bf16x8 k0 = *(const LAS bf16x8*)(Kb + kt * 16 * KROW * 2), k1 = *(const LAS bf16x8*)(Kb + kt * 16 * KROW * 2 + 64);
                    s[kt] = __builtin_amdgcn_mfma_f32_16x16x32_bf16(k0, qf0, (f32x4){0.f, 0.f, 0.f, 0.f}, 0, 0, 0);
                    s[kt] = __builtin_amdgcn_mfma_f32_16x16x32_bf16(k1, qf1, s[kt], 0, 0, 0);
                } else s[kt] = (f32x4){-1e30f, -1e30f, -1e30f, -1e30f};
            }
            float mx = sinkv;
#pragma unroll
            for (int kt = 0; kt < 12; ++kt) mx = fmaxf(fmaxf(mx, fmaxf(s[kt][0], s[kt][1])), fmaxf(s[kt][2], s[kt][3]));
            mx = fmaxf(mx, __shfl_xor(mx, 16)); mx = fmaxf(mx, __shfl_xor(mx, 32));
            float l = 0.f;
#pragma unroll
            for (int kt = 0; kt < 12; ++kt)
#pragma unroll
                for (int j = 0; j < 4; ++j) { s[kt][j] = __builtin_amdgcn_exp2f(s[kt][j] - mx); l += s[kt][j]; }
            l += __shfl_xor(l, 16); l += __shfl_xor(l, 32);
            l += __builtin_amdgcn_exp2f(sinkv - mx);
            f32x4 o[4];
#pragma unroll
            for (int dt = 0; dt < 4; ++dt) o[dt] = (f32x4){0.f, 0.f, 0.f, 0.f};
#pragma unroll
            for (int si = 0; si < 6; ++si) {
                if (32 * si >= kstart) {
                    u32x4 pw; pw.x = pk2(s[2 * si][0], s[2 * si][1]); pw.y = pk2(s[2 * si][2], s[2 * si][3]); pw.z = pk2(s[2 * si + 1][0], s[2 * si + 1][1]); pw.w = pk2(s[2 * si + 1][2], s[2 * si + 1][3]);
                    const bf16x8 pf = __builtin_bit_cast(bf16x8, pw);
#pragma unroll
                    for (int dt = 0; dt < 4; ++dt) {
                        const u32x2 a = *(const LAS u32x2*)(Vb + (dt * 16 * VROW + 32 * si) * 2), bq = *(const LAS u32x2*)(Vb + (dt * 16 * VROW + 32 * si + 16) * 2);
                        const u32x4 vw = {a.x, a.y, bq.x, bq.y};
                        o[dt] = __builtin_amdgcn_mfma_f32_16x16x32_bf16(__builtin_bit_cast(bf16x8, vw), pf, o[dt], 0, 0, 0);
                    }
                }
            }
            const float inv = 1.0f / l;
#pragma unroll
            for (int dt = 0; dt < 4; ++dt) { u32x2 w; w.x = pk2(o[dt][0] * inv, o[dt][1] * inv); w.y = pk2(o[dt][2] * inv, o[dt][3] * inv);
                *(u32x2*)(mix + (size_t)row * DM + h * 64 + 16 * dt + 4 * quad) = w; }
        }
    }
    __syncthreads();
    {
        const int oct = tid & 63, tg = tid >> 6, c0 = 8 * oct, g = oct >> 4, w = 2 << g, t0 = 8 * tg;
        const float* sp = p.in[I_SP] + ((size_t)layer * NB + b) * 15 * 512 + c0;
        float sum[8];
#pragma unroll
        for (int i = 0; i < 8; ++i) sum[i] = 0.f;
#pragma unroll 1
        for (int j = 1; j < 16; ++j) if (j < w) { float u[8]; loadu(z, sp, is_s, c, tok0, c0, t0 - j, u);
#pragma unroll
            for (int i = 0; i < 8; ++i) sum[i] += u[i]; }
#pragma unroll 1
        for (int ti = 0; ti < 8; ++ti) {
            const int t = t0 + ti; float u[8]; loadu(z, sp, is_s, c, tok0, c0, t, u);
            const int cnt = is_s ? w : min(c * 64 + t + 1, w); const float rc = 1.0f / (float)cnt;
            float d[8];
#pragma unroll
            for (int i = 0; i < 8; ++i) { sum[i] += u[i]; d[i] = sum[i] * rc - u[i]; }
            *(LAS bf16x8*)(L + (t * DROW + c0) * 2) = pack8(d);
            if (t >= 49 && (is_s || c == 31)) { float* o = p.out + (is_s ? O_US : O_UP) + (((size_t)layer * NB + b) * 15 + (t - 49)) * 512 + c0;
                *(f32x4*)o = (f32x4){u[0], u[1], u[2], u[3]}; *(f32x4*)(o + 4) = (f32x4){u[4], u[5], u[6], u[7]}; }
            float ul[8]; loadu(z, sp, is_s, c, tok0, c0, t - w + 1, ul);
#pragma unroll
            for (int i = 0; i < 8; ++i) sum[i] -= ul[i];
        }
    }
    __syncthreads();
    {
        const int g = wave >> 1, th = wave & 1, q16 = lane & 15, quad = lane >> 4;
        bf16x8 dfr[2][4];
#pragma unroll
        for (int tb = 0; tb < 2; ++tb)
#pragma unroll
            for (int ks = 0; ks < 4; ++ks) dfr[tb][ks] = *(const LAS bf16x8*)(L + ((32 * th + 16 * tb + q16) * DROW + 128 * g + 32 * ks + 8 * quad) * 2);
        const bf16_t* wp = (const bf16_t*)(p.ws + WS_W + (size_t)layer * WL_STRIDE + WL_POOL) + (size_t)g * 128 * 128;
#pragma unroll 2
        for (int nt = 0; nt < 8; ++nt) {
            bf16x8 wf[4];
#pragma unroll
            for (int ks = 0; ks < 4; ++ks) wf[ks] = *(const bf16x8*)(wp + (16 * nt + q16) * 128 + 32 * ks + 8 * quad);
#pragma unroll
            for (int tb = 0; tb < 2; ++tb) {
                f32x4 o = (f32x4){0.f, 0.f, 0.f, 0.f};
#pragma unroll
                for (int ks = 0; ks < 4; ++ks) o = __builtin_amdgcn_mfma_f32_16x16x32_bf16(wf[ks], dfr[tb][ks], o, 0, 0, 0);
                u32x2 ww; ww.x = pk2(o[0], o[1]); ww.y = pk2(o[2], o[3]);
                *(u32x2*)(mix + (size_t)(tok0 + 32 * th + 16 * tb + q16) * DM + 512 + 128 * g + 16 * nt + 4 * quad) = ww;
            }
        }
    }
    __syncthreads();
}

constexpr int LDS_BYTES = 131072 + 4096;
__global__ void __launch_bounds__(512, 2) hymba_fwd(Params p) {
    extern __shared__ __attribute__((aligned(16))) unsigned char lds_raw[];
    LAS unsigned char* L = (LAS unsigned char*)lds_raw;
    cg::grid_group grid = cg::this_grid();
#define PHASE_VARS size_t oz_ = 0; int ly = layer; asm volatile("" : "+s"(oz_), "+s"(ly)); unsigned char* ws = p.ws + oz_; bf16_t* xb = (bf16_t*)(ws + WS_XB); bf16_t* act = (bf16_t*)(ws + WS_ACT); bf16_t* zb = (bf16_t*)(ws + WS_Z); bf16_t* mixb = (bf16_t*)(ws + WS_MIX); bf16_t* ub = (bf16_t*)(ws + WS_U); \
        float* xres = p.out + O_Y; unsigned char* wl = ws + WS_W + (size_t)ly * WL_STRIDE; float* sq = (float*)(ws + WS_SSQ) + (size_t)ly * 4 * MT; (void)xb; (void)act; (void)zb; (void)mixb; (void)ub; (void)xres; (void)wl; (void)sq;
    const int G = gridDim.x, c = blockIdx.x;
    prologue(p, L);
    grid.sync();
#pragma unroll 1
    for (int layer = 0; layer < NLAYER; ++layer) {
        { PHASE_VARS pg8::Gemm g{ly == 0 ? xb : (const bf16_t*)(ws + WS_XB2), (const bf16_t*)(wl + WL_FFA_IN), MT, NFF2, DM}; pg8::StaticOrder S; S.init(MT, NFF2, G, c); EpiSwiglu E{act, sq};
          pg8::gemm_phase<EpiSwiglu, pg8::StaticOrder, true, true>(L, g, S, E); }
        grid.sync();
        { PHASE_VARS pg8::Gemm g{act, (const bf16_t*)(wl + WL_FFA_OUT), MT, DM, DFF}; pg8::StaticOrder S; S.init(MT, DM, G, c);
          EpiResid<0> E{ly == 0 ? xb : (const bf16_t*)(ws + WS_XB2), xb, nullptr, sq + MT, 0.5f, nullptr, nullptr};
          pg8::gemm_phase<EpiResid<0>, pg8::StaticOrder, true, true>(L, g, S, E); }
        grid.sync();
        { PHASE_VARS pg8::Gemm g{xb, (const bf16_t*)(wl + WL_IN), MT, NIN, DM}; pg8::StaticOrder S; S.init(MT, NIN, G, c); EpiStore E{zb, NIN, sq + MT};
          pg8::gemm_phase<EpiStore, pg8::StaticOrder, true, true>(L, g, S, E); }
        grid.sync();
#pragma unroll 1
        for (int cu = c; cu < 1056; cu += G) mixer_unit(p, layer, cu, L);
        grid.sync();
        { PHASE_VARS pg8::Gemm g{mixb, (const bf16_t*)(wl + WL_OUT), MT, DM, DM}; pg8::StaticOrder S; S.init(MT, DM, G, c);
          EpiResid<0> E{xb, xb, nullptr, sq + 2 * MT, 1.0f, nullptr, nullptr};
          pg8::gemm_phase<EpiResid<0>, pg8::StaticOrder, true, true>(L, g, S, E); }
        grid.sync();
        { PHASE_VARS pg8::Gemm g{xb, (const bf16_t*)(wl + WL_FFB_IN), MT, NFF2, DM}; pg8::StaticOrder S; S.init(MT, NFF2, G, c); EpiSwiglu E{act, sq + 2 * MT};
          pg8::gemm_phase<EpiSwiglu, pg8::StaticOrder, true, true>(L, g, S, E); }
        grid.sync();
        { PHASE_VARS pg8::Gemm g{act, (const bf16_t*)(wl + WL_FFB_OUT), MT, DM, DFF}; pg8::StaticOrder S; S.init(MT, DM, G, c);
          EpiResid<0> E{xb, xb, nullptr, sq + 3 * MT, 0.5f, nullptr, nullptr};
          pg8::gemm_phase<EpiResid<0>, pg8::StaticOrder, true, true>(L, g, S, E); }
        grid.sync();
        { PHASE_VARS pg8::Gemm g{(const bf16_t*)(ws + WS_PB) + (size_t)ly * MT * PED, (const bf16_t*)(wl + WL_PEU), MT, DM, PED}; pg8::StaticOrder S; S.init(MT, DM, G, c); EpiStore E{ub, DM, nullptr};
          pg8::gemm_phase<EpiStore, pg8::StaticOrder, true, true>(L, g, S, E); }
        { PHASE_VARS pg8::Gemm g{xb, (const bf16_t*)(wl + WL_PEG), MT, DM, DM}; pg8::StaticOrder S; S.init(MT, DM, G, c);
          EpiResid<1> E{xb, (bf16_t*)(ws + WS_XB2), ly + 1 < NLAYER ? nullptr : xres, sq + 4 * MT, 1.0f, ub, sq + 3 * MT};
          pg8::gemm_phase<EpiResid<1>, pg8::StaticOrder, true, true>(L, g, S, E); }
        if (layer + 1 < NLAYER) grid.sync();
    }
}

extern "C" void kernel_launch(void* const* d_in, const int* in_sizes, int n_in, void* d_out, int out_size, void* d_ws, size_t ws_size, hipStream_t stream) {
    static int grid = 0;
    if (grid == 0) {
        if (n_in != 24 || in_sizes[0] != MP * DM || (size_t)out_size != O_END || ws_size < WS_END) { fprintf(stderr, "kernel_launch: unexpected shapes (n_in %d, in0 %d, out %d, ws %zu)\n", n_in, n_in > 0 ? in_sizes[0] : -1, out_size, ws_size); grid = -1; return; }
        int dev = 0, cus = 0, per_cu = 0;
        if (hipGetDevice(&dev) != hipSuccess || hipDeviceGetAttribute(&cus, hipDeviceAttributeMultiprocessorCount, dev) != hipSuccess) { grid = -1; return; }
        if (hipFuncSetAttribute((const void*)hymba_fwd, hipFuncAttributeMaxDynamicSharedMemorySize, LDS_BYTES) != hipSuccess) { fprintf(stderr, "kernel_launch: hipFuncSetAttribute failed\n"); grid = -1; return; }
        if (hipOccupancyMaxActiveBlocksPerMultiprocessor(&per_cu, (const void*)hymba_fwd, 512, LDS_BYTES) != hipSuccess || per_cu < 1) { fprintf(stderr, "kernel_launch: occupancy query says %d\n", per_cu); per_cu = 1; }
        (void)hipGetLastError();
        grid = cus * 1;
    }
    if (grid < 0) return;
    Params p{};
    for (int i = 0; i < 24; ++i) p.in[i] = (const float*)d_in[i];
    p.out = (float*)d_out; p.ws = (unsigned char*)d_ws;
    void* args[] = {&p};
    hipError_t e = hipLaunchCooperativeKernel((const void*)hymba_fwd, dim3(grid), dim3(512), args, LDS_BYTES, stream);
    if (e != hipSuccess) fprintf(stderr, "kernel_launch: cooperative launch failed: %s (grid %d)\n", hipGetErrorString(e), grid);
}
```

```cpp
#include <hip/hip_runtime.h>
#include <hip/hip_cooperative_groups.h>
#include <cstdio>
#include <cstdint>
namespace cg = cooperative_groups;
namespace pg8 {
#define PG8_LAS __attribute__((address_space(3)))
typedef unsigned short bf16_t;
typedef short bf16x8 __attribute__((ext_vector_type(8)));
typedef float f32x4 __attribute__((ext_vector_type(4)));
typedef unsigned u32x4 __attribute__((ext_vector_type(4)));
constexpr int BM = 256, BK = 64, HALF = 128, HTB = HALF * BK * 2  , STAGE_BYTES = 8 * HTB, NXCD = 8, WGM = 8;

__host__ __device__ __forceinline__ int lds_byte(int r, int c) { const int st = (r >> 4) * 2 + (c >> 5), rr = r & 15, cc = c & 31, ob = rr * 64 + cc * 2; return st * 1024 + (ob ^ (((ob >> 9) & 1) << 5)); }
__host__ __device__ __forceinline__ void stage_rc(int b, int& R, int& C) { const int st = b / 1024, sb = b % 1024, swz = sb ^ (((sb >> 9) & 1) << 5); R = (st >> 1) * 16 + swz / 64; C = (st & 1) * 32 + (swz % 64) / 2; }
__host__ __device__ __forceinline__ int perm32(int rho) { const int n = rho >> 4, i = rho & 15; return 8 * (i >> 2) + 4 * n + (i & 3); }

struct Unit { int pm, pn; };
struct Gemm { const bf16_t* A; const bf16_t* Bt; int M, N, K; };

struct StaticOrder {
    int nM, nN, nwg, G, c;
    __host__ __device__ void init(int M, int N, int G_, int c_) { nM = M / BM; nN = N / BM; nwg = nM * nN; G = G_; c = c_; }
    __host__ __device__ bool next(int i, Unit& u) const {
        const long L = (long)i * G + c; if (L >= nwg) return false;
        int wgid = (int)L; { const int q = nwg / NXCD, r = nwg % NXCD, xcd = wgid % NXCD, off = wgid / NXCD; wgid = (xcd < r ? xcd * (q + 1) : r * (q + 1) + (xcd - r) * q) + off; }
        const int nig = WGM * nN, gid = wgid / nig, fm = gid * WGM, gsz = (nM - fm) < WGM ? (nM - fm) : WGM;
        u.pm = fm + ((wgid % nig) % gsz); u.pn = (wgid % nig) / gsz; return true;
    }
    __device__ __forceinline__ void a_ready(const Unit&) const {}
    __device__ __forceinline__ void done(const Unit&) const {}
};
__device__ __forceinline__ unsigned cvt_pk_bf16(float lo, float hi) { unsigned r; asm volatile("v_cvt_pk_bf16_f32 %0, %1, %2" : "=v"(r) : "v"(lo), "v"(hi)); return r; }
typedef float f32x2 __attribute__((ext_vector_type(2)));
template <class Epi, class Sched, bool ALIGN_EPI = false, bool SP2 = false>
__device__ __forceinline__ void gemm_phase(PG8_LAS unsigned char* lds, const Gemm g, const Sched& S, const Epi& E) {
    int tid_ = threadIdx.x; asm volatile("" : "+v"(tid_));
    const int tid = tid_, wid = __builtin_amdgcn_readfirstlane(tid >> 6), lane = tid & 63, wr = wid >> 2, wc = wid & 3, fr = lane & 15, fq = lane >> 4;
    const int K = g.K, nt = K / BK;
    unsigned voffA[2], voffB[2];
#pragma unroll
    for (int i = 0; i < 2; ++i) { int R, C; stage_rc(tid * 16 + i * 8192, R, C); const int Rb = Epi::PERM ? ((R & ~31) + perm32(R & 31)) : R;
        voffA[i] = (unsigned)(R * K + C) * 2u; voffB[i] = (unsigned)(Rb * K + C) * 2u; }
    const size_t kstep = (size_t)(BK * 2);
    const size_t hstep = (size_t)HALF * K * 2;
    const size_t tstep = 2 * hstep;
    const unsigned ldsw = (unsigned)wid * 1024u;
    const int aoff = lds_byte(wr * 64 + fr, fq * 8), boff = lds_byte(wc * 32 + fr, fq * 8);
#define PG8_SA(b, h) (((b) * 2 + (h)) * HTB)
#define PG8_SB(b, h) ((4 + (b) * 2 + (h)) * HTB)
#define PG8_STAGE(bufoff, gbase, voff) do { _Pragma("unroll") for (int _i = 0; _i < 2; ++_i) \
        __builtin_amdgcn_global_load_lds((const unsigned*)((const char*)(gbase) + (voff)[_i]), (PG8_LAS unsigned*)(lds + (bufoff) + ldsw + _i * 8192), 16, 0, 0); } while (0)
#define PG8_LDA(dst, b, h) do { _Pragma("unroll") for (int m = 0; m < 4; ++m) _Pragma("unroll") for (int k = 0; k < 2; ++k) dst[m][k] = *(const PG8_LAS bf16x8*)(lds + PG8_SA(b, h) + aoff + m * 2048 + k * 1024); } while (0)
#define PG8_LDB(dst, b, h) do { _Pragma("unroll") for (int n = 0; n < 2; ++n) _Pragma("unroll") for (int k = 0; k < 2; ++k) dst[n][k] = *(const PG8_LAS bf16x8*)(lds + PG8_SB(b, h) + boff + n * 2048 + k * 1024); } while (0)
#define PG8_MMA(ai, bj, At, Bt) do { __builtin_amdgcn_s_setprio(1); _Pragma("unroll") for (int m = 0; m < 4; ++m) _Pragma("unroll") for (int n = 0; n < 2; ++n) _Pragma("unroll") for (int k = 0; k < 2; ++k) \
        acc[ai][bj][m][n] = __builtin_amdgcn_mfma_f32_16x16x32_bf16(Bt[n][k], At[m][k], acc[ai][bj][m][n], 0, 0, 0); __builtin_amdgcn_s_setprio(0); } while (0)
#define PG8_WAIT_V(n) asm volatile("s_waitcnt vmcnt(" #n ")" ::: "memory")
#define PG8_WAIT_L(n) asm volatile("s_waitcnt lgkmcnt(" #n ")" ::: "memory")
#define PG8_BAR __builtin_amdgcn_s_barrier()
#define PG8_SCHED __builtin_amdgcn_sched_barrier(0)
    Unit cur, nxt; int ui = 0;
    if (!S.next(0, cur)) return;
    f32x4 acc[2][2][4][2];
#pragma unroll
    for (int a = 0; a < 2; ++a)
#pragma unroll
        for (int b = 0; b < 2; ++b)
#pragma unroll
            for (int m = 0; m < 4; ++m)
#pragma unroll
                for (int n = 0; n < 2; ++n) acc[a][b][m][n] = (f32x4){0.f, 0.f, 0.f, 0.f};
    bf16x8 At[4][2], B0[2][2], B1[2][2];
    const char* cA = (const char*)g.A + (size_t)cur.pm * tstep; const char* cB = (const char*)g.Bt + (size_t)cur.pn * tstep;
    S.a_ready(cur);
    if constexpr (SP2) {
        PG8_STAGE(PG8_SB(0, 0), cB, voffB); PG8_STAGE(PG8_SB(0, 1), cB + hstep, voffB); PG8_STAGE(PG8_SA(0, 0), cA, voffA); PG8_STAGE(PG8_SA(0, 1), cA + hstep, voffA);
        if (wr == 1) PG8_BAR;
        PG8_WAIT_V(2); PG8_BAR;
        PG8_STAGE(PG8_SB(1, 0), cB + kstep, voffB); PG8_STAGE(PG8_SA(1, 0), cA + kstep, voffA); PG8_STAGE(PG8_SB(1, 1), cB + hstep + kstep, voffB);
        PG8_WAIT_V(6); PG8_BAR;
    } else {
        PG8_STAGE(PG8_SB(0, 0), cB, voffB); PG8_STAGE(PG8_SA(0, 0), cA, voffA); PG8_STAGE(PG8_SB(0, 1), cB + hstep, voffB); PG8_STAGE(PG8_SA(0, 1), cA + hstep, voffA);
        if (wr == 1) PG8_BAR;
        PG8_WAIT_V(4); PG8_BAR;
        PG8_STAGE(PG8_SB(1, 0), cB + kstep, voffB); PG8_STAGE(PG8_SA(1, 0), cA + kstep, voffA); PG8_STAGE(PG8_SB(1, 1), cB + hstep + kstep, voffB);
        PG8_WAIT_V(6); PG8_BAR;
    }
    for (;;) {
        const bool has_next = S.next(ui + 1, nxt);
        const char* nA = has_next ? (const char*)g.A + (size_t)nxt.pm * tstep : cA; const char* nB = has_next ? (const char*)g.Bt + (size_t)nxt.pn * tstep : cB;
        for (int t = 0; t < nt; t += 2) {
            const bool last = (t == nt - 2);
            const char* a1 = cA + (size_t)(t + 1) * kstep;
            const char* a2 = last ? nA : cA + (size_t)(t + 2) * kstep; const char* b2 = last ? nB : cB + (size_t)(t + 2) * kstep;
            const char* a3 = a2 + kstep; const char* b3 = b2 + kstep;
            if (last && has_next) S.a_ready(nxt);
            if constexpr (SP2) {
            PG8_LDB(B0, 0, 0); PG8_LDB(B1, 0, 1); PG8_SCHED; PG8_LDA(At, 0, 0); PG8_STAGE(PG8_SA(1, 1), a1 + hstep, voffA);
            PG8_WAIT_V(8); PG8_WAIT_L(0); PG8_BAR; PG8_MMA(0, 0, At, B0); PG8_MMA(0, 1, At, B1); PG8_BAR; PG8_SCHED;
            PG8_LDA(At, 0, 1); PG8_STAGE(PG8_SB(0, 0), b2, voffB); PG8_STAGE(PG8_SB(0, 1), b2 + hstep, voffB); PG8_STAGE(PG8_SA(0, 0), a2, voffA);
            PG8_WAIT_V(8); PG8_WAIT_L(0); PG8_BAR; PG8_MMA(1, 0, At, B0); PG8_MMA(1, 1, At, B1); PG8_BAR; PG8_SCHED;
            PG8_LDB(B0, 1, 0); PG8_LDB(B1, 1, 1); PG8_SCHED; PG8_LDA(At, 1, 0); PG8_STAGE(PG8_SA(0, 1), a2 + hstep, voffA);
            PG8_WAIT_V(8); PG8_WAIT_L(0); PG8_BAR; PG8_MMA(0, 0, At, B0); PG8_MMA(0, 1, At, B1); PG8_BAR; PG8_SCHED;
            PG8_LDA(At, 1, 1); PG8_STAGE(PG8_SB(1, 0), b3, voffB); PG8_STAGE(PG8_SB(1, 1), b3 + hstep, voffB); PG8_STAGE(PG8_SA(1, 0), a3, voffA);
            PG8_WAIT_V(8); PG8_WAIT_L(0); PG8_BAR; PG8_MMA(1, 0, At, B0); PG8_MMA(1, 1, At, B1); PG8_BAR; PG8_SCHED;
            } else {
            PG8_LDB(B0, 0, 0); PG8_SCHED; PG8_LDA(At, 0, 0); PG8_STAGE(PG8_SA(1, 1), a1 + hstep, voffA);
            PG8_WAIT_L(8); PG8_BAR; PG8_WAIT_L(0); PG8_MMA(0, 0, At, B0); PG8_BAR; PG8_SCHED;
            PG8_LDB(B1, 0, 1); PG8_STAGE(PG8_SB(0, 0), b2, voffB);
            PG8_BAR; PG8_WAIT_L(0); PG8_MMA(0, 1, At, B1); PG8_BAR;
            PG8_LDA(At, 0, 1); PG8_STAGE(PG8_SA(0, 0), a2, voffA);
            PG8_BAR; PG8_WAIT_L(0); PG8_MMA(1, 0, At, B0); PG8_BAR; PG8_SCHED;
            PG8_STAGE(PG8_SB(0, 1), b2 + hstep, voffB);
            PG8_WAIT_V(6); PG8_BAR; PG8_MMA(1, 1, At, B1); PG8_BAR;
            PG8_LDB(B0, 1, 0); PG8_SCHED; PG8_LDA(At, 1, 0); PG8_STAGE(PG8_SA(0, 1), a2 + hstep, voffA);
            PG8_WAIT_L(8); PG8_BAR; PG8_WAIT_L(0); PG8_MMA(0, 0, At, B0); PG8_BAR; PG8_SCHED;
            PG8_LDB(B1, 1, 1); PG8_STAGE(PG8_SB(1, 0), b3, voffB);
            PG8_BAR; PG8_WAIT_L(0); PG8_MMA(0, 1, At, B1); PG8_BAR;
            PG8_LDA(At, 1, 1); PG8_STAGE(PG8_SA(1, 0), a3, voffA);
            PG8_BAR; PG8_WAIT_L(0); PG8_MMA(1, 0, At, B0); PG8_BAR; PG8_SCHED;
            PG8_STAGE(PG8_SB(1, 1), b3 + hstep, voffB);
            PG8_WAIT_V(6); PG8_BAR; PG8_MMA(1, 1, At, B1); PG8_BAR;
            }
        }
        if constexpr (ALIGN_EPI) { if (wr == 0) PG8_BAR; }
        if constexpr (!Epi::AFTER_DRAIN) { E(acc, cur, wr, wc, fr, fq); S.done(cur); }
        if (!has_next) break;
#pragma unroll
        for (int a = 0; a < 2; ++a)
#pragma unroll
            for (int b = 0; b < 2; ++b)
#pragma unroll
                for (int m = 0; m < 4; ++m)
#pragma unroll
                    for (int n = 0; n < 2; ++n) acc[a][b][m][n] = (f32x4){0.f, 0.f, 0.f, 0.f};
        cur = nxt; cA = nA; cB = nB; ++ui;
        if constexpr (ALIGN_EPI) { if (wr == 1) PG8_BAR; }
    }
    PG8_WAIT_V(0);
    if constexpr (!ALIGN_EPI) { if (wr == 0) PG8_BAR; }
    PG8_BAR;
    if constexpr (Epi::AFTER_DRAIN) { E.fused(acc, cur, wr, wc, fr, fq, lds, wid, lane); S.done(cur); }
#undef PG8_SA
#undef PG8_SB
#undef PG8_STAGE
#undef PG8_LDA
#undef PG8_LDB
#undef PG8_MMA
#undef PG8_WAIT_V
#undef PG8_WAIT_L
#undef PG8_BAR
#undef PG8_SCHED
}
}

#define LAS __attribute__((address_space(3)))
using pg8::f32x4; using pg8::u32x4; using pg8::bf16_t; using pg8::bf16x8; using pg8::Unit;
typedef float f32x2 __attribute__((ext_vector_type(2)));
typedef __bf16 bf16x2_t __attribute__((ext_vector_type(2)));
typedef unsigned u32x2 __attribute__((ext_vector_type(2)));
constexpr int DM = 1024, DFF = 2816, NFF2 = 5632, NIN = 1280, PED = 256;
constexpr int MP = 65536, MS = 2048, MT = MP + MS;
constexpr int NB = 32, SEQ = 2048, DSEQ = 64, NLAYER = 2;
constexpr float EPS = 1e-6f, LOG2E = 1.4426950408889634f;
constexpr size_t MiB = 1u << 20;
constexpr size_t WL_FFA_IN = 0, WL_FFA_OUT = 11 * MiB, WL_IN = WL_FFA_OUT + 5 * MiB + MiB / 2, WL_OUT = WL_IN + 2 * MiB + MiB / 2, WL_FFB_IN = WL_OUT + 2 * MiB,
                 WL_FFB_OUT = WL_FFB_IN + 11 * MiB, WL_PEG = WL_FFB_OUT + 5 * MiB + MiB / 2, WL_PEU = WL_PEG + 2 * MiB, WL_POOL = WL_PEU + MiB / 2, WL_STRIDE = 41 * MiB;
static_assert(WL_POOL + 131072 <= WL_STRIDE, "weights map");
constexpr size_t WS_W = 0, WS_XB = 82 * MiB, WS_ACT = 214 * MiB, WS_Z = WS_ACT, WS_MIX = WS_ACT + 165 * MiB, WS_U = WS_ACT, WS_PB = 577 * MiB, WS_SSQ = 643 * MiB, WS_ROPE = 646 * MiB, WS_XB2 = 647 * MiB, WS_U2 = 779 * MiB, WS_END = 911 * MiB;
static_assert((size_t)MT * DM * 2 == 132 * MiB && (size_t)MT * DFF * 2 == 363 * MiB && (size_t)MT * NIN * 2 == 165 * MiB && (size_t)2 * MT * PED * 2 == 66 * MiB, "buffer sizes");
constexpr size_t O_Y = 0, O_KP = (size_t)MT * DM, O_VP = O_KP + 1048576, O_UP = O_VP + 1048576, O_KS = O_UP + 491520, O_VS = O_KS + 1048576, O_US = O_VS + 1048576, O_END = O_US + 491520;

struct Params {
    const float* in[24]; float* out; unsigned char* ws;
};
enum { I_XP = 0, I_XS, I_PP, I_PS, I_CK, I_CV, I_SP, I_NFFA, I_WFFA_IN, I_WFFA_OUT, I_NMIX, I_WIN, I_QN, I_KN, I_SINK, I_WPOOL, I_PSCALE, I_WOUT, I_NFFB, I_WFFB_IN, I_WFFB_OUT, I_NPE, I_WPEG, I_WPEU };

__device__ __forceinline__ unsigned pk2(float lo, float hi) { f32x2 v = {lo, hi}; bf16x2_t b = __builtin_convertvector(v, bf16x2_t); return __builtin_bit_cast(unsigned, b); }
__device__ __forceinline__ float bflo(unsigned w) { return __uint_as_float(w << 16); }
__device__ __forceinline__ float bfhi(unsigned w) { return __uint_as_float(w & 0xffff0000u); }
__device__ __forceinline__ float rstd_of(const float* ssq, int row) { return __builtin_amdgcn_rsqf(ssq[row] * (1.0f / 1024.0f) + EPS); }
__device__ __forceinline__ float silu_f(float g) { return g * __builtin_amdgcn_rcpf(1.0f + __builtin_amdgcn_exp2f(-LOG2E * g)); }
__device__ __forceinline__ float sigm_f(float g) { return __builtin_amdgcn_rcpf(1.0f + __builtin_amdgcn_exp2f(-LOG2E * g)); }
__device__ __forceinline__ float wave_sum(float v) {
#pragma unroll
    for (int o = 1; o < 64; o <<= 1) v += __shfl_xor(v, o);
    return v;
}

struct EpiSwiglu {
    static constexpr bool PERM = true, AFTER_DRAIN = false;
    bf16_t* act; const float* ssq;
    __device__ __forceinline__ void operator()(const f32x4 (&acc)[2][2][4][2], const Unit& u, int wr, int wc, int fr, int fq) const {
        const int row0 = u.pm * 256 + wr * 64 + fr, col0 = u.pn * 128 + wc * 32 + 8 * fq;
#pragma unroll
        for (int ai = 0; ai < 2; ++ai)
#pragma unroll
            for (int m = 0; m < 4; ++m) {
                const int row = row0 + ai * 128 + m * 16; const float rs = rstd_of(ssq, row);
                const f32x4 g0 = acc[ai][0][m][0] * rs, g1 = acc[ai][0][m][1] * rs, u0 = acc[ai][1][m][0] * rs, u1 = acc[ai][1][m][1] * rs;
                u32x4 w;
                w.x = pk2(silu_f(g0[0]) * u0[0], silu_f(g0[1]) * u0[1]); w.y = pk2(silu_f(g0[2]) * u0[2], silu_f(g0[3]) * u0[3]);
                w.z = pk2(silu_f(g1[0]) * u1[0], silu_f(g1[1]) * u1[1]); w.w = pk2(silu_f(g1[2]) * u1[2], silu_f(g1[3]) * u1[3]);
                *(u32x4*)(act + (size_t)row * DFF + col0) = w;
            }
    }
};
struct EpiStore {
    static constexpr bool PERM = true, AFTER_DRAIN = false;
    bf16_t* O; int ldc; const float* ssq;
    __device__ __forceinline__ void operator()(const f32x4 (&acc)[2][2][4][2], const Unit& u, int wr, int wc, int fr, int fq) const {
        const int row0 = u.pm * 256 + wr * 64 + fr, col0 = u.pn * 256 + wc * 32 + 8 * fq;
#pragma unroll
        for (int ai = 0; ai < 2; ++ai)
#pragma unroll
            for (int m = 0; m < 4; ++m) {
                const int row = row0 + ai * 128 + m * 16; const float rs = ssq ? rstd_of(ssq, row) : 1.0f;
#pragma unroll
                for (int bj = 0; bj < 2; ++bj) {
                    const f32x4 v0 = acc[ai][bj][m][0] * rs, v1 = acc[ai][bj][m][1] * rs;
                    u32x4 w; w.x = pk2(v0[0], v0[1]); w.y = pk2(v0[2], v0[3]); w.z = pk2(v1[0], v1[1]); w.w = pk2(v1[2], v1[3]);
                    *(u32x4*)(O + (size_t)row * ldc + col0 + bj * 128) = w;
                }
            }
    }
};
template <int MODE> struct EpiResid {
    static constexpr bool PERM = true, AFTER_DRAIN = false;
    const bf16_t* xi; bf16_t* xo; float* yout; float* ssq_next; float scale; const bf16_t* U; const float* ssq_cur;
    __device__ __forceinline__ void operator()(const f32x4 (&acc)[2][2][4][2], const Unit& u, int wr, int wc, int fr, int fq) const {
        const int row0 = u.pm * 256 + wr * 64 + fr, col0 = u.pn * 256 + wc * 32 + 8 * fq;
#pragma unroll
        for (int ai = 0; ai < 2; ++ai)
#pragma unroll
            for (int m = 0; m < 4; ++m) {
                const int row = row0 + ai * 128 + m * 16; const size_t off = (size_t)row * DM + col0;
                const float rs = (MODE == 1) ? rstd_of(ssq_cur, row) : 0.f; float ss = 0.f;
#pragma unroll
                for (int bj = 0; bj < 2; ++bj) {
                    const u32x4 xw = *(const u32x4*)(xi + off + bj * 128);
                    f32x4 a0 = acc[ai][bj][m][0], a1 = acc[ai][bj][m][1];
                    if (MODE == 1) {
                        const u32x4 uu = *(const u32x4*)(U + off + bj * 128);
                        a0[0] = sigm_f(a0[0] * rs) * bflo(uu.x); a0[1] = sigm_f(a0[1] * rs) * bfhi(uu.x); a0[2] = sigm_f(a0[2] * rs) * bflo(uu.y); a0[3] = sigm_f(a0[3] * rs) * bfhi(uu.y);
                        a1[0] = sigm_f(a1[0] * rs) * bflo(uu.z); a1[1] = sigm_f(a1[1] * rs) * bfhi(uu.z); a1[2] = sigm_f(a1[2] * rs) * bflo(uu.w); a1[3] = sigm_f(a1[3] * rs) * bfhi(uu.w);
                    } else { a0 = a0 * scale; a1 = a1 * scale; }
                    const f32x4 v0 = (f32x4){bflo(xw.x), bfhi(xw.x), bflo(xw.y), bfhi(xw.y)} + a0, v1 = (f32x4){bflo(xw.z), bfhi(xw.z), bflo(xw.w), bfhi(xw.w)} + a1;
                    if (yout) { *(f32x4*)(yout + off + bj * 128) = v0; *(f32x4*)(yout + off + bj * 128 + 4) = v1; }
                    else {
                        u32x4 w; w.x = pk2(v0[0], v0[1]); w.y = pk2(v0[2], v0[3]); w.z = pk2(v1[0], v1[1]); w.w = pk2(v1[2], v1[3]);
                        *(u32x4*)(xo + off + bj * 128) = w;
                        ss += (v0[0] * v0[0] + v0[1] * v0[1]) + (v0[2] * v0[2] + v0[3] * v0[3]) + (v1[0] * v1[0] + v1[1] * v1[1]) + (v1[2] * v1[2] + v1[3] * v1[3]);
                    }
                }
                if (!yout) { ss += __shfl_xor(ss, 16); ss += __shfl_xor(ss, 32);
                    if (fq == 0) __hip_atomic_fetch_add(ssq_next + row, ss, __ATOMIC_RELAXED, __HIP_MEMORY_SCOPE_AGENT); }
                if (m & 1) asm volatile("" ::: "memory");
            }
    }
};

__device__ __forceinline__ void transpose_item(const float* W, int K, int N, bf16_t* WT, const float* gk, int mode, LAS float* scr, int item, int lane) {
    const int nblk = N / 32, kb = item / nblk, nb = item % nblk, k0 = 64 * kb, n0 = 32 * nb;
    const int sc = (mode == 1) ? (((n0 >> 7) & 1) * DFF + (n0 >> 8) * 128 + (n0 & 127)) : n0;
#pragma unroll 8
    for (int i = 0; i < 32; ++i) { const int kk = 2 * i + (lane >> 5); const float gv = gk ? gk[k0 + kk] : 1.0f; scr[kk * 33 + (lane & 31)] = W[(size_t)(k0 + kk) * N + sc + (lane & 31)] * gv; }
    asm volatile("s_waitcnt lgkmcnt(0)" ::: "memory");
    const int c = lane & 7;
#pragma unroll
    for (int j = 0; j < 4; ++j) { const int n = (lane >> 3) + 8 * j; const LAS float* s = scr + (8 * c) * 33 + n;
        u32x4 o; o.x = pk2(s[0 * 33], s[1 * 33]); o.y = pk2(s[2 * 33], s[3 * 33]); o.z = pk2(s[4 * 33], s[5 * 33]); o.w = pk2(s[6 * 33], s[7 * 33]);
        *(u32x4*)(WT + (size_t)(n0 + n) * K + k0 + 8 * c) = o; }
    asm volatile("s_waitcnt lgkmcnt(0)" ::: "memory");
}
__device__ __forceinline__ float rope_inv(int i) {
    return i == 0 ? 1.0f : i == 1 ? 0.1939227432012558f : i == 2 ? 0.03760603070259094f : i == 3 ? 0.007292664609849453f : i == 4 ? 0.0014142135623842478f : i == 5 ? 0.00027424818836152554f : i == 6 ? 5.3182957344688475e-05f : 1.0313385246263351e-05f;
}
__device__ __forceinline__ void sincos_d(float angf, float& c, float& s) {
    const double a = (double)angf; const double n = __builtin_rint(a * 0.63661977236758134308);
    const double r = __builtin_fma(-n, 1.5707963267948966192, a) - n * 6.123233995736766e-17; const double r2 = r * r;
    double sp = -7.6471637318198164759e-13; sp = sp * r2 + 1.6059043836821614599e-10; sp = sp * r2 - 2.5052108385441718775e-8; sp = sp * r2 + 2.7557319223985890653e-6; sp = sp * r2 - 1.9841269841269841270e-4; sp = sp * r2 + 8.3333333333333333333e-3; sp = sp * r2 - 1.6666666666666666667e-1;
    const double sn = r + r * r2 * sp;
    double cp = 4.7794773323873852974e-14; cp = cp * r2 - 1.1470745597729724714e-11; cp = cp * r2 + 2.0876756987868098979e-9; cp = cp * r2 - 2.7557319223985890653e-7; cp = cp * r2 + 2.4801587301587301587e-5; cp = cp * r2 - 1.3888888888888888889e-3; cp = cp * r2 + 4.1666666666666666667e-2; cp = cp * r2 - 0.5;
    const double cs = 1.0 + r2 * cp;
    const int q = ((int)n) & 3;
    const double cc = (q == 0) ? cs : (q == 1) ? -sn : (q == 2) ? -cs : sn;
    const double ss = (q == 0) ? sn : (q == 1) ? cs : (q == 2) ? -sn : -cs;
    c = (float)cc; s = (float)ss;
}
__device__ __forceinline__ void prologue(const Params& p, LAS unsigned char* L) {
    const int tid = threadIdx.x, lane = tid & 63, wave = __builtin_amdgcn_readfirstlane(tid >> 6);
    const int G = gridDim.x, gw = blockIdx.x * 8 + wave, NGW = G * 8; const int gt = blockIdx.x * 512 + tid, NGT = G * 512;
    LAS float* scr = (LAS float*)(L + wave * 16384);
    unsigned char* ws = p.ws;
    constexpr int I_FI = 16 * 176, I_FO = 44 * 32, I_IN = 16 * 40, I_O = 16 * 32, I_PG = 16 * 32, I_PU = 4 * 32;
    constexpr int PER_LAYER = 2 * I_FI + 2 * I_FO + I_IN + I_O + I_PG + I_PU;
    for (int it = gw; it < NLAYER * PER_LAYER; it += NGW) {
        const int l = it / PER_LAYER; int r = it % PER_LAYER; unsigned char* wl = ws + WS_W + (size_t)l * WL_STRIDE;
        if (r < I_FI) { transpose_item(p.in[I_WFFA_IN] + (size_t)l * DM * NFF2, DM, NFF2, (bf16_t*)(wl + WL_FFA_IN), p.in[I_NFFA] + l * DM, 1, scr, r, lane); continue; } r -= I_FI;
        if (r < I_FI) { transpose_item(p.in[I_WFFB_IN] + (size_t)l * DM * NFF2, DM, NFF2, (bf16_t*)(wl + WL_FFB_IN), p.in[I_NFFB] + l * DM, 1, scr, r, lane); continue; } r -= I_FI;
        if (r < I_FO) { transpose_item(p.in[I_WFFA_OUT] + (size_t)l * DFF * DM, DFF, DM, (bf16_t*)(wl + WL_FFA_OUT), nullptr, 0, scr, r, lane); continue; } r -= I_FO;
        if (r < I_FO) { transpose_item(p.in[I_WFFB_OUT] + (size_t)l * DFF * DM, DFF, DM, (bf16_t*)(wl + WL_FFB_OUT), nullptr, 0, scr, r, lane); continue; } r -= I_FO;
        if (r < I_IN) { transpose_item(p.in[I_WIN] + (size_t)l * DM * NIN, DM, NIN, (bf16_t*)(wl + WL_IN), p.in[I_NMIX] + l * DM, 0, scr, r, lane); continue; } r -= I_IN;
        if (r < I_O) { transpose_item(p.in[I_WOUT] + (size_t)l * DM * DM, DM, DM, (bf16_t*)(wl + WL_OUT), nullptr, 0, scr, r, lane); continue; } r -= I_O;
        if (r < I_PG) { transpose_item(p.in[I_WPEG] + (size_t)l * DM * DM, DM, DM, (bf16_t*)(wl + WL_PEG), p.in[I_NPE] + l * DM, 0, scr, r, lane); continue; } r -= I_PG;
        transpose_item(p.in[I_WPEU] + (size_t)l * PED * DM, PED, DM, (bf16_t*)(wl + WL_PEU), nullptr, 0, scr, r, lane);
    }
    for (int t = gt; t < NLAYER * 4 * 128 * 16; t += NGT) {
        const int ko = t & 15, n = (t >> 4) & 127, g = (t >> 11) & 3, l = t >> 13;
        const float* src = p.in[I_WPOOL] + ((size_t)(l * 4 + g) * 128 + 8 * ko) * 128 + n; const float sc = p.in[I_PSCALE][l * 512 + g * 128 + n];
        u32x4 o; o.x = pk2(src[0] * sc, src[128] * sc); o.y = pk2(src[256] * sc, src[384] * sc); o.z = pk2(src[512] * sc, src[640] * sc); o.w = pk2(src[768] * sc, src[896] * sc);
        *(u32x4*)((bf16_t*)(ws + WS_W + (size_t)l * WL_STRIDE + WL_POOL) + ((size_t)g * 128 + n) * 128 + 8 * ko) = o;
    }
    bf16_t* xb = (bf16_t*)(ws + WS_XB); float* ssq = (float*)(ws + WS_SSQ);
    for (int m = gw; m < MT; m += NGW) {
        const float* xr = (m < MP) ? p.in[I_XP] + (size_t)m * DM : p.in[I_XS] + (size_t)(m - MP) * DM;
        f32x4 v[4]; float s = 0.f;
#pragma unroll
        for (int j = 0; j < 4; ++j) { v[j] = *((const f32x4*)xr + lane + 64 * j); s += (v[j][0] * v[j][0] + v[j][1] * v[j][1]) + (v[j][2] * v[j][2] + v[j][3] * v[j][3]); }
        s = wave_sum(s);
#pragma unroll
        for (int j = 0; j < 4; ++j) { u32x2 o; o.x = pk2(v[j][0], v[j][1]); o.y = pk2(v[j][2], v[j][3]); *((u32x2*)(xb + (size_t)m * DM) + lane + 64 * j) = o; }
        if (lane == 0) ssq[m] = s;
    }
    for (int t = gt; t < 8 * MT / 4; t += NGT) *((f32x4*)(ssq + MT) + t) = (f32x4){0.f, 0.f, 0.f, 0.f};
    bf16_t* pb = (bf16_t*)(ws + WS_PB);
    for (int t = gt; t < NLAYER * MT * 32; t += NGT) {
        const int o8 = t & 31, m = (t >> 5) % MT, l = (t >> 5) / MT;
        const float* src = ((m < MP) ? p.in[I_PP] + ((size_t)l * MP + m) * PED : p.in[I_PS] + ((size_t)l * MS + (m - MP)) * PED) + 8 * o8;
        const f32x4 a = *(const f32x4*)src, b = *(const f32x4*)(src + 4);
        u32x4 o; o.x = pk2(a[0], a[1]); o.y = pk2(a[2], a[3]); o.z = pk2(b[0], b[1]); o.w = pk2(b[2], b[3]);
        *(u32x4*)(pb + ((size_t)l * MT + m) * PED + 8 * o8) = o;
    }
    float* rope = (float*)(ws + WS_ROPE);
    for (int t = gt; t < 2112 * 8; t += NGT) {
        const int i = t & 7, idx = t >> 3, pos = idx < 2048 ? idx : 4096 + idx - 2048;
        const float ang = (float)pos * rope_inv(i); float c, s; sincos_d(ang, c, s);
        rope[idx * 16 + i] = c; rope[idx * 16 + 8 + i] = s;
    }
}

constexpr int KROW = 72, DROW = 520;
constexpr int LK_OFF = 0, LV_OFF = 2 * 192 * KROW * 2, LMIX_END = 2 * LV_OFF;
static_assert(LMIX_END <= 131072 && 64 * DROW * 2 <= 131072, "mixer LDS");
typedef short v4i16_t __attribute__((ext_vector_type(4)));
__device__ __forceinline__ u32x2 tr_read(const LAS unsigned char* q) { const v4i16_t r = __builtin_amdgcn_ds_read_tr16_b64_v4i16((LAS v4i16_t*)q); return __builtin_bit_cast(u32x2, r); }
__device__ __forceinline__ bf16x8 pack8(const float* v) { u32x4 w; w.x = pk2(v[0], v[1]); w.y = pk2(v[2], v[3]); w.z = pk2(v[4], v[5]); w.w = pk2(v[6], v[7]); return __builtin_bit_cast(bf16x8, w); }
__device__ __forceinline__ void unpack8(u32x4 w, float* v) { v[0] = bflo(w.x); v[1] = bfhi(w.x); v[2] = bflo(w.y); v[3] = bfhi(w.y); v[4] = bflo(w.z); v[5] = bfhi(w.z); v[6] = bflo(w.w); v[7] = bfhi(w.w); }

template <int W> __device__ __forceinline__ void pool_stage(const Params& p, const bf16_t* z, int layer, bool is_s, int b, int c, int tok0, int g, int half, int lane, LAS unsigned char* L) {
    const int oct = lane & 15, tq = lane >> 4, c0 = 128 * g + 8 * oct, t0 = 32 * half + 8 * tq;
    const float* sp = p.in[I_SP] + ((size_t)layer * NB + b) * 15 * 512 + c0;
    u32x4 raw[W + 7];
#pragma unroll
    for (int j = 0; j < W + 7; ++j) {
        const int t = t0 - (W - 1) + j;
        u32x4 r = {0u, 0u, 0u, 0u};
        if (t >= 0 || (!is_s && c * 64 + t >= 0)) r = *(const u32x4*)(z + (size_t)(tok0 + t) * NIN + 768 + c0);
        else if (is_s) { const f32x4 a = *(const f32x4*)(sp + (15 + t) * 512), bb = *(const f32x4*)(sp + (15 + t) * 512 + 4); r.x = pk2(a[0], a[1]); r.y = pk2(a[2], a[3]); r.z = pk2(bb[0], bb[1]); r.w = pk2(bb[2], bb[3]); }
        raw[j] = r;
    }
    float sum[8];
#pragma unroll
    for (int i = 0; i < 8; ++i) sum[i] = 0.f;
#pragma unroll
    for (int j = 0; j < W - 1; ++j) { float u[8]; unpack8(raw[j], u);
#pragma unroll
        for (int i = 0; i < 8; ++i) sum[i] += u[i]; }
#pragma unroll
    for (int ti = 0; ti < 8; ++ti) {
        const int t = t0 + ti; float u[8], ul[8], d[8]; unpack8(raw[W - 1 + ti], u); unpack8(raw[ti], ul);
        const int cnt = is_s ? W : min(c * 64 + t + 1, W); const float rc = 1.0f / (float)cnt;
#pragma unroll
        for (int i = 0; i < 8; ++i) { sum[i] += u[i]; d[i] = sum[i] * rc - u[i]; sum[i] -= ul[i]; }
        *(LAS bf16x8*)(L + (t * DROW + c0) * 2) = pack8(d);
        if (t >= 49 && (is_s || c == 31)) { float* o = p.out + (is_s ? O_US : O_UP) + (((size_t)layer * NB + b) * 15 + (t - 49)) * 512 + c0;
            *(f32x4*)o = (f32x4){u[0], u[1], u[2], u[3]}; *(f32x4*)(o + 4) = (f32x4){u[4], u[5], u[6], u[7]}; }
    }
}

__device__ __forceinline__ void mixer_unit(const Params& p, int layer, int cu, LAS unsigned char* L) {
    int tid_ = threadIdx.x; asm volatile("" : "+v"(tid_));
    const int tid = tid_, lane = tid & 63, wave = __builtin_amdgcn_readfirstlane(tid >> 6);
    const bool is_s = cu >= 1024;
    const int b = is_s ? cu - 1024 : (cu >> 5), c = is_s ? 0 : (cu & 31);
    const int tok0 = is_s ? MP + b * 64 : b * SEQ + c * 64;
    const int kstart = is_s ? 0 : (c >= 2 ? 0 : (2 - c) * 64);
    const int pidx0 = is_s ? 2048 : c * 64;
    const bf16_t* z = (const bf16_t*)(p.ws + WS_Z); bf16_t* mix = (bf16_t*)(p.ws + WS_MIX);
    const float* rope = (const float*)(p.ws + WS_ROPE);
    const int q16 = lane & 15, quad = lane >> 4, h = wave, kvhq = h >> 2;
    const int piece = tid & 31, rsub = tid >> 5, sub = piece & 7, kvh = (piece >> 3) & 1; const bool isK = piece < 16;
    const int klo = is_s ? 128 : kstart, npass = (192 - klo) >> 4;
    u32x4 raw[12], qraw[4][2];
#pragma unroll
    for (int ps = 0; ps < 12; ++ps) if (ps < npass) raw[ps] = *(const u32x4*)(z + (size_t)(tok0 + klo + 16 * ps + rsub - 128) * NIN + 512 + piece * 8);
    if (is_s) {
#pragma unroll 1
        for (int ps = 0; ps < 8; ++ps) {
            const int kk = 16 * ps + rsub; const size_t o = ((((size_t)layer * NB + b) * 128 + kk) * 2 + kvh) * 64 + sub * 8;
            const float* src = (isK ? p.in[I_CK] : p.in[I_CV]) + o;
            const f32x4 a0 = *(const f32x4*)src, a1 = *(const f32x4*)(src + 4);
            float v[8] = {a0[0], a0[1], a0[2], a0[3], a1[0], a1[1], a1[2], a1[3]};
            *(LAS bf16x8*)(L + (isK ? LK_OFF : LV_OFF) + ((kvh * 192 + kk) * KROW + sub * 8) * 2) = pack8(v);
            if (kk >= 64) { float* dst = p.out + (isK ? O_KS : O_VS) + ((((size_t)layer * NB + b) * 128 + (kk - 64)) * 2 + kvh) * 64 + sub * 8; *(f32x4*)dst = a0; *(f32x4*)(dst + 4) = a1; }
        }
    }
    {
        float kn[8];
#pragma unroll
        for (int i = 0; i < 8; ++i) kn[i] = p.in[I_KN][layer * 64 + sub * 8 + i];
#pragma unroll
        for (int ps = 0; ps < 12; ++ps) if (ps < npass) {
            const int kk = klo + 16 * ps + rsub;
            float v[8]; unpack8(raw[ps], v);
            float ss = 0.f;
#pragma unroll
            for (int i = 0; i < 8; ++i) ss += v[i] * v[i];
            ss += __shfl_xor(ss, 1); ss += __shfl_xor(ss, 2); ss += __shfl_xor(ss, 4);
            const float rs = __builtin_amdgcn_rsqf(ss * (1.0f / 64.0f) + EPS);
            float pv[8];
#pragma unroll
            for (int i = 0; i < 8; ++i) { if (isK) v[i] = v[i] * rs * kn[i]; pv[i] = __shfl_xor(v[i], 1); }
            if (isK && sub < 2) {
                const float* rt = rope + (size_t)(pidx0 + kk - 128) * 16;
                const f32x4 c0 = *(const f32x4*)rt, c1 = *(const f32x4*)(rt + 4), s0 = *(const f32x4*)(rt + 8), s1 = *(const f32x4*)(rt + 12);
#pragma unroll
                for (int i = 0; i < 8; ++i) { const float cs = i < 4 ? c0[i & 3] : c1[i & 3], sn = i < 4 ? s0[i & 3] : s1[i & 3]; v[i] = (sub == 0) ? v[i] * cs - pv[i] * sn : v[i] * cs + pv[i] * sn; }
            }
            *(LAS bf16x8*)(L + (isK ? LK_OFF : LV_OFF) + ((kvh * 192 + kk) * KROW + sub * 8) * 2) = pack8(v);
            int orow = -1;
            if (is_s) orow = kk - 64; else if (c >= 30 && kk >= 128) orow = (c - 30) * 64 + (kk - 128);
            if (orow >= 0) {
                float* dst = p.out + (isK ? (is_s ? O_KS : O_KP) : (is_s ? O_VS : O_VP)) + ((((size_t)layer * NB + b) * 128 + orow) * 2 + kvh) * 64 + sub * 8;
                *(f32x4*)dst = (f32x4){v[0], v[1], v[2], v[3]}; *(f32x4*)(dst + 4) = (f32x4){v[4], v[5], v[6], v[7]};
            }
        }
    }
#pragma unroll
    for (int qb = 0; qb < 4; ++qb) { const bf16_t* qp = z + (size_t)(tok0 + 16 * qb + q16) * NIN + h * 64 + 8 * quad; qraw[qb][0] = *(const u32x4*)qp; qraw[qb][1] = *(const u32x4*)(qp + 32); }
    bf16x8 qf[4][2];
    {
        float gq0[8], gq1[8];
#pragma unroll
        for (int i = 0; i < 8; ++i) { gq0[i] = p.in[I_QN][layer * 64 + 8 * quad + i]; gq1[i] = p.in[I_QN][layer * 64 + 32 + 8 * quad + i]; }
        constexpr float QS = 0.125f * LOG2E;
#pragma unroll
        for (int qb = 0; qb < 4; ++qb) {
            float v0[8], v1[8]; unpack8(qraw[qb][0], v0); unpack8(qraw[qb][1], v1);
            float ss = 0.f;
#pragma unroll
            for (int i = 0; i < 8; ++i) ss += v0[i] * v0[i] + v1[i] * v1[i];
            ss += __shfl_xor(ss, 16); ss += __shfl_xor(ss, 32);
            const float rs = __builtin_amdgcn_rsqf(ss * (1.0f / 64.0f) + EPS);
            float pv[8];
#pragma unroll
            for (int i = 0; i < 8; ++i) { v0[i] = v0[i] * rs * gq0[i]; v1[i] = v1[i] * rs * gq1[i] * QS; pv[i] = __shfl_xor(v0[i], 16); }
            if (quad < 2) {
                const float* rt = rope + (size_t)(pidx0 + 16 * qb + q16) * 16;
                const f32x4 c0 = *(const f32x4*)rt, c1 = *(const f32x4*)(rt + 4), s0 = *(const f32x4*)(rt + 8), s1 = *(const f32x4*)(rt + 12);
#pragma unroll
                for (int i = 0; i < 8; ++i) { const float cs = i < 4 ? c0[i & 3] : c1[i & 3], sn = i < 4 ? s0[i & 3] : s1[i & 3]; v0[i] = (quad == 0) ? v0[i] * cs - pv[i] * sn : v0[i] * cs + pv[i] * sn; }
            }
#pragma unroll
            for (int i = 0; i < 8; ++i) v0[i] *= QS;
            qf[qb][0] = pack8(v0); qf[qb][1] = pack8(v1);
        }
    }
    __syncthreads();
    {
        const float sinkv = p.in[I_SINK][layer * 8 + h] * LOG2E;
        const LAS unsigned char* Kb = L + LK_OFF + ((kvhq * 192 + q16) * KROW + 8 * quad) * 2;
        const LAS unsigned char* Vb = L + LV_OFF + ((kvhq * 192 + 4 * quad + (q16 >> 2)) * KROW + 4 * (q16 & 3)) * 2;
#pragma unroll
        for (int pr = 0; pr < 2; ++pr) {
            f32x4 s[2][12];
#pragma unroll
            for (int kt = 0; kt < 12; ++kt) {
                if (16 * kt >= kstart) {
                    const bf16x8 k0 = *(const LAS bf16x8*)(Kb + kt * 16 * KROW * 2), k1 = *(const LAS bf16x8*)(Kb + kt * 16 * KROW * 2 + 64);
#pragma unroll
                    for (int e = 0; e < 2; ++e) { s[e][kt] = __builtin_amdgcn_mfma_f32_16x16x32_bf16(k0, qf[2 * pr + e][0], (f32x4){0.f, 0.f, 0.f, 0.f}, 0, 0, 0);
                        s[e][kt] = __builtin_amdgcn_mfma_f32_16x16x32_bf16(k1, qf[2 * pr + e][1], s[e][kt], 0, 0, 0); }
                } else { s[0][kt] = (f32x4){-1e30f, -1e30f, -1e30f, -1e30f}; s[1][kt] = s[0][kt]; }
            }
            float inv[2];
#pragma unroll
            for (int e = 0; e < 2; ++e) {
                float mx = sinkv;
#pragma unroll
                for (int kt = 0; kt < 12; ++kt) mx = fmaxf(fmaxf(mx, fmaxf(s[e][kt][0], s[e][kt][1])), fmaxf(s[e][kt][2], s[e][kt][3]));
                mx = fmaxf(mx, __shfl_xor(mx, 16)); mx = fmaxf(mx, __shfl_xor(mx, 32));
                float l = 0.f;
#pragma unroll
                for (int kt = 0; kt < 12; ++kt)
#pragma unroll
                    for (int j = 0; j < 4; ++j) { s[e][kt][j] = __builtin_amdgcn_exp2f(s[e][kt][j] - mx); l += s[e][kt][j]; }
                l += __shfl_xor(l, 16); l += __shfl_xor(l, 32);
                l += __builtin_amdgcn_exp2f(sinkv - mx);
                inv[e] = 1.0f / l;
            }
            f32x4 o[2][4];
#pragma unroll
            for (int e = 0; e < 2; ++e)
#pragma unroll
                for (int dt = 0; dt < 4; ++dt) o[e][dt] = (f32x4){0.f, 0.f, 0.f, 0.f};
#pragma unroll
            for (int si = 0; si < 6; ++si) {
                if (32 * si >= kstart) {
                    bf16x8 pf[2];
#pragma unroll
                    for (int e = 0; e < 2; ++e) { u32x4 pw; pw.x = pk2(s[e][2 * si][0], s[e][2 * si][1]); pw.y = pk2(s[e][2 * si][2], s[e][2 * si][3]); pw.z = pk2(s[e][2 * si + 1][0], s[e][2 * si + 1][1]); pw.w = pk2(s[e][2 * si + 1][2], s[e][2 * si + 1][3]); pf[e] = __builtin_bit_cast(bf16x8, pw); }
#pragma unroll
                    for (int dt = 0; dt < 4; ++dt) {
                        const u32x2 a = tr_read(Vb + ((32 * si) * KROW + 16 * dt) * 2), bq = tr_read(Vb + ((32 * si + 16) * KROW + 16 * dt) * 2);
                        const u32x4 vw = {a.x, a.y, bq.x, bq.y}; const bf16x8 vf = __builtin_bit_cast(bf16x8, vw);
#pragma unroll
                        for (int e = 0; e < 2; ++e) o[e][dt] = __builtin_amdgcn_mfma_f32_16x16x32_bf16(vf, pf[e], o[e][dt], 0, 0, 0);
                    }
                }
            }
#pragma unroll
            for (int e = 0; e < 2; ++e) { const int row = tok0 + 16 * (2 * pr + e) + q16;
#pragma unroll
                for (int dt = 0; dt < 4; ++dt) { u32x2 w; w.x = pk2(o[e][dt][0] * inv[e], o[e][dt][1] * inv[e]); w.y = pk2(o[e][dt][2] * inv[e], o[e][dt][3] * inv[e]);
                    *(u32x2*)(mix + (size_t)row * DM + h * 64 + 16 * dt + 4 * quad) = w; } }
        }
    }
    __syncthreads();
    {
        const int g = wave >> 1, half = wave & 1;
        if (g == 0) pool_stage<2>(p, z, layer, is_s, b, c, tok0, g, half, lane, L);
        else if (g == 1) pool_stage<4>(p, z, layer, is_s, b, c, tok0, g, half, lane, L);
        else if (g == 2) pool_stage<8>(p, z, layer, is_s, b, c, tok0, g, half, lane, L);
        else pool_stage<16>(p, z, layer, is_s, b, c, tok0, g, half, lane, L);
    }
    __syncthreads();
    {
        const int g = wave >> 1, th = wave & 1;
        bf16x8 dfr[2][4];
#pragma unroll
        for (int tb = 0; tb < 2; ++tb)
#pragma unroll
            for (int ks = 0; ks < 4; ++ks) dfr[tb][ks] = *(const LAS bf16x8*)(L + ((32 * th + 16 * tb + q16) * DROW + 128 * g + 32 * ks + 8 * quad) * 2);
        const bf16_t* wp = (const bf16_t*)(p.ws + WS_W + (size_t)layer * WL_STRIDE + WL_POOL) + (size_t)g * 128 * 128;
#pragma unroll 2
        for (int nt = 0; nt < 8; ++nt) {
            bf16x8 wf[4];
#pragma unroll
            for (int ks = 0; ks < 4; ++ks) wf[ks] = *(const bf16x8*)(wp + (16 * nt + q16) * 128 + 32 * ks + 8 * quad);
#pragma unroll
            for (int tb = 0; tb < 2; ++tb) {
                f32x4 o = (f32x4){0.f, 0.f, 0.f, 0.f};
#pragma unroll
                for (int ks = 0; ks < 4; ++ks) o = __builtin_amdgcn_mfma_f32_16x16x32_bf16(wf[ks], dfr[tb][ks], o, 0, 0, 0);
                u32x2 ww; ww.x = pk2(o[0], o[1]); ww.y = pk2(o[2], o[3]);
                *(u32x2*)(mix + (size_t)(tok0 + 32 * th + 16 * tb + q16) * DM + 512 + 128 * g + 16 * nt + 4 * quad) = ww;
            }
        }
    }
    __syncthreads();
}

constexpr int LDS_BYTES = 131072 + 4096;
__global__ void __launch_bounds__(512, 2) hymba_fwd(Params p) {
    extern __shared__ __attribute__((aligned(16))) unsigned char lds_raw[];
    LAS unsigned char* L = (LAS unsigned char*)lds_raw;
    cg::grid_group grid = cg::this_grid();
#define PHASE_VARS size_t oz_ = 0; int ly = layer; asm volatile("" : "+s"(oz_), "+s"(ly)); unsigned char* ws = p.ws + oz_; bf16_t* xb = (bf16_t*)(ws + WS_XB); bf16_t* act = (bf16_t*)(ws + WS_ACT); bf16_t* zb = (bf16_t*)(ws + WS_Z); bf16_t* mixb = (bf16_t*)(ws + WS_MIX); bf16_t* ub = (bf16_t*)(ws + WS_U); \
        float* xres = p.out + O_Y; unsigned char* wl = ws + WS_W + (size_t)ly * WL_STRIDE; float* sq = (float*)(ws + WS_SSQ) + (size_t)ly * 4 * MT; (void)xb; (void)act; (void)zb; (void)mixb; (void)ub; (void)xres; (void)wl; (void)sq;
    const int G = gridDim.x, c = blockIdx.x;
    prologue(p, L);
    grid.sync();
#pragma unroll 1
    for (int layer = 0; layer < NLAYER; ++layer) {
        { PHASE_VARS pg8::Gemm g{ly == 0 ? xb : (const bf16_t*)(ws + WS_XB2), (const bf16_t*)(wl + WL_FFA_IN), MT, NFF2, DM}; pg8::StaticOrder S; S.init(MT, NFF2, G, c); EpiSwiglu E{act, sq};
          pg8::gemm_phase<EpiSwiglu, pg8::StaticOrder, true, true>(L, g, S, E); }
        grid.sync();
        { PHASE_VARS pg8::Gemm g{act, (const bf16_t*)(wl + WL_FFA_OUT), MT, DM, DFF}; pg8::StaticOrder S; S.init(MT, DM, G, c);
          EpiResid<0> E{ly == 0 ? xb : (const bf16_t*)(ws + WS_XB2), xb, nullptr, sq + MT, 0.5f, nullptr, nullptr};
          pg8::gemm_phase<EpiResid<0>, pg8::StaticOrder, true, true>(L, g, S, E); }
        grid.sync();
        { PHASE_VARS pg8::Gemm g{xb, (const bf16_t*)(wl + WL_IN), MT, NIN, DM}; pg8::StaticOrder S; S.init(MT, NIN, G, c); EpiStore E{zb, NIN, sq + MT};
          pg8::gemm_phase<EpiStore, pg8::StaticOrder, true, true>(L, g, S, E); }
        grid.sync();
#pragma unroll 1
        for (int cu = c; cu < 1056; cu += G) { const int un = (G == 256 && cu < 1024) ? ((cu & 255) << 2) + (cu >> 8) : cu; mixer_unit(p, layer, un, L); }
        grid.sync();
        { PHASE_VARS pg8::Gemm g{mixb, (const bf16_t*)(wl + WL_OUT), MT, DM, DM}; pg8::StaticOrder S; S.init(MT, DM, G, c);
          EpiResid<0> E{xb, xb, nullptr, sq + 2 * MT, 1.0f, nullptr, nullptr};
          pg8::gemm_phase<EpiResid<0>, pg8::StaticOrder, true, true>(L, g, S, E); }
        grid.sync();
        { PHASE_VARS pg8::Gemm g{xb, (const bf16_t*)(wl + WL_FFB_IN), MT, NFF2, DM}; pg8::StaticOrder S; S.init(MT, NFF2, G, c); EpiSwiglu E{act, sq + 2 * MT};
          pg8::gemm_phase<EpiSwiglu, pg8::StaticOrder, true, true>(L, g, S, E); }
        grid.sync();
        { PHASE_VARS pg8::Gemm g{act, (const bf16_t*)(wl + WL_FFB_OUT), MT, DM, DFF}; pg8::StaticOrder S; S.init(MT, DM, G, c);
          EpiResid<0> E{xb, xb, nullptr, sq + 3 * MT, 0.5f, nullptr, nullptr};
          pg8::gemm_phase<EpiResid<0>, pg8::StaticOrder, true, true>(L, g, S, E); }
        if (G == 256 ? c >= 32 : true) { PHASE_VARS pg8::Gemm g{(const bf16_t*)(ws + WS_PB) + (size_t)ly * MT * PED, (const bf16_t*)(wl + WL_PEU), MT, DM, PED}; pg8::StaticOrder S;
          if (G == 256) S.init(MT, DM, 224, c - 32); else S.init(MT, DM, G, c);
          EpiStore E{(bf16_t*)(ws + WS_U2), DM, nullptr};
          pg8::gemm_phase<EpiStore, pg8::StaticOrder, true, true>(L, g, S, E); }
        grid.sync();
        { PHASE_VARS pg8::Gemm g{xb, (const bf16_t*)(wl + WL_PEG), MT, DM, DM}; pg8::StaticOrder S; S.init(MT, DM, G, c);
          EpiResid<1> E{xb, (bf16_t*)(ws + WS_XB2), ly + 1 < NLAYER ? nullptr : xres, sq + 4 * MT, 1.0f, (const bf16_t*)(ws + WS_U2), sq + 3 * MT};
          pg8::gemm_phase<EpiResid<1>, pg8::StaticOrder, true, true>(L, g, S, E); }
        if (layer + 1 < NLAYER) grid.sync();
    }
}

extern "C" void kernel_launch(void* const* d_in, const int* in_sizes, int n_in, void* d_out, int out_size, void* d_ws, size_t ws_size, hipStream_t stream) {
    static int grid = 0;
    if (grid == 0) {
        if (n_in != 24 || in_sizes[0] != MP * DM || (size_t)out_size != O_END || ws_size < WS_END) { fprintf(stderr, "kernel_launch: unexpected shapes (n_in %d, in0 %d, out %d, ws %zu)\n", n_in, n_in > 0 ? in_sizes[0] : -1, out_size, ws_size); grid = -1; return; }
        int dev = 0, cus = 0, per_cu = 0;
        if (hipGetDevice(&dev) != hipSuccess || hipDeviceGetAttribute(&cus, hipDeviceAttributeMultiprocessorCount, dev) != hipSuccess) { grid = -1; return; }
        if (hipFuncSetAttribute((const void*)hymba_fwd, hipFuncAttributeMaxDynamicSharedMemorySize, LDS_BYTES) != hipSuccess) { fprintf(stderr, "kernel_launch: hipFuncSetAttribute failed\n"); grid = -1; return; }
        if (hipOccupancyMaxActiveBlocksPerMultiprocessor(&per_cu, (const void*)hymba_fwd, 512, LDS_BYTES) != hipSuccess || per_cu < 1) { fprintf(stderr, "kernel_launch: occupancy query says %d\n", per_cu); per_cu = 1; }
        (void)hipGetLastError();
        grid = cus * 1;
    }
    if (grid < 0) return;
    Params p{};
    for (int i = 0; i < 24; ++i) p.in[i] = (const float*)d_in[i];
    p.out = (float*)d_out; p.ws = (unsigned char*)d_ws;
    void* args[] = {&p};
    hipError_t e = hipLaunchCooperativeKernel((const void*)hymba_fwd, dim3(grid), dim3(512), args, LDS_BYTES, stream);
    if (e != hipSuccess) fprintf(stderr, "kernel_launch: cooperative launch failed: %s (grid %d)\n", hipGetErrorString(e), grid);
}
```

```cpp
#include <hip/hip_runtime.h>
#include <hip/hip_cooperative_groups.h>
#include <cstdio>
#include <cstdint>
namespace cg = cooperative_groups;
__device__ __forceinline__ int tid_of(int wv) { return wv * 64 + (int)__builtin_amdgcn_mbcnt_hi(~0u, __builtin_amdgcn_mbcnt_lo(~0u, 0u)); }
namespace pg8 {
#define PG8_LAS __attribute__((address_space(3)))
typedef unsigned short bf16_t;
typedef short bf16x8 __attribute__((ext_vector_type(8)));
typedef float f32x4 __attribute__((ext_vector_type(4)));
typedef unsigned u32x4 __attribute__((ext_vector_type(4)));
constexpr int BM = 256, BK = 64, HALF = 128, HTB = HALF * BK * 2  , STAGE_BYTES = 8 * HTB, NXCD = 8, WGM = 8;

__host__ __device__ __forceinline__ int lds_byte(int r, int c) { const int st = (r >> 4) * 2 + (c >> 5), rr = r & 15, cc = c & 31, ob = rr * 64 + cc * 2; return st * 1024 + (ob ^ (((ob >> 9) & 1) << 5)); }
__host__ __device__ __forceinline__ void stage_rc(int b, int& R, int& C) { const int st = b / 1024, sb = b % 1024, swz = sb ^ (((sb >> 9) & 1) << 5); R = (st >> 1) * 16 + swz / 64; C = (st & 1) * 32 + (swz % 64) / 2; }
__host__ __device__ __forceinline__ int perm32(int rho) { const int n = rho >> 4, i = rho & 15; return 8 * (i >> 2) + 4 * n + (i & 3); }

struct Unit { int pm, pn; };
struct Gemm { const bf16_t* A; const bf16_t* Bt; int M, N, K; };

struct StaticOrder {
    int nM, nN, nwg, G, c;
    __host__ __device__ void init(int M, int N, int G_, int c_) { nM = M / BM; nN = N / BM; nwg = nM * nN; G = G_; c = c_; }
    __host__ __device__ bool next(int i, Unit& u) const {
        const int L = i * G + c; if (L >= nwg) return false;
        int wgid = L; { const int q = nwg / NXCD, r = nwg % NXCD, xcd = wgid % NXCD, off = wgid / NXCD; wgid = (xcd < r ? xcd * (q + 1) : r * (q + 1) + (xcd - r) * q) + off; }
        const int nig = WGM * nN, gid = wgid / nig, fm = gid * WGM, gsz = (nM - fm) < WGM ? (nM - fm) : WGM;
        u.pm = fm + ((wgid % nig) % gsz); u.pn = (wgid % nig) / gsz; return true;
    }
    __device__ __forceinline__ void a_ready(const Unit&) const {}
    __device__ __forceinline__ void done(const Unit&) const {}
};
__device__ __forceinline__ unsigned cvt_pk_bf16(float lo, float hi) { unsigned r; asm volatile("v_cvt_pk_bf16_f32 %0, %1, %2" : "=v"(r) : "v"(lo), "v"(hi)); return r; }
typedef float f32x2 __attribute__((ext_vector_type(2)));
template <class Epi, class Sched, bool ALIGN_EPI = false, bool SP2 = false>
__device__ __forceinline__ void gemm_phase(PG8_LAS unsigned char* lds, const Gemm g, const Sched& S, const Epi& E, int wv) {
    int tid_ = tid_of(wv); asm volatile("" : "+v"(tid_));
    const int tid = tid_, wid = __builtin_amdgcn_readfirstlane(tid >> 6), lane = tid & 63, wr = wid >> 2, wc = wid & 3, fr = lane & 15, fq = lane >> 4;
    const int K = g.K, nt = K / BK;
    unsigned voffA[2], voffB[2];
#pragma unroll
    for (int i = 0; i < 2; ++i) { int R, C; stage_rc(tid * 16 + i * 8192, R, C); const int Rb = Epi::PERM ? ((R & ~31) + perm32(R & 31)) : R;
        voffA[i] = (unsigned)(R * K + C) * 2u; voffB[i] = (unsigned)(Rb * K + C) * 2u; }
    const size_t kstep = (size_t)(BK * 2);
    const size_t hstep = (size_t)HALF * K * 2;
    const size_t tstep = 2 * hstep;
    const unsigned ldsw = (unsigned)wid * 1024u;
    const int aoff = lds_byte(wr * 64 + fr, fq * 8), boff = lds_byte(wc * 32 + fr, fq * 8);
#define PG8_SA(b, h) (((b) * 2 + (h)) * HTB)
#define PG8_SB(b, h) ((4 + (b) * 2 + (h)) * HTB)
#define PG8_STAGE(bufoff, gbase, voff) do { _Pragma("unroll") for (int _i = 0; _i < 2; ++_i) \
        __builtin_amdgcn_global_load_lds((const unsigned*)((const char*)(gbase) + (voff)[_i]), (PG8_LAS unsigned*)(lds + (bufoff) + ldsw + _i * 8192), 16, 0, 0); } while (0)
#define PG8_LDA(dst, b, h) do { _Pragma("unroll") for (int m = 0; m < 4; ++m) _Pragma("unroll") for (int k = 0; k < 2; ++k) dst[m][k] = *(const PG8_LAS bf16x8*)(lds + PG8_SA(b, h) + aoff + m * 2048 + k * 1024); } while (0)
#define PG8_LDB(dst, b, h) do { _Pragma("unroll") for (int n = 0; n < 2; ++n) _Pragma("unroll") for (int k = 0; k < 2; ++k) dst[n][k] = *(const PG8_LAS bf16x8*)(lds + PG8_SB(b, h) + boff + n * 2048 + k * 1024); } while (0)
#define PG8_MMA(ai, bj, At, Bt) do { __builtin_amdgcn_s_setprio(1); _Pragma("unroll") for (int m = 0; m < 4; ++m) _Pragma("unroll") for (int n = 0; n < 2; ++n) _Pragma("unroll") for (int k = 0; k < 2; ++k) \
        acc[ai][bj][m][n] = __builtin_amdgcn_mfma_f32_16x16x32_bf16(Bt[n][k], At[m][k], acc[ai][bj][m][n], 0, 0, 0); __builtin_amdgcn_s_setprio(0); } while (0)
#define PG8_WAIT_V(n) asm volatile("s_waitcnt vmcnt(" #n ")" ::: "memory")
#define PG8_WAIT_L(n) asm volatile("s_waitcnt lgkmcnt(" #n ")" ::: "memory")
#define PG8_BAR __builtin_amdgcn_s_barrier()
#define PG8_SCHED __builtin_amdgcn_sched_barrier(0)
    Unit cur, nxt; int ui = 0;
    if (!S.next(0, cur)) return;
    f32x4 acc[2][2][4][2];
#pragma unroll
    for (int a = 0; a < 2; ++a)
#pragma unroll
        for (int b = 0; b < 2; ++b)
#pragma unroll
            for (int m = 0; m < 4; ++m)
#pragma unroll
                for (int n = 0; n < 2; ++n) acc[a][b][m][n] = (f32x4){0.f, 0.f, 0.f, 0.f};
    bf16x8 At[4][2], B0[2][2], B1[2][2];
    const char* cA = (const char*)g.A + (size_t)cur.pm * tstep; const char* cB = (const char*)g.Bt + (size_t)cur.pn * tstep;
    S.a_ready(cur);
    if constexpr (SP2) {
        PG8_STAGE(PG8_SB(0, 0), cB, voffB); PG8_STAGE(PG8_SB(0, 1), cB + hstep, voffB); PG8_STAGE(PG8_SA(0, 0), cA, voffA); PG8_STAGE(PG8_SA(0, 1), cA + hstep, voffA);
        if (wr == 1) PG8_BAR;
        PG8_WAIT_V(2); PG8_BAR;
        PG8_STAGE(PG8_SB(1, 0), cB + kstep, voffB); PG8_STAGE(PG8_SA(1, 0), cA + kstep, voffA); PG8_STAGE(PG8_SB(1, 1), cB + hstep + kstep, voffB);
        PG8_WAIT_V(6); PG8_BAR;
    } else {
        PG8_STAGE(PG8_SB(0, 0), cB, voffB); PG8_STAGE(PG8_SA(0, 0), cA, voffA); PG8_STAGE(PG8_SB(0, 1), cB + hstep, voffB); PG8_STAGE(PG8_SA(0, 1), cA + hstep, voffA);
        if (wr == 1) PG8_BAR;
        PG8_WAIT_V(4); PG8_BAR;
        PG8_STAGE(PG8_SB(1, 0), cB + kstep, voffB); PG8_STAGE(PG8_SA(1, 0), cA + kstep, voffA); PG8_STAGE(PG8_SB(1, 1), cB + hstep + kstep, voffB);
        PG8_WAIT_V(6); PG8_BAR;
    }
    for (;;) {
        const bool has_next = S.next(ui + 1, nxt);
        const char* nA = has_next ? (const char*)g.A + (size_t)nxt.pm * tstep : cA; const char* nB = has_next ? (const char*)g.Bt + (size_t)nxt.pn * tstep : cB;
        for (int t = 0; t < nt; t += 2) {
            const bool last = (t == nt - 2);
            const char* a1 = cA + (size_t)(t + 1) * kstep;
            const char* a2 = last ? nA : cA + (size_t)(t + 2) * kstep; const char* b2 = last ? nB : cB + (size_t)(t + 2) * kstep;
            const char* a3 = a2 + kstep; const char* b3 = b2 + kstep;
            if (last && has_next) S.a_ready(nxt);
            if constexpr (SP2) {
            PG8_LDB(B0, 0, 0); PG8_LDB(B1, 0, 1); PG8_SCHED; PG8_LDA(At, 0, 0); PG8_STAGE(PG8_SA(1, 1), a1 + hstep, voffA);
            PG8_WAIT_V(8); PG8_WAIT_L(0); PG8_BAR; PG8_MMA(0, 0, At, B0); PG8_MMA(0, 1, At, B1); PG8_BAR; PG8_SCHED;
            PG8_LDA(At, 0, 1); PG8_STAGE(PG8_SB(0, 0), b2, voffB); PG8_STAGE(PG8_SB(0, 1), b2 + hstep, voffB); PG8_STAGE(PG8_SA(0, 0), a2, voffA);
            PG8_WAIT_V(8); PG8_WAIT_L(0); PG8_BAR; PG8_MMA(1, 0, At, B0); PG8_MMA(1, 1, At, B1); PG8_BAR; PG8_SCHED;
            PG8_LDB(B0, 1, 0); PG8_LDB(B1, 1, 1); PG8_SCHED; PG8_LDA(At, 1, 0); PG8_STAGE(PG8_SA(0, 1), a2 + hstep, voffA);
            PG8_WAIT_V(8); PG8_WAIT_L(0); PG8_BAR; PG8_MMA(0, 0, At, B0); PG8_MMA(0, 1, At, B1); PG8_BAR; PG8_SCHED;
            PG8_LDA(At, 1, 1); PG8_STAGE(PG8_SB(1, 0), b3, voffB); PG8_STAGE(PG8_SB(1, 1), b3 + hstep, voffB); PG8_STAGE(PG8_SA(1, 0), a3, voffA);
            PG8_WAIT_V(8); PG8_WAIT_L(0); PG8_BAR; PG8_MMA(1, 0, At, B0); PG8_MMA(1, 1, At, B1); PG8_BAR; PG8_SCHED;
            } else {
            PG8_LDB(B0, 0, 0); PG8_SCHED; PG8_LDA(At, 0, 0); PG8_STAGE(PG8_SA(1, 1), a1 + hstep, voffA);
            PG8_WAIT_L(8); PG8_BAR; PG8_WAIT_L(0); PG8_MMA(0, 0, At, B0); PG8_BAR; PG8_SCHED;
            PG8_LDB(B1, 0, 1); PG8_STAGE(PG8_SB(0, 0), b2, voffB);
            PG8_BAR; PG8_WAIT_L(0); PG8_MMA(0, 1, At, B1); PG8_BAR;
            PG8_LDA(At, 0, 1); PG8_STAGE(PG8_SA(0, 0), a2, voffA);
            PG8_BAR; PG8_WAIT_L(0); PG8_MMA(1, 0, At, B0); PG8_BAR; PG8_SCHED;
            PG8_STAGE(PG8_SB(0, 1), b2 + hstep, voffB);
            PG8_WAIT_V(6); PG8_BAR; PG8_MMA(1, 1, At, B1); PG8_BAR;
            PG8_LDB(B0, 1, 0); PG8_SCHED; PG8_LDA(At, 1, 0); PG8_STAGE(PG8_SA(0, 1), a2 + hstep, voffA);
            PG8_WAIT_L(8); PG8_BAR; PG8_WAIT_L(0); PG8_MMA(0, 0, At, B0); PG8_BAR; PG8_SCHED;
            PG8_LDB(B1, 1, 1); PG8_STAGE(PG8_SB(1, 0), b3, voffB);
            PG8_BAR; PG8_WAIT_L(0); PG8_MMA(0, 1, At, B1); PG8_BAR;
            PG8_LDA(At, 1, 1); PG8_STAGE(PG8_SA(1, 0), a3, voffA);
            PG8_BAR; PG8_WAIT_L(0); PG8_MMA(1, 0, At, B0); PG8_BAR; PG8_SCHED;
            PG8_STAGE(PG8_SB(1, 1), b3 + hstep, voffB);
            PG8_WAIT_V(6); PG8_BAR; PG8_MMA(1, 1, At, B1); PG8_BAR;
            }
        }
        if constexpr (ALIGN_EPI) { if (wr == 0) PG8_BAR; }
        if constexpr (!Epi::AFTER_DRAIN) { E(acc, cur, wr, wc, fr, fq); S.done(cur); }
        if (!has_next) break;
#pragma unroll
        for (int a = 0; a < 2; ++a)
#pragma unroll
            for (int b = 0; b < 2; ++b)
#pragma unroll
                for (int m = 0; m < 4; ++m)
#pragma unroll
                    for (int n = 0; n < 2; ++n) acc[a][b][m][n] = (f32x4){0.f, 0.f, 0.f, 0.f};
        cur = nxt; cA = nA; cB = nB; ++ui;
        if constexpr (ALIGN_EPI) { if (wr == 1) PG8_BAR; }
    }
    PG8_WAIT_V(0);
    if constexpr (!ALIGN_EPI) { if (wr == 0) PG8_BAR; }
    PG8_BAR;
    if constexpr (Epi::AFTER_DRAIN) { E.fused(acc, cur, wr, wc, fr, fq, lds, wid, lane); S.done(cur); }
#undef PG8_SA
#undef PG8_SB
#undef PG8_STAGE
#undef PG8_LDA
#undef PG8_LDB
#undef PG8_MMA
#undef PG8_WAIT_V
#undef PG8_WAIT_L
#undef PG8_BAR
#undef PG8_SCHED
}
}

#define LAS __attribute__((address_space(3)))
using pg8::f32x4; using pg8::u32x4; using pg8::bf16_t; using pg8::bf16x8; using pg8::Unit;
typedef float f32x2 __attribute__((ext_vector_type(2)));
typedef __bf16 bf16x2_t __attribute__((ext_vector_type(2)));
typedef unsigned u32x2 __attribute__((ext_vector_type(2)));
constexpr int DM = 1024, DFF = 2816, NFF2 = 5632, NIN = 1280, PED = 256;
constexpr int MP = 65536, MS = 2048, MT = MP + MS;
constexpr int NB = 32, SEQ = 2048, DSEQ = 64, NLAYER = 2;
constexpr float EPS = 1e-6f, LOG2E = 1.4426950408889634f;
constexpr size_t MiB = 1u << 20;
constexpr size_t WL_FFA_IN = 0, WL_FFA_OUT = 11 * MiB, WL_IN = WL_FFA_OUT + 5 * MiB + MiB / 2, WL_OUT = WL_IN + 2 * MiB + MiB / 2, WL_FFB_IN = WL_OUT + 2 * MiB,
                 WL_FFB_OUT = WL_FFB_IN + 11 * MiB, WL_PEG = WL_FFB_OUT + 5 * MiB + MiB / 2, WL_PEU = WL_PEG + 2 * MiB, WL_POOL = WL_PEU + MiB / 2, WL_STRIDE = 41 * MiB;
static_assert(WL_POOL + 131072 <= WL_STRIDE, "weights map");
constexpr size_t WS_W = 0, WS_XB = 82 * MiB, WS_ACT = 214 * MiB, WS_Z = WS_ACT, WS_MIX = WS_ACT + 165 * MiB, WS_U = WS_ACT, WS_PB = 577 * MiB, WS_SSQ = 643 * MiB, WS_ROPE = 646 * MiB, WS_BAR = 646 * MiB + 512 * 1024, WS_XB2 = 647 * MiB, WS_U2 = 779 * MiB, WS_END = 911 * MiB;
static_assert((size_t)MT * DM * 2 == 132 * MiB && (size_t)MT * DFF * 2 == 363 * MiB && (size_t)MT * NIN * 2 == 165 * MiB && (size_t)2 * MT * PED * 2 == 66 * MiB, "buffer sizes");
constexpr size_t O_Y = 0, O_KP = (size_t)MT * DM, O_VP = O_KP + 1048576, O_UP = O_VP + 1048576, O_KS = O_UP + 491520, O_VS = O_KS + 1048576, O_US = O_VS + 1048576, O_END = O_US + 491520;

struct Params {
    const float* in[24]; float* out; unsigned char* ws;
};
enum { I_XP = 0, I_XS, I_PP, I_PS, I_CK, I_CV, I_SP, I_NFFA, I_WFFA_IN, I_WFFA_OUT, I_NMIX, I_WIN, I_QN, I_KN, I_SINK, I_WPOOL, I_PSCALE, I_WOUT, I_NFFB, I_WFFB_IN, I_WFFB_OUT, I_NPE, I_WPEG, I_WPEU };

__device__ __forceinline__ unsigned pk2(float lo, float hi) { f32x2 v = {lo, hi}; bf16x2_t b = __builtin_convertvector(v, bf16x2_t); return __builtin_bit_cast(unsigned, b); }
__device__ __forceinline__ float bflo(unsigned w) { return __uint_as_float(w << 16); }
__device__ __forceinline__ float bfhi(unsigned w) { return __uint_as_float(w & 0xffff0000u); }
__device__ __forceinline__ float rstd_of(const float* ssq, int row) { return __builtin_amdgcn_rsqf(ssq[row] * (1.0f / 1024.0f) + EPS); }
__device__ __forceinline__ float silu_f(float g) { return g * __builtin_amdgcn_rcpf(1.0f + __builtin_amdgcn_exp2f(-LOG2E * g)); }
__device__ __forceinline__ float sigm_f(float g) { return __builtin_amdgcn_rcpf(1.0f + __builtin_amdgcn_exp2f(-LOG2E * g)); }
__device__ __forceinline__ float wave_sum(float v) {
#pragma unroll
    for (int o = 1; o < 64; o <<= 1) v += __shfl_xor(v, o);
    return v;
}

struct EpiSwiglu {
    static constexpr bool PERM = true, AFTER_DRAIN = false;
    bf16_t* act; const float* ssq;
    __device__ __forceinline__ void operator()(const f32x4 (&acc)[2][2][4][2], const Unit& u, int wr, int wc, int fr, int fq) const {
        const int row0 = u.pm * 256 + wr * 64 + fr, col0 = u.pn * 128 + wc * 32 + 8 * fq;
#pragma unroll
        for (int ai = 0; ai < 2; ++ai)
#pragma unroll
            for (int m = 0; m < 4; ++m) {
                const int row = row0 + ai * 128 + m * 16; const float rs = rstd_of(ssq, row);
                const f32x4 g0 = acc[ai][0][m][0] * rs, g1 = acc[ai][0][m][1] * rs, u0 = acc[ai][1][m][0] * rs, u1 = acc[ai][1][m][1] * rs;
                u32x4 w;
                w.x = pk2(silu_f(g0[0]) * u0[0], silu_f(g0[1]) * u0[1]); w.y = pk2(silu_f(g0[2]) * u0[2], silu_f(g0[3]) * u0[3]);
                w.z = pk2(silu_f(g1[0]) * u1[0], silu_f(g1[1]) * u1[1]); w.w = pk2(silu_f(g1[2]) * u1[2], silu_f(g1[3]) * u1[3]);
                *(u32x4*)(act + (size_t)row * DFF + col0) = w;
            }
    }
};
struct EpiStore {
    static constexpr bool PERM = true, AFTER_DRAIN = false;
    bf16_t* O; int ldc; const float* ssq;
    __device__ __forceinline__ void operator()(const f32x4 (&acc)[2][2][4][2], const Unit& u, int wr, int wc, int fr, int fq) const {
        const int row0 = u.pm * 256 + wr * 64 + fr, col0 = u.pn * 256 + wc * 32 + 8 * fq;
#pragma unroll
        for (int ai = 0; ai < 2; ++ai)
#pragma unroll
            for (int m = 0; m < 4; ++m) {
                const int row = row0 + ai * 128 + m * 16; const float rs = ssq ? rstd_of(ssq, row) : 1.0f;
#pragma unroll
                for (int bj = 0; bj < 2; ++bj) {
                    const f32x4 v0 = acc[ai][bj][m][0] * rs, v1 = acc[ai][bj][m][1] * rs;
                    u32x4 w; w.x = pk2(v0[0], v0[1]); w.y = pk2(v0[2], v0[3]); w.z = pk2(v1[0], v1[1]); w.w = pk2(v1[2], v1[3]);
                    *(u32x4*)(O + (size_t)row * ldc + col0 + bj * 128) = w;
                }
            }
    }
};
template <int MODE> struct EpiResid {
    static constexpr bool PERM = true, AFTER_DRAIN = false;
    const bf16_t* xi; bf16_t* xo; float* yout; float* ssq_next; float scale; const bf16_t* U; const float* ssq_cur;
    __device__ __forceinline__ void operator()(const f32x4 (&acc)[2][2][4][2], const Unit& u, int wr, int wc, int fr, int fq) const {
        const int row0 = u.pm * 256 + wr * 64 + fr, col0 = u.pn * 256 + wc * 32 + 8 * fq;
#pragma unroll
        for (int ai = 0; ai < 2; ++ai)
#pragma unroll
            for (int m = 0; m < 4; ++m) {
                const int row = row0 + ai * 128 + m * 16; const size_t off = (size_t)row * DM + col0;
                const float rs = (MODE == 1) ? rstd_of(ssq_cur, row) : 0.f; float ss = 0.f;
#pragma unroll
                for (int bj = 0; bj < 2; ++bj) {
                    const u32x4 xw = *(const u32x4*)(xi + off + bj * 128);
                    f32x4 a0 = acc[ai][bj][m][0], a1 = acc[ai][bj][m][1];
                    if (MODE == 1) {
                        const u32x4 uu = *(const u32x4*)(U + off + bj * 128);
                        a0[0] = sigm_f(a0[0] * rs) * bflo(uu.x); a0[1] = sigm_f(a0[1] * rs) * bfhi(uu.x); a0[2] = sigm_f(a0[2] * rs) * bflo(uu.y); a0[3] = sigm_f(a0[3] * rs) * bfhi(uu.y);
                        a1[0] = sigm_f(a1[0] * rs) * bflo(uu.z); a1[1] = sigm_f(a1[1] * rs) * bfhi(uu.z); a1[2] = sigm_f(a1[2] * rs) * bflo(uu.w); a1[3] = sigm_f(a1[3] * rs) * bfhi(uu.w);
                    } else { a0 = a0 * scale; a1 = a1 * scale; }
                    const f32x4 v0 = (f32x4){bflo(xw.x), bfhi(xw.x), bflo(xw.y), bfhi(xw.y)} + a0, v1 = (f32x4){bflo(xw.z), bfhi(xw.z), bflo(xw.w), bfhi(xw.w)} + a1;
                    if (yout) { *(f32x4*)(yout + off + bj * 128) = v0; *(f32x4*)(yout + off + bj * 128 + 4) = v1; }
                    else {
                        u32x4 w; w.x = pk2(v0[0], v0[1]); w.y = pk2(v0[2], v0[3]); w.z = pk2(v1[0], v1[1]); w.w = pk2(v1[2], v1[3]);
                        *(u32x4*)(xo + off + bj * 128) = w;
                        ss += (v0[0] * v0[0] + v0[1] * v0[1]) + (v0[2] * v0[2] + v0[3] * v0[3]) + (v1[0] * v1[0] + v1[1] * v1[1]) + (v1[2] * v1[2] + v1[3] * v1[3]);
                    }
                }
                if (!yout) { ss += __shfl_xor(ss, 16); ss += __shfl_xor(ss, 32);
                    if (fq == 0) __hip_atomic_fetch_add(ssq_next + row, ss, __ATOMIC_RELAXED, __HIP_MEMORY_SCOPE_AGENT); }
                if (m & 1) asm volatile("" ::: "memory");
            }
    }
};

__device__ __forceinline__ void transpose_item(const float* W, int K, int N, bf16_t* WT, const float* gk, int mode, LAS float* scr, int item, int lane) {
    const int nblk = N / 32, kb = item / nblk, nb = item % nblk, k0 = 64 * kb, n0 = 32 * nb;
    const int sc = (mode == 1) ? (((n0 >> 7) & 1) * DFF + (n0 >> 8) * 128 + (n0 & 127)) : n0;
#pragma unroll 8
    for (int i = 0; i < 32; ++i) { const int kk = 2 * i + (lane >> 5); const float gv = gk ? gk[k0 + kk] : 1.0f; scr[kk * 33 + (lane & 31)] = W[(size_t)(k0 + kk) * N + sc + (lane & 31)] * gv; }
    asm volatile("s_waitcnt lgkmcnt(0)" ::: "memory");
    const int c = lane & 7;
#pragma unroll
    for (int j = 0; j < 4; ++j) { const int n = (lane >> 3) + 8 * j; const LAS float* s = scr + (8 * c) * 33 + n;
        u32x4 o; o.x = pk2(s[0 * 33], s[1 * 33]); o.y = pk2(s[2 * 33], s[3 * 33]); o.z = pk2(s[4 * 33], s[5 * 33]); o.w = pk2(s[6 * 33], s[7 * 33]);
        *(u32x4*)(WT + (size_t)(n0 + n) * K + k0 + 8 * c) = o; }
    asm volatile("s_waitcnt lgkmcnt(0)" ::: "memory");
}
__device__ __forceinline__ float rope_inv(int i) {
    return i == 0 ? 1.0f : i == 1 ? 0.1939227432012558f : i == 2 ? 0.03760603070259094f : i == 3 ? 0.007292664609849453f : i == 4 ? 0.0014142135623842478f : i == 5 ? 0.00027424818836152554f : i == 6 ? 5.3182957344688475e-05f : 1.0313385246263351e-05f;
}
__device__ __forceinline__ void sincos_d(float angf, float& c, float& s) {
    const double a = (double)angf; const double n = __builtin_rint(a * 0.63661977236758134308);
    const double r = __builtin_fma(-n, 1.5707963267948966192, a) - n * 6.123233995736766e-17; const double r2 = r * r;
    double sp = -7.6471637318198164759e-13; sp = sp * r2 + 1.6059043836821614599e-10; sp = sp * r2 - 2.5052108385441718775e-8; sp = sp * r2 + 2.7557319223985890653e-6; sp = sp * r2 - 1.9841269841269841270e-4; sp = sp * r2 + 8.3333333333333333333e-3; sp = sp * r2 - 1.6666666666666666667e-1;
    const double sn = r + r * r2 * sp;
    double cp = 4.7794773323873852974e-14; cp = cp * r2 - 1.1470745597729724714e-11; cp = cp * r2 + 2.0876756987868098979e-9; cp = cp * r2 - 2.7557319223985890653e-7; cp = cp * r2 + 2.4801587301587301587e-5; cp = cp * r2 - 1.3888888888888888889e-3; cp = cp * r2 + 4.1666666666666666667e-2; cp = cp * r2 - 0.5;
    const double cs = 1.0 + r2 * cp;
    const int q = ((int)n) & 3;
    const double cc = (q == 0) ? cs : (q == 1) ? -sn : (q == 2) ? -cs : sn;
    const double ss = (q == 0) ? sn : (q == 1) ? cs : (q == 2) ? -sn : -cs;
    c = (float)cc; s = (float)ss;
}
__device__ __forceinline__ void prologue(const Params& p, LAS unsigned char* L, int wv) {
    const int tid = tid_of(wv), lane = tid & 63, wave = __builtin_amdgcn_readfirstlane(tid >> 6);
    const int G = gridDim.x, gw = blockIdx.x * 8 + wave, NGW = G * 8; const int gt = blockIdx.x * 512 + tid, NGT = G * 512;
    LAS float* scr = (LAS float*)(L + wave * 16384);
    unsigned char* ws = p.ws;
    constexpr int I_FI = 16 * 176, I_FO = 44 * 32, I_IN = 16 * 40, I_O = 16 * 32, I_PG = 16 * 32, I_PU = 4 * 32;
    constexpr int PER_LAYER = 2 * I_FI + 2 * I_FO + I_IN + I_O + I_PG + I_PU;
    for (int it = gw; it < NLAYER * PER_LAYER; it += NGW) {
        const int l = it / PER_LAYER; int r = it % PER_LAYER; unsigned char* wl = ws + WS_W + (size_t)l * WL_STRIDE;
        if (r < I_FI) { transpose_item(p.in[I_WFFA_IN] + (size_t)l * DM * NFF2, DM, NFF2, (bf16_t*)(wl + WL_FFA_IN), p.in[I_NFFA] + l * DM, 1, scr, r, lane); continue; } r -= I_FI;
        if (r < I_FI) { transpose_item(p.in[I_WFFB_IN] + (size_t)l * DM * NFF2, DM, NFF2, (bf16_t*)(wl + WL_FFB_IN), p.in[I_NFFB] + l * DM, 1, scr, r, lane); continue; } r -= I_FI;
        if (r < I_FO) { transpose_item(p.in[I_WFFA_OUT] + (size_t)l * DFF * DM, DFF, DM, (bf16_t*)(wl + WL_FFA_OUT), nullptr, 0, scr, r, lane); continue; } r -= I_FO;
        if (r < I_FO) { transpose_item(p.in[I_WFFB_OUT] + (size_t)l * DFF * DM, DFF, DM, (bf16_t*)(wl + WL_FFB_OUT), nullptr, 0, scr, r, lane); continue; } r -= I_FO;
        if (r < I_IN) { transpose_item(p.in[I_WIN] + (size_t)l * DM * NIN, DM, NIN, (bf16_t*)(wl + WL_IN), p.in[I_NMIX] + l * DM, 0, scr, r, lane); continue; } r -= I_IN;
        if (r < I_O) { transpose_item(p.in[I_WOUT] + (size_t)l * DM * DM, DM, DM, (bf16_t*)(wl + WL_OUT), nullptr, 0, scr, r, lane); continue; } r -= I_O;
        if (r < I_PG) { transpose_item(p.in[I_WPEG] + (size_t)l * DM * DM, DM, DM, (bf16_t*)(wl + WL_PEG), p.in[I_NPE] + l * DM, 0, scr, r, lane); continue; } r -= I_PG;
        transpose_item(p.in[I_WPEU] + (size_t)l * PED * DM, PED, DM, (bf16_t*)(wl + WL_PEU), nullptr, 0, scr, r, lane);
    }
    for (int t = gt; t < NLAYER * 4 * 128 * 16; t += NGT) {
        const int ko = t & 15, n = (t >> 4) & 127, g = (t >> 11) & 3, l = t >> 13;
        const float* src = p.in[I_WPOOL] + ((size_t)(l * 4 + g) * 128 + 8 * ko) * 128 + n; const float sc = p.in[I_PSCALE][l * 512 + g * 128 + n];
        u32x4 o; o.x = pk2(src[0] * sc, src[128] * sc); o.y = pk2(src[256] * sc, src[384] * sc); o.z = pk2(src[512] * sc, src[640] * sc); o.w = pk2(src[768] * sc, src[896] * sc);
        *(u32x4*)((bf16_t*)(ws + WS_W + (size_t)l * WL_STRIDE + WL_POOL) + ((size_t)g * 128 + n) * 128 + 8 * ko) = o;
    }
    bf16_t* xb = (bf16_t*)(ws + WS_XB); float* ssq = (float*)(ws + WS_SSQ);
    for (int m = gw; m < MT; m += NGW) {
        const float* xr = (m < MP) ? p.in[I_XP] + (size_t)m * DM : p.in[I_XS] + (size_t)(m - MP) * DM;
        f32x4 v[4]; float s = 0.f;
#pragma unroll
        for (int j = 0; j < 4; ++j) { v[j] = *((const f32x4*)xr + lane + 64 * j); s += (v[j][0] * v[j][0] + v[j][1] * v[j][1]) + (v[j][2] * v[j][2] + v[j][3] * v[j][3]); }
        s = wave_sum(s);
#pragma unroll
        for (int j = 0; j < 4; ++j) { u32x2 o; o.x = pk2(v[j][0], v[j][1]); o.y = pk2(v[j][2], v[j][3]); *((u32x2*)(xb + (size_t)m * DM) + lane + 64 * j) = o; }
        if (lane == 0) ssq[m] = s;
    }
    for (int t = gt; t < 8 * MT / 4; t += NGT) *((f32x4*)(ssq + MT) + t) = (f32x4){0.f, 0.f, 0.f, 0.f};
    bf16_t* pb = (bf16_t*)(ws + WS_PB);
    for (int t = gt; t < NLAYER * MT * 32; t += NGT) {
        const int o8 = t & 31, m = (t >> 5) % MT, l = (t >> 5) / MT;
        const float* src = ((m < MP) ? p.in[I_PP] + ((size_t)l * MP + m) * PED : p.in[I_PS] + ((size_t)l * MS + (m - MP)) * PED) + 8 * o8;
        const f32x4 a = *(const f32x4*)src, b = *(const f32x4*)(src + 4);
        u32x4 o; o.x = pk2(a[0], a[1]); o.y = pk2(a[2], a[3]); o.z = pk2(b[0], b[1]); o.w = pk2(b[2], b[3]);
        *(u32x4*)(pb + ((size_t)l * MT + m) * PED + 8 * o8) = o;
    }
    float* rope = (float*)(ws + WS_ROPE);
    for (int t = gt; t < 2112 * 8; t += NGT) {
        const int i = t & 7, idx = t >> 3, pos = idx < 2048 ? idx : 4096 + idx - 2048;
        const float ang = (float)pos * rope_inv(i); float c, s; sincos_d(ang, c, s);
        rope[idx * 16 + i] = c; rope[idx * 16 + 8 + i] = s;
    }
}

constexpr int KROW = 72, DROW = 520;
constexpr int LK_OFF = 0, LV_OFF = 2 * 192 * KROW * 2, LMIX_END = 2 * LV_OFF;
static_assert(LMIX_END <= 131072 && 64 * DROW * 2 <= 131072, "mixer LDS");
typedef short v4i16_t __attribute__((ext_vector_type(4)));
__device__ __forceinline__ u32x2 tr_read(const LAS unsigned char* q) { const v4i16_t r = __builtin_amdgcn_ds_read_tr16_b64_v4i16((LAS v4i16_t*)q); return __builtin_bit_cast(u32x2, r); }
__device__ __forceinline__ bf16x8 pack8(const float* v) { u32x4 w; w.x = pk2(v[0], v[1]); w.y = pk2(v[2], v[3]); w.z = pk2(v[4], v[5]); w.w = pk2(v[6], v[7]); return __builtin_bit_cast(bf16x8, w); }
__device__ __forceinline__ void unpack8(u32x4 w, float* v) { v[0] = bflo(w.x); v[1] = bfhi(w.x); v[2] = bflo(w.y); v[3] = bfhi(w.y); v[4] = bflo(w.z); v[5] = bfhi(w.z); v[6] = bflo(w.w); v[7] = bfhi(w.w); }

template <int W> __device__ __forceinline__ void pool_stage(const Params& p, const bf16_t* z, int layer, bool is_s, int b, int c, int tok0, int g, int half, int lane, LAS unsigned char* L) {
    const int oct = lane & 15, tq = lane >> 4, c0 = 128 * g + 8 * oct, t0 = 32 * half + 8 * tq;
    const float* sp = p.in[I_SP] + ((size_t)layer * NB + b) * 15 * 512 + c0;
    u32x4 raw[W + 7];
#pragma unroll
    for (int j = 0; j < W + 7; ++j) {
        const int t = t0 - (W - 1) + j;
        u32x4 r = {0u, 0u, 0u, 0u};
        if (t >= 0 || (!is_s && c * 64 + t >= 0)) r = *(const u32x4*)(z + (size_t)(tok0 + t) * NIN + 768 + c0);
        else if (is_s) { const f32x4 a = *(const f32x4*)(sp + (15 + t) * 512), bb = *(const f32x4*)(sp + (15 + t) * 512 + 4); r.x = pk2(a[0], a[1]); r.y = pk2(a[2], a[3]); r.z = pk2(bb[0], bb[1]); r.w = pk2(bb[2], bb[3]); }
        raw[j] = r;
    }
    float sum[8];
#pragma unroll
    for (int i = 0; i < 8; ++i) sum[i] = 0.f;
#pragma unroll
    for (int j = 0; j < W - 1; ++j) { float u[8]; unpack8(raw[j], u);
#pragma unroll
        for (int i = 0; i < 8; ++i) sum[i] += u[i]; }
#pragma unroll
    for (int ti = 0; ti < 8; ++ti) {
        const int t = t0 + ti; float u[8], ul[8], d[8]; unpack8(raw[W - 1 + ti], u); unpack8(raw[ti], ul);
        const int cnt = is_s ? W : min(c * 64 + t + 1, W); const float rc = 1.0f / (float)cnt;
#pragma unroll
        for (int i = 0; i < 8; ++i) { sum[i] += u[i]; d[i] = sum[i] * rc - u[i]; sum[i] -= ul[i]; }
        *(LAS bf16x8*)(L + (t * DROW + c0) * 2) = pack8(d);
        if (t >= 49 && (is_s || c == 31)) { float* o = p.out + (is_s ? O_US : O_UP) + (((size_t)layer * NB + b) * 15 + (t - 49)) * 512 + c0;
            *(f32x4*)o = (f32x4){u[0], u[1], u[2], u[3]}; *(f32x4*)(o + 4) = (f32x4){u[4], u[5], u[6], u[7]}; }
    }
}

__device__ __forceinline__ void mixer_unit(const Params& p, int layer, int cu, LAS unsigned char* L, int wv) {
    int tid_ = tid_of(wv); asm volatile("" : "+v"(tid_));
    const int tid = tid_, lane = tid & 63, wave = __builtin_amdgcn_readfirstlane(tid >> 6);
    const bool is_s = cu >= 1024;
    const int b = is_s ? cu - 1024 : (cu >> 5), c = is_s ? 0 : (cu & 31);
    const int tok0 = is_s ? MP + b * 64 : b * SEQ + c * 64;
    const int kstart = is_s ? 0 : (c >= 2 ? 0 : (2 - c) * 64);
    const int pidx0 = is_s ? 2048 : c * 64;
    const bf16_t* z = (const bf16_t*)(p.ws + WS_Z); bf16_t* mix = (bf16_t*)(p.ws + WS_MIX);
    const float* rope = (const float*)(p.ws + WS_ROPE);
    const int q16 = lane & 15, quad = lane >> 4, h = wave, kvhq = h >> 2;
    const int piece = tid & 31, rsub = tid >> 5, sub = piece & 7, kvh = (piece >> 3) & 1; const bool isK = piece < 16;
    const int klo = is_s ? 128 : kstart, npass = (192 - klo) >> 4;
    u32x4 raw[12], qraw[4][2];
#pragma unroll
    for (int ps = 0; ps < 12; ++ps) if (ps < npass) raw[ps] = *(const u32x4*)(z + (size_t)(tok0 + klo + 16 * ps + rsub - 128) * NIN + 512 + piece * 8);
    if (is_s) {
#pragma unroll 1
        for (int ps = 0; ps < 8; ++ps) {
            const int kk = 16 * ps + rsub; const size_t o = ((((size_t)layer * NB + b) * 128 + kk) * 2 + kvh) * 64 + sub * 8;
            const float* src = (isK ? p.in[I_CK] : p.in[I_CV]) + o;
            const f32x4 a0 = *(const f32x4*)src, a1 = *(const f32x4*)(src + 4);
            float v[8] = {a0[0], a0[1], a0[2], a0[3], a1[0], a1[1], a1[2], a1[3]};
            *(LAS bf16x8*)(L + (isK ? LK_OFF : LV_OFF) + ((kvh * 192 + kk) * KROW + sub * 8) * 2) = pack8(v);
            if (kk >= 64) { float* dst = p.out + (isK ? O_KS : O_VS) + ((((size_t)layer * NB + b) * 128 + (kk - 64)) * 2 + kvh) * 64 + sub * 8; *(f32x4*)dst = a0; *(f32x4*)(dst + 4) = a1; }
        }
    }
    {
        float kn[8];
#pragma unroll
        for (int i = 0; i < 8; ++i) kn[i] = p.in[I_KN][layer * 64 + sub * 8 + i];
#pragma unroll
        for (int ps = 0; ps < 12; ++ps) if (ps < npass) {
            const int kk = klo + 16 * ps + rsub;
            float v[8]; unpack8(raw[ps], v);
            float ss = 0.f;
#pragma unroll
            for (int i = 0; i < 8; ++i) ss += v[i] * v[i];
            ss += __shfl_xor(ss, 1); ss += __shfl_xor(ss, 2); ss += __shfl_xor(ss, 4);
            const float rs = __builtin_amdgcn_rsqf(ss * (1.0f / 64.0f) + EPS);
            float pv[8];
#pragma unroll
            for (int i = 0; i < 8; ++i) { if (isK) v[i] = v[i] * rs * kn[i]; pv[i] = __shfl_xor(v[i], 1); }
            if (isK && sub < 2) {
                const float* rt = rope + (size_t)(pidx0 + kk - 128) * 16;
                const f32x4 c0 = *(const f32x4*)rt, c1 = *(const f32x4*)(rt + 4), s0 = *(const f32x4*)(rt + 8), s1 = *(const f32x4*)(rt + 12);
#pragma unroll
                for (int i = 0; i < 8; ++i) { const float cs = i < 4 ? c0[i & 3] : c1[i & 3], sn = i < 4 ? s0[i & 3] : s1[i & 3]; v[i] = (sub == 0) ? v[i] * cs - pv[i] * sn : v[i] * cs + pv[i] * sn; }
            }
            *(LAS bf16x8*)(L + (isK ? LK_OFF : LV_OFF) + ((kvh * 192 + kk) * KROW + sub * 8) * 2) = pack8(v);
            int orow = -1;
            if (is_s) orow = kk - 64; else if (c >= 30 && kk >= 128) orow = (c - 30) * 64 + (kk - 128);
            if (orow >= 0) {
                float* dst = p.out + (isK ? (is_s ? O_KS : O_KP) : (is_s ? O_VS : O_VP)) + ((((size_t)layer * NB + b) * 128 + orow) * 2 + kvh) * 64 + sub * 8;
                *(f32x4*)dst = (f32x4){v[0], v[1], v[2], v[3]}; *(f32x4*)(dst + 4) = (f32x4){v[4], v[5], v[6], v[7]};
            }
        }
    }
#pragma unroll
    for (int qb = 0; qb < 4; ++qb) { const bf16_t* qp = z + (size_t)(tok0 + 16 * qb + q16) * NIN + h * 64 + 8 * quad; qraw[qb][0] = *(const u32x4*)qp; qraw[qb][1] = *(const u32x4*)(qp + 32); }
    bf16x8 qf[4][2];
    {
        float gq0[8], gq1[8];
#pragma unroll
        for (int i = 0; i < 8; ++i) { gq0[i] = p.in[I_QN][layer * 64 + 8 * quad + i]; gq1[i] = p.in[I_QN][layer * 64 + 32 + 8 * quad + i]; }
        constexpr float QS = 0.125f * LOG2E;
#pragma unroll
        for (int qb = 0; qb < 4; ++qb) {
            float v0[8], v1[8]; unpack8(qraw[qb][0], v0); unpack8(qraw[qb][1], v1);
            float ss = 0.f;
#pragma unroll
            for (int i = 0; i < 8; ++i) ss += v0[i] * v0[i] + v1[i] * v1[i];
            ss += __shfl_xor(ss, 16); ss += __shfl_xor(ss, 32);
            const float rs = __builtin_amdgcn_rsqf(ss * (1.0f / 64.0f) + EPS);
            float pv[8];
#pragma unroll
            for (int i = 0; i < 8; ++i) { v0[i] = v0[i] * rs * gq0[i]; v1[i] = v1[i] * rs * gq1[i] * QS; pv[i] = __shfl_xor(v0[i], 16); }
            if (quad < 2) {
                const float* rt = rope + (size_t)(pidx0 + 16 * qb + q16) * 16;
                const f32x4 c0 = *(const f32x4*)rt, c1 = *(const f32x4*)(rt + 4), s0 = *(const f32x4*)(rt + 8), s1 = *(const f32x4*)(rt + 12);
#pragma unroll
                for (int i = 0; i < 8; ++i) { const float cs = i < 4 ? c0[i & 3] : c1[i & 3], sn = i < 4 ? s0[i & 3] : s1[i & 3]; v0[i] = (quad == 0) ? v0[i] * cs - pv[i] * sn : v0[i] * cs + pv[i] * sn; }
            }
#pragma unroll
            for (int i = 0; i < 8; ++i) v0[i] *= QS;
            qf[qb][0] = pack8(v0); qf[qb][1] = pack8(v1);
        }
    }
    __syncthreads();
    {
        const float sinkv = p.in[I_SINK][layer * 8 + h] * LOG2E;
        const LAS unsigned char* Kb = L + LK_OFF + ((kvhq * 192 + q16) * KROW + 8 * quad) * 2;
        const LAS unsigned char* Vb = L + LV_OFF + ((kvhq * 192 + 4 * quad + (q16 >> 2)) * KROW + 4 * (q16 & 3)) * 2;
#pragma unroll
        for (int pr = 0; pr < 2; ++pr) {
            f32x4 s[2][12];
#pragma unroll
            for (int kt = 0; kt < 12; ++kt) {
                if (16 * kt >= kstart) {
                    const bf16x8 k0 = *(const LAS bf16x8*)(Kb + kt * 16 * KROW * 2), k1 = *(const LAS bf16x8*)(Kb + kt * 16 * KROW * 2 + 64);
#pragma unroll
                    for (int e = 0; e < 2; ++e) { s[e][kt] = __builtin_amdgcn_mfma_f32_16x16x32_bf16(k0, qf[2 * pr + e][0], (f32x4){0.f, 0.f, 0.f, 0.f}, 0, 0, 0);
                        s[e][kt] = __builtin_amdgcn_mfma_f32_16x16x32_bf16(k1, qf[2 * pr + e][1], s[e][kt], 0, 0, 0); }
                } else { s[0][kt] = (f32x4){-1e30f, -1e30f, -1e30f, -1e30f}; s[1][kt] = s[0][kt]; }
            }
            float inv[2];
#pragma unroll
            for (int e = 0; e < 2; ++e) {
                float mx = sinkv;
#pragma unroll
                for (int kt = 0; kt < 12; ++kt) mx = fmaxf(fmaxf(mx, fmaxf(s[e][kt][0], s[e][kt][1])), fmaxf(s[e][kt][2], s[e][kt][3]));
                mx = fmaxf(mx, __shfl_xor(mx, 16)); mx = fmaxf(mx, __shfl_xor(mx, 32));
                float l = 0.f;
#pragma unroll
                for (int kt = 0; kt < 12; ++kt)
#pragma unroll
                    for (int j = 0; j < 4; ++j) { s[e][kt][j] = __builtin_amdgcn_exp2f(s[e][kt][j] - mx); l += s[e][kt][j]; }
                l += __shfl_xor(l, 16); l += __shfl_xor(l, 32);
                l += __builtin_amdgcn_exp2f(sinkv - mx);
                inv[e] = 1.0f / l;
            }
            f32x4 o[2][4];
#pragma unroll
            for (int e = 0; e < 2; ++e)
#pragma unroll
                for (int dt = 0; dt < 4; ++dt) o[e][dt] = (f32x4){0.f, 0.f, 0.f, 0.f};
#pragma unroll
            for (int si = 0; si < 6; ++si) {
                if (32 * si >= kstart) {
                    bf16x8 pf[2];
#pragma unroll
                    for (int e = 0; e < 2; ++e) { u32x4 pw; pw.x = pk2(s[e][2 * si][0], s[e][2 * si][1]); pw.y = pk2(s[e][2 * si][2], s[e][2 * si][3]); pw.z = pk2(s[e][2 * si + 1][0], s[e][2 * si + 1][1]); pw.w = pk2(s[e][2 * si + 1][2], s[e][2 * si + 1][3]); pf[e] = __builtin_bit_cast(bf16x8, pw); }
#pragma unroll
                    for (int dt = 0; dt < 4; ++dt) {
                        const u32x2 a = tr_read(Vb + ((32 * si) * KROW + 16 * dt) * 2), bq = tr_read(Vb + ((32 * si + 16) * KROW + 16 * dt) * 2);
                        const u32x4 vw = {a.x, a.y, bq.x, bq.y}; const bf16x8 vf = __builtin_bit_cast(bf16x8, vw);
#pragma unroll
                        for (int e = 0; e < 2; ++e) o[e][dt] = __builtin_amdgcn_mfma_f32_16x16x32_bf16(vf, pf[e], o[e][dt], 0, 0, 0);
                    }
                }
            }
#pragma unroll
            for (int e = 0; e < 2; ++e) { const int row = tok0 + 16 * (2 * pr + e) + q16;
#pragma unroll
                for (int dt = 0; dt < 4; ++dt) { u32x2 w; w.x = pk2(o[e][dt][0] * inv[e], o[e][dt][1] * inv[e]); w.y = pk2(o[e][dt][2] * inv[e], o[e][dt][3] * inv[e]);
                    *(u32x2*)(mix + (size_t)row * DM + h * 64 + 16 * dt + 4 * quad) = w; } }
        }
    }
    __syncthreads();
    {
        const int g = wave >> 1, half = wave & 1;
        if (g == 0) pool_stage<2>(p, z, layer, is_s, b, c, tok0, g, half, lane, L);
        else if (g == 1) pool_stage<4>(p, z, layer, is_s, b, c, tok0, g, half, lane, L);
        else if (g == 2) pool_stage<8>(p, z, layer, is_s, b, c, tok0, g, half, lane, L);
        else pool_stage<16>(p, z, layer, is_s, b, c, tok0, g, half, lane, L);
    }
    __syncthreads();
    {
        const int g = wave >> 1, th = wave & 1;
        bf16x8 dfr[2][4];
#pragma unroll
        for (int tb = 0; tb < 2; ++tb)
#pragma unroll
            for (int ks = 0; ks < 4; ++ks) dfr[tb][ks] = *(const LAS bf16x8*)(L + ((32 * th + 16 * tb + q16) * DROW + 128 * g + 32 * ks + 8 * quad) * 2);
        const bf16_t* wp = (const bf16_t*)(p.ws + WS_W + (size_t)layer * WL_STRIDE + WL_POOL) + (size_t)g * 128 * 128;
#pragma unroll 2
        for (int nt = 0; nt < 8; ++nt) {
            bf16x8 wf[4];
#pragma unroll
            for (int ks = 0; ks < 4; ++ks) wf[ks] = *(const bf16x8*)(wp + (16 * nt + q16) * 128 + 32 * ks + 8 * quad);
#pragma unroll
            for (int tb = 0; tb < 2; ++tb) {
                f32x4 o = (f32x4){0.f, 0.f, 0.f, 0.f};
#pragma unroll
                for (int ks = 0; ks < 4; ++ks) o = __builtin_amdgcn_mfma_f32_16x16x32_bf16(wf[ks], dfr[tb][ks], o, 0, 0, 0);
                u32x2 ww; ww.x = pk2(o[0], o[1]); ww.y = pk2(o[2], o[3]);
                *(u32x2*)(mix + (size_t)(tok0 + 32 * th + 16 * tb + q16) * DM + 512 + 128 * g + 16 * nt + 4 * quad) = ww;
            }
        }
    }
    __syncthreads();
}

#define XB_TMO      128
#define XB_XCNT(j)  (256  + 64 * (j))
#define XB_XSUB(j)  (1280 + 64 * (j))
#define XB_XGEN(j)  (2304 + 64 * (j))
#define XB_TOP      3328
#define XB_TOPGEN   3392
#define XCD_BAR_WORDS 3456
#define XB_SPIN_CAP (1u << 18)

__device__ __forceinline__ unsigned xb_ld(unsigned* p)              { return __hip_atomic_load(p, __ATOMIC_RELAXED, __HIP_MEMORY_SCOPE_AGENT); }
__device__ __forceinline__ unsigned xb_add(unsigned* p, unsigned v) { return __hip_atomic_fetch_add(p, v, __ATOMIC_RELAXED, __HIP_MEMORY_SCOPE_AGENT); }
__device__ __forceinline__ unsigned xb_xcc_id() { return (unsigned)__builtin_amdgcn_s_getreg((3 << 11) | 20) & 0xFu; }
#define XB_SPIN(cond, bar) do { unsigned _sp = 0; while (cond) { __builtin_amdgcn_s_sleep(1); \
    if ((++_sp & 255u) == 0u) { if (xb_ld(&(bar)[XB_TMO])) break; if (_sp > XB_SPIN_CAP) { atomicAdd(&(bar)[XB_TMO], 1u); break; } } } } while (0)

struct XcdBarrier {
    unsigned* bar; unsigned x;
    volatile LAS unsigned* st;
};

__device__ __forceinline__ XcdBarrier xcd_barrier_post(unsigned* bar, volatile LAS unsigned* st) {
    XcdBarrier b; b.bar = bar; b.x = xb_xcc_id(); b.st = st;
    if (threadIdx.x == 0) (void)xb_add(&bar[XB_XCNT(b.x)], 1u);
    return b;
}
__device__ __forceinline__ void xcd_barrier_complete(unsigned* bar, unsigned x, unsigned& nloc, unsigned& nx) {
    const unsigned G = gridDim.x * gridDim.y * gridDim.z;
    unsigned sum, cnt, mine, sp = 0u;
    for (;;) {
        sum = 0u; cnt = 0u; mine = 0u;
#pragma unroll
        for (unsigned j = 0; j < 16; ++j) { const unsigned c = xb_ld(&bar[XB_XCNT(j)]); sum += c; cnt += (c > 0u) ? 1u : 0u; mine = (j == x) ? c : mine; }
        if (sum == G) break;
        __builtin_amdgcn_s_sleep(1);
        if ((++sp & 255u) == 0u) { if (xb_ld(&bar[XB_TMO])) break; if (sp > XB_SPIN_CAP) { atomicAdd(&bar[XB_TMO], 1u); break; } }
    }
    nloc = mine > 0u ? mine : 1u; nx = cnt > 0u ? cnt : 1u;
}

__device__ __forceinline__ void xcd_barrier(const XcdBarrier& b, bool t0) {
    asm volatile("s_waitcnt vmcnt(0)" ::: "memory");
    __syncthreads();
    if (t0) {
        unsigned* bar = b.bar;
        __builtin_amdgcn_s_waitcnt(0);
        unsigned nloc = b.st[0], nx = b.st[1];
        if (nloc == 0u) { xcd_barrier_complete(bar, b.x, nloc, nx); b.st[0] = nloc; b.st[1] = nx; }
        const unsigned old = xb_add(&bar[XB_XSUB(b.x)], 1u);
        const unsigned gen = old / nloc;
        if (old + 1u == (gen + 1u) * nloc) {
            __builtin_amdgcn_fence(__ATOMIC_RELEASE, "agent");
            asm volatile("s_waitcnt vmcnt(0)" ::: "memory");
            const unsigned og = xb_add(&bar[XB_TOP], 1u);
            const unsigned tg = og / nx;
            if (og + 1u == (tg + 1u) * nx) xb_add(&bar[XB_TOPGEN], 1u);
            else XB_SPIN(xb_ld(&bar[XB_TOPGEN]) == tg, bar);
            __builtin_amdgcn_fence(__ATOMIC_ACQUIRE, "agent");
            xb_add(&bar[XB_XGEN(b.x)], 1u);
            asm volatile("s_waitcnt vmcnt(0)" ::: "memory");
        } else {
            XB_SPIN(xb_ld(&bar[XB_XGEN(b.x)]) == gen, bar);
            __builtin_amdgcn_fence(__ATOMIC_ACQUIRE, "agent");
            asm volatile("s_waitcnt vmcnt(0)" ::: "memory");
        }
    }
    __syncthreads();
}

constexpr int LDS_BYTES = 131072 + 4096;
__global__ void __launch_bounds__(512, 2) hymba_fwd(Params p) {
    extern __shared__ __attribute__((aligned(16))) unsigned char lds_raw[];
    LAS unsigned char* L = (LAS unsigned char*)lds_raw;
    cg::grid_group grid = cg::this_grid();
    const int wv = __builtin_amdgcn_readfirstlane((int)threadIdx.x >> 6);
#define PHASE_VARS size_t oz_ = 0; int ly = layer; asm volatile("" : "+s"(oz_), "+s"(ly)); unsigned char* ws = p.ws + oz_; bf16_t* xb = (bf16_t*)(ws + WS_XB); bf16_t* act = (bf16_t*)(ws + WS_ACT); bf16_t* zb = (bf16_t*)(ws + WS_Z); bf16_t* mixb = (bf16_t*)(ws + WS_MIX); bf16_t* ub = (bf16_t*)(ws + WS_U); \
        float* xres = p.out + O_Y; unsigned char* wl = ws + WS_W + (size_t)ly * WL_STRIDE; float* sq = (float*)(ws + WS_SSQ) + (size_t)ly * 4 * MT; (void)xb; (void)act; (void)zb; (void)mixb; (void)ub; (void)xres; (void)wl; (void)sq;
    const int G = gridDim.x, c = blockIdx.x;
#define XBAR() do { XcdBarrier bar_; bar_.bar = (unsigned*)(p.ws + WS_BAR); bar_.x = xb_xcc_id(); bar_.st = (volatile LAS unsigned*)(L + 131072 + 64); int t_ = tid_of(wv); asm volatile("" : "+v"(t_)); xcd_barrier(bar_, t_ == 0); } while (0)
    volatile LAS unsigned* bst = (volatile LAS unsigned*)(L + 131072 + 64);
    if (threadIdx.x == 0) { bst[0] = 0u; bst[1] = 0u; }
    __syncthreads();
    (void)xcd_barrier_post((unsigned*)(p.ws + WS_BAR), bst);
    prologue(p, L, wv);
    grid.sync();
#pragma unroll 1
    for (int layer = 0; layer < NLAYER; ++layer) {
        { PHASE_VARS pg8::Gemm g{ly == 0 ? xb : (const bf16_t*)(ws + WS_XB2), (const bf16_t*)(wl + WL_FFA_IN), MT, NFF2, DM}; pg8::StaticOrder S; S.init(MT, NFF2, G, c); EpiSwiglu E{act, sq};
          pg8::gemm_phase<EpiSwiglu, pg8::StaticOrder, true, true>(L, g, S, E, wv); }
        XBAR();
        { PHASE_VARS pg8::Gemm g{act, (const bf16_t*)(wl + WL_FFA_OUT), MT, DM, DFF}; pg8::StaticOrder S; S.init(MT, DM, G, c);
          EpiResid<0> E{ly == 0 ? xb : (const bf16_t*)(ws + WS_XB2), xb, nullptr, sq + MT, 0.5f, nullptr, nullptr};
          pg8::gemm_phase<EpiResid<0>, pg8::StaticOrder, true, true>(L, g, S, E, wv); }
        XBAR();
        { PHASE_VARS pg8::Gemm g{xb, (const bf16_t*)(wl + WL_IN), MT, NIN, DM}; pg8::StaticOrder S; S.init(MT, NIN, G, c); EpiStore E{zb, NIN, sq + MT};
          pg8::gemm_phase<EpiStore, pg8::StaticOrder, true, true>(L, g, S, E, wv); }
        XBAR();
#pragma unroll 1
        for (int cu = c; cu < 1056; cu += G) { int Gl = G; asm volatile("" : "+s"(Gl)); const int un = (Gl == 256 && cu < 1024) ? ((cu & 255) << 2) + (cu >> 8) : cu; mixer_unit(p, layer, un, L, wv); }
        XBAR();
        { PHASE_VARS pg8::Gemm g{mixb, (const bf16_t*)(wl + WL_OUT), MT, DM, DM}; pg8::StaticOrder S; S.init(MT, DM, G, c);
          EpiResid<0> E{xb, xb, nullptr, sq + 2 * MT, 1.0f, nullptr, nullptr};
          pg8::gemm_phase<EpiResid<0>, pg8::StaticOrder, true, true>(L, g, S, E, wv); }
        XBAR();
        { PHASE_VARS pg8::Gemm g{xb, (const bf16_t*)(wl + WL_FFB_IN), MT, NFF2, DM}; pg8::StaticOrder S; S.init(MT, NFF2, G, c); EpiSwiglu E{act, sq + 2 * MT};
          pg8::gemm_phase<EpiSwiglu, pg8::StaticOrder, true, true>(L, g, S, E, wv); }
        XBAR();
        { PHASE_VARS pg8::Gemm g{act, (const bf16_t*)(wl + WL_FFB_OUT), MT, DM, DFF}; pg8::StaticOrder S; S.init(MT, DM, G, c);
          EpiResid<0> E{xb, xb, nullptr, sq + 3 * MT, 0.5f, nullptr, nullptr};
          pg8::gemm_phase<EpiResid<0>, pg8::StaticOrder, true, true>(L, g, S, E, wv); }
        int Gf = G, cf = c; asm volatile("" : "+s"(Gf), "+s"(cf));
        if (Gf == 256 ? cf >= 32 : true) { PHASE_VARS pg8::Gemm g{(const bf16_t*)(ws + WS_PB) + (size_t)ly * MT * PED, (const bf16_t*)(wl + WL_PEU), MT, DM, PED}; pg8::StaticOrder S;
          if (Gf == 256) S.init(MT, DM, 224, cf - 32); else S.init(MT, DM, Gf, cf);
          EpiStore E{(bf16_t*)(ws + WS_U2), DM, nullptr};
          pg8::gemm_phase<EpiStore, pg8::StaticOrder, true, true>(L, g, S, E, wv); }
        XBAR();
        { PHASE_VARS pg8::Gemm g{xb, (const bf16_t*)(wl + WL_PEG), MT, DM, DM}; pg8::StaticOrder S; S.init(MT, DM, G, c);
          EpiResid<1> E{xb, (bf16_t*)(ws + WS_XB2), ly + 1 < NLAYER ? nullptr : xres, sq + 4 * MT, 1.0f, (const bf16_t*)(ws + WS_U2), sq + 3 * MT};
          pg8::gemm_phase<EpiResid<1>, pg8::StaticOrder, true, true>(L, g, S, E, wv); }
        if (layer + 1 < NLAYER) XBAR();
    }
}

extern "C" void kernel_launch(void* const* d_in, const int* in_sizes, int n_in, void* d_out, int out_size, void* d_ws, size_t ws_size, hipStream_t stream) {
    static int grid = 0;
    if (grid == 0) {
        if (n_in != 24 || in_sizes[0] != MP * DM || (size_t)out_size != O_END || ws_size < WS_END) { fprintf(stderr, "kernel_launch: unexpected shapes (n_in %d, in0 %d, out %d, ws %zu)\n", n_in, n_in > 0 ? in_sizes[0] : -1, out_size, ws_size); grid = -1; return; }
        int dev = 0, cus = 0, per_cu = 0;
        if (hipGetDevice(&dev) != hipSuccess || hipDeviceGetAttribute(&cus, hipDeviceAttributeMultiprocessorCount, dev) != hipSuccess) { grid = -1; return; }
        if (hipFuncSetAttribute((const void*)hymba_fwd, hipFuncAttributeMaxDynamicSharedMemorySize, LDS_BYTES) != hipSuccess) { fprintf(stderr, "kernel_launch: hipFuncSetAttribute failed\n"); grid = -1; return; }
        if (hipOccupancyMaxActiveBlocksPerMultiprocessor(&per_cu, (const void*)hymba_fwd, 512, LDS_BYTES) != hipSuccess || per_cu < 1) { fprintf(stderr, "kernel_launch: occupancy query says %d\n", per_cu); per_cu = 1; }
        (void)hipGetLastError();
        grid = cus * 1;
    }
    if (grid < 0) return;
    if (hipMemsetAsync((char*)d_ws + WS_BAR, 0, 16384, stream) != hipSuccess) { fprintf(stderr, "kernel_launch: memset of the barrier words failed\n"); return; }
    Params p{};
    for (int i = 0; i < 24; ++i) p.in[i] = (const float*)d_in[i];
    p.out = (float*)d_out; p.ws = (unsigned char*)d_ws;
    void* args[] = {&p};
    hipError_t e = hipLaunchCooperativeKernel((const void*)hymba_fwd, dim3(grid), dim3(512), args, LDS_BYTES, stream);
    if (e != hipSuccess) fprintf(stderr, "kernel_launch: cooperative launch failed: %s (grid %d)\n", hipGetErrorString(e), grid);
}
```

```cpp
#include <hip/hip_runtime.h>
#include <hip/hip_cooperative_groups.h>
#include <cstdio>
#include <cstdint>
namespace cg = cooperative_groups;
__device__ __forceinline__ int tid_of(int wv) { return wv * 64 + (int)__builtin_amdgcn_mbcnt_hi(~0u, __builtin_amdgcn_mbcnt_lo(~0u, 0u)); }
namespace pg8 {
#define PG8_LAS __attribute__((address_space(3)))
typedef unsigned short bf16_t;
typedef short bf16x8 __attribute__((ext_vector_type(8)));
typedef float f32x4 __attribute__((ext_vector_type(4)));
typedef unsigned u32x4 __attribute__((ext_vector_type(4)));
constexpr int BM = 256, BK = 64, HALF = 128, HTB = HALF * BK * 2  , STAGE_BYTES = 8 * HTB, NXCD = 8, WGM = 8;

__host__ __device__ __forceinline__ int lds_byte(int r, int c) { const int st = (r >> 4) * 2 + (c >> 5), rr = r & 15, cc = c & 31, ob = rr * 64 + cc * 2; return st * 1024 + (ob ^ (((ob >> 9) & 1) << 5)); }
__host__ __device__ __forceinline__ void stage_rc(int b, int& R, int& C) { const int st = b / 1024, sb = b % 1024, swz = sb ^ (((sb >> 9) & 1) << 5); R = (st >> 1) * 16 + swz / 64; C = (st & 1) * 32 + (swz % 64) / 2; }
__host__ __device__ __forceinline__ int perm32(int rho) { const int n = rho >> 4, i = rho & 15; return 8 * (i >> 2) + 4 * n + (i & 3); }

struct Unit { int pm, pn; };
struct Gemm { const bf16_t* A; const bf16_t* Bt; int M, N, K; };

struct StaticOrder {
    int nM, nN, nwg, G, c;
    __host__ __device__ void init(int M, int N, int G_, int c_) { nM = M / BM; nN = N / BM; nwg = nM * nN; G = G_; c = c_; }
    __host__ __device__ bool next(int i, Unit& u) const {
        const int L = i * G + c; if (L >= nwg) return false;
        int wgid = L; { const int q = nwg / NXCD, r = nwg % NXCD, xcd = wgid % NXCD, off = wgid / NXCD; wgid = (xcd < r ? xcd * (q + 1) : r * (q + 1) + (xcd - r) * q) + off; }
        const int nig = WGM * nN, gid = wgid / nig, fm = gid * WGM, gsz = (nM - fm) < WGM ? (nM - fm) : WGM;
        u.pm = fm + ((wgid % nig) % gsz); u.pn = (wgid % nig) / gsz; return true;
    }
    __device__ __forceinline__ void a_ready(const Unit&) const {}
    __device__ __forceinline__ void done(const Unit&) const {}
};
__device__ __forceinline__ unsigned cvt_pk_bf16(float lo, float hi) { unsigned r; asm volatile("v_cvt_pk_bf16_f32 %0, %1, %2" : "=v"(r) : "v"(lo), "v"(hi)); return r; }
typedef float f32x2 __attribute__((ext_vector_type(2)));
template <class Epi, class Sched, bool ALIGN_EPI = false, bool SP2 = false>
__device__ __forceinline__ void gemm_phase(PG8_LAS unsigned char* lds, const Gemm g, const Sched& S, const Epi& E, int wv) {
    int tid_ = tid_of(wv); asm volatile("" : "+v"(tid_));
    const int tid = tid_, wid = __builtin_amdgcn_readfirstlane(tid >> 6), lane = tid & 63, wr = wid >> 2, wc = wid & 3, fr = lane & 15, fq = lane >> 4;
    const int K = g.K, nt = K / BK;
    unsigned voffA[2], voffB[2];
#pragma unroll
    for (int i = 0; i < 2; ++i) { int R, C; stage_rc(tid * 16 + i * 8192, R, C); const int Rb = Epi::PERM ? ((R & ~31) + perm32(R & 31)) : R;
        voffA[i] = (unsigned)(R * K + C) * 2u; voffB[i] = (unsigned)(Rb * K + C) * 2u; }
    const size_t kstep = (size_t)(BK * 2);
    const size_t hstep = (size_t)HALF * K * 2;
    const size_t tstep = 2 * hstep;
    const unsigned ldsw = (unsigned)wid * 1024u;
    const int aoff = lds_byte(wr * 64 + fr, fq * 8), boff = lds_byte(wc * 32 + fr, fq * 8);
#define PG8_SA(b, h) (((b) * 2 + (h)) * HTB)
#define PG8_SB(b, h) ((4 + (b) * 2 + (h)) * HTB)
#define PG8_STAGE(bufoff, gbase, voff) do { _Pragma("unroll") for (int _i = 0; _i < 2; ++_i) \
        __builtin_amdgcn_global_load_lds((const unsigned*)((const char*)(gbase) + (voff)[_i]), (PG8_LAS unsigned*)(lds + (bufoff) + ldsw + _i * 8192), 16, 0, 0); } while (0)
#define PG8_LDA(dst, b, h) do { _Pragma("unroll") for (int m = 0; m < 4; ++m) _Pragma("unroll") for (int k = 0; k < 2; ++k) dst[m][k] = *(const PG8_LAS bf16x8*)(lds + PG8_SA(b, h) + aoff + m * 2048 + k * 1024); } while (0)
#define PG8_LDB(dst, b, h) do { _Pragma("unroll") for (int n = 0; n < 2; ++n) _Pragma("unroll") for (int k = 0; k < 2; ++k) dst[n][k] = *(const PG8_LAS bf16x8*)(lds + PG8_SB(b, h) + boff + n * 2048 + k * 1024); } while (0)
#define PG8_MMA(ai, bj, At, Bt) do { __builtin_amdgcn_s_setprio(1); _Pragma("unroll") for (int m = 0; m < 4; ++m) _Pragma("unroll") for (int n = 0; n < 2; ++n) _Pragma("unroll") for (int k = 0; k < 2; ++k) \
        acc[ai][bj][m][n] = __builtin_amdgcn_mfma_f32_16x16x32_bf16(Bt[n][k], At[m][k], acc[ai][bj][m][n], 0, 0, 0); __builtin_amdgcn_s_setprio(0); } while (0)
#define PG8_WAIT_V(n) asm volatile("s_waitcnt vmcnt(" #n ")" ::: "memory")
#define PG8_WAIT_L(n) asm volatile("s_waitcnt lgkmcnt(" #n ")" ::: "memory")
#define PG8_BAR __builtin_amdgcn_s_barrier()
#define PG8_SCHED __builtin_amdgcn_sched_barrier(0)
    Unit cur, nxt; int ui = 0;
    if (!S.next(0, cur)) return;
    f32x4 acc[2][2][4][2];
#pragma unroll
    for (int a = 0; a < 2; ++a)
#pragma unroll
        for (int b = 0; b < 2; ++b)
#pragma unroll
            for (int m = 0; m < 4; ++m)
#pragma unroll
                for (int n = 0; n < 2; ++n) acc[a][b][m][n] = (f32x4){0.f, 0.f, 0.f, 0.f};
    bf16x8 At[4][2], B0[2][2], B1[2][2];
    const char* cA = (const char*)g.A + (size_t)cur.pm * tstep; const char* cB = (const char*)g.Bt + (size_t)cur.pn * tstep;
    S.a_ready(cur);
    if constexpr (SP2) {
        PG8_STAGE(PG8_SB(0, 0), cB, voffB); PG8_STAGE(PG8_SB(0, 1), cB + hstep, voffB); PG8_STAGE(PG8_SA(0, 0), cA, voffA); PG8_STAGE(PG8_SA(0, 1), cA + hstep, voffA);
        if (wr == 1) PG8_BAR;
        PG8_WAIT_V(2); PG8_BAR;
        PG8_STAGE(PG8_SB(1, 0), cB + kstep, voffB); PG8_STAGE(PG8_SA(1, 0), cA + kstep, voffA); PG8_STAGE(PG8_SB(1, 1), cB + hstep + kstep, voffB);
        PG8_WAIT_V(6); PG8_BAR;
    } else {
        PG8_STAGE(PG8_SB(0, 0), cB, voffB); PG8_STAGE(PG8_SA(0, 0), cA, voffA); PG8_STAGE(PG8_SB(0, 1), cB + hstep, voffB); PG8_STAGE(PG8_SA(0, 1), cA + hstep, voffA);
        if (wr == 1) PG8_BAR;
        PG8_WAIT_V(4); PG8_BAR;
        PG8_STAGE(PG8_SB(1, 0), cB + kstep, voffB); PG8_STAGE(PG8_SA(1, 0), cA + kstep, voffA); PG8_STAGE(PG8_SB(1, 1), cB + hstep + kstep, voffB);
        PG8_WAIT_V(6); PG8_BAR;
    }
    for (;;) {
        const bool has_next = S.next(ui + 1, nxt);
        const char* nA = has_next ? (const char*)g.A + (size_t)nxt.pm * tstep : cA; const char* nB = has_next ? (const char*)g.Bt + (size_t)nxt.pn * tstep : cB;
        for (int t = 0; t < nt; t += 2) {
            const bool last = (t == nt - 2);
            const char* a1 = cA + (size_t)(t + 1) * kstep;
            const char* a2 = last ? nA : cA + (size_t)(t + 2) * kstep; const char* b2 = last ? nB : cB + (size_t)(t + 2) * kstep;
            const char* a3 = a2 + kstep; const char* b3 = b2 + kstep;
            if (last && has_next) S.a_ready(nxt);
            if constexpr (SP2) {
            PG8_LDB(B0, 0, 0); PG8_LDB(B1, 0, 1); PG8_SCHED; PG8_LDA(At, 0, 0); PG8_STAGE(PG8_SA(1, 1), a1 + hstep, voffA);
            PG8_WAIT_V(8); PG8_WAIT_L(0); PG8_BAR; PG8_MMA(0, 0, At, B0); PG8_MMA(0, 1, At, B1); PG8_BAR; PG8_SCHED;
            PG8_LDA(At, 0, 1); PG8_STAGE(PG8_SB(0, 0), b2, voffB); PG8_STAGE(PG8_SB(0, 1), b2 + hstep, voffB); PG8_STAGE(PG8_SA(0, 0), a2, voffA);
            PG8_WAIT_V(8); PG8_WAIT_L(0); PG8_BAR; PG8_MMA(1, 0, At, B0); PG8_MMA(1, 1, At, B1); PG8_BAR; PG8_SCHED;
            PG8_LDB(B0, 1, 0); PG8_LDB(B1, 1, 1); PG8_SCHED; PG8_LDA(At, 1, 0); PG8_STAGE(PG8_SA(0, 1), a2 + hstep, voffA);
            PG8_WAIT_V(8); PG8_WAIT_L(0); PG8_BAR; PG8_MMA(0, 0, At, B0); PG8_MMA(0, 1, At, B1); PG8_BAR; PG8_SCHED;
            PG8_LDA(At, 1, 1); PG8_STAGE(PG8_SB(1, 0), b3, voffB); PG8_STAGE(PG8_SB(1, 1), b3 + hstep, voffB); PG8_STAGE(PG8_SA(1, 0), a3, voffA);
            PG8_WAIT_V(8); PG8_WAIT_L(0); PG8_BAR; PG8_MMA(1, 0, At, B0); PG8_MMA(1, 1, At, B1); PG8_BAR; PG8_SCHED;
            } else {
            PG8_LDB(B0, 0, 0); PG8_SCHED; PG8_LDA(At, 0, 0); PG8_STAGE(PG8_SA(1, 1), a1 + hstep, voffA);
            PG8_WAIT_L(8); PG8_BAR; PG8_WAIT_L(0); PG8_MMA(0, 0, At, B0); PG8_BAR; PG8_SCHED;
            PG8_LDB(B1, 0, 1); PG8_STAGE(PG8_SB(0, 0), b2, voffB);
            PG8_BAR; PG8_WAIT_L(0); PG8_MMA(0, 1, At, B1); PG8_BAR;
            PG8_LDA(At, 0, 1); PG8_STAGE(PG8_SA(0, 0), a2, voffA);
            PG8_BAR; PG8_WAIT_L(0); PG8_MMA(1, 0, At, B0); PG8_BAR; PG8_SCHED;
            PG8_STAGE(PG8_SB(0, 1), b2 + hstep, voffB);
            PG8_WAIT_V(6); PG8_BAR; PG8_MMA(1, 1, At, B1); PG8_BAR;
            PG8_LDB(B0, 1, 0); PG8_SCHED; PG8_LDA(At, 1, 0); PG8_STAGE(PG8_SA(0, 1), a2 + hstep, voffA);
            PG8_WAIT_L(8); PG8_BAR; PG8_WAIT_L(0); PG8_MMA(0, 0, At, B0); PG8_BAR; PG8_SCHED;
            PG8_LDB(B1, 1, 1); PG8_STAGE(PG8_SB(1, 0), b3, voffB);
            PG8_BAR; PG8_WAIT_L(0); PG8_MMA(0, 1, At, B1); PG8_BAR;
            PG8_LDA(At, 1, 1); PG8_STAGE(PG8_SA(1, 0), a3, voffA);
            PG8_BAR; PG8_WAIT_L(0); PG8_MMA(1, 0, At, B0); PG8_BAR; PG8_SCHED;
            PG8_STAGE(PG8_SB(1, 1), b3 + hstep, voffB);
            PG8_WAIT_V(6); PG8_BAR; PG8_MMA(1, 1, At, B1); PG8_BAR;
            }
        }
        if constexpr (ALIGN_EPI) { if (wr == 0) PG8_BAR; }
        if constexpr (!Epi::AFTER_DRAIN) { E(acc, cur, wr, wc, fr, fq); S.done(cur); }
        if (!has_next) break;
#pragma unroll
        for (int a = 0; a < 2; ++a)
#pragma unroll
            for (int b = 0; b < 2; ++b)
#pragma unroll
                for (int m = 0; m < 4; ++m)
#pragma unroll
                    for (int n = 0; n < 2; ++n) acc[a][b][m][n] = (f32x4){0.f, 0.f, 0.f, 0.f};
        cur = nxt; cA = nA; cB = nB; ++ui;
        if constexpr (ALIGN_EPI) { if (wr == 1) PG8_BAR; }
    }
    PG8_WAIT_V(0);
    if constexpr (!ALIGN_EPI) { if (wr == 0) PG8_BAR; }
    PG8_BAR;
    if constexpr (Epi::AFTER_DRAIN) { E.fused(acc, cur, wr, wc, fr, fq, lds, wid, lane); S.done(cur); }
#undef PG8_SA
#undef PG8_SB
#undef PG8_STAGE
#undef PG8_LDA
#undef PG8_LDB
#undef PG8_MMA
#undef PG8_WAIT_V
#undef PG8_WAIT_L
#undef PG8_BAR
#undef PG8_SCHED
}
}

#define LAS __attribute__((address_space(3)))
using pg8::f32x4; using pg8::u32x4; using pg8::bf16_t; using pg8::bf16x8; using pg8::Unit;
typedef float f32x2 __attribute__((ext_vector_type(2)));
typedef __bf16 bf16x2_t __attribute__((ext_vector_type(2)));
typedef unsigned u32x2 __attribute__((ext_vector_type(2)));
constexpr int DM = 1024, DFF = 2816, NFF2 = 5632, NIN = 1280, PED = 256;
constexpr int MP = 65536, MS = 2048, MT = MP + MS;
constexpr int NB = 32, SEQ = 2048, DSEQ = 64, NLAYER = 2;
constexpr float EPS = 1e-6f, LOG2E = 1.4426950408889634f;
constexpr size_t MiB = 1u << 20;
constexpr size_t WL_FFA_IN = 0, WL_FFA_OUT = 11 * MiB, WL_IN = WL_FFA_OUT + 5 * MiB + MiB / 2, WL_OUT = WL_IN + 2 * MiB + MiB / 2, WL_FFB_IN = WL_OUT + 2 * MiB,
                 WL_FFB_OUT = WL_FFB_IN + 11 * MiB, WL_PEG = WL_FFB_OUT + 5 * MiB + MiB / 2, WL_PEU = WL_PEG + 2 * MiB, WL_POOL = WL_PEU + MiB / 2, WL_STRIDE = 41 * MiB;
static_assert(WL_POOL + 131072 <= WL_STRIDE, "weights map");
constexpr size_t WS_W = 0, WS_XB = 82 * MiB, WS_ACT = 214 * MiB, WS_Z = WS_ACT, WS_MIX = WS_ACT + 165 * MiB, WS_U = WS_ACT, WS_PB = 577 * MiB, WS_SSQ = 643 * MiB, WS_ROPE = 646 * MiB, WS_BAR = 646 * MiB + 512 * 1024, WS_XB2 = 647 * MiB, WS_U2 = 779 * MiB, WS_END = 911 * MiB;
static_assert((size_t)MT * DM * 2 == 132 * MiB && (size_t)MT * DFF * 2 == 363 * MiB && (size_t)MT * NIN * 2 == 165 * MiB && (size_t)2 * MT * PED * 2 == 66 * MiB, "buffer sizes");
constexpr size_t O_Y = 0, O_KP = (size_t)MT * DM, O_VP = O_KP + 1048576, O_UP = O_VP + 1048576, O_KS = O_UP + 491520, O_VS = O_KS + 1048576, O_US = O_VS + 1048576, O_END = O_US + 491520;

struct Params {
    const float* in[24]; float* out; unsigned char* ws;
};
enum { I_XP = 0, I_XS, I_PP, I_PS, I_CK, I_CV, I_SP, I_NFFA, I_WFFA_IN, I_WFFA_OUT, I_NMIX, I_WIN, I_QN, I_KN, I_SINK, I_WPOOL, I_PSCALE, I_WOUT, I_NFFB, I_WFFB_IN, I_WFFB_OUT, I_NPE, I_WPEG, I_WPEU };

__device__ __forceinline__ unsigned pk2(float lo, float hi) { f32x2 v = {lo, hi}; bf16x2_t b = __builtin_convertvector(v, bf16x2_t); return __builtin_bit_cast(unsigned, b); }
__device__ __forceinline__ float bflo(unsigned w) { return __uint_as_float(w << 16); }
__device__ __forceinline__ float bfhi(unsigned w) { return __uint_as_float(w & 0xffff0000u); }
__device__ __forceinline__ float rstd_of(const float* ssq, int row) { return __builtin_amdgcn_rsqf(ssq[row] * (1.0f / 1024.0f) + EPS); }
__device__ __forceinline__ float silu_f(float g) { return g * __builtin_amdgcn_rcpf(1.0f + __builtin_amdgcn_exp2f(-LOG2E * g)); }
__device__ __forceinline__ float sigm_f(float g) { return __builtin_amdgcn_rcpf(1.0f + __builtin_amdgcn_exp2f(-LOG2E * g)); }
__device__ __forceinline__ float wave_sum(float v) {
#pragma unroll
    for (int o = 1; o < 64; o <<= 1) v += __shfl_xor(v, o);
    return v;
}

struct EpiSwiglu {
    static constexpr bool PERM = true, AFTER_DRAIN = false;
    bf16_t* act; const float* ssq;
    __device__ __forceinline__ void operator()(const f32x4 (&acc)[2][2][4][2], const Unit& u, int wr, int wc, int fr, int fq) const {
        const int row0 = u.pm * 256 + wr * 64 + fr, col0 = u.pn * 128 + wc * 32 + 8 * fq;
#pragma unroll
        for (int ai = 0; ai < 2; ++ai)
#pragma unroll
            for (int m = 0; m < 4; ++m) {
                const int row = row0 + ai * 128 + m * 16; const float rs = rstd_of(ssq, row);
                const f32x4 g0 = acc[ai][0][m][0] * rs, g1 = acc[ai][0][m][1] * rs, u0 = acc[ai][1][m][0] * rs, u1 = acc[ai][1][m][1] * rs;
                u32x4 w;
                w.x = pk2(silu_f(g0[0]) * u0[0], silu_f(g0[1]) * u0[1]); w.y = pk2(silu_f(g0[2]) * u0[2], silu_f(g0[3]) * u0[3]);
                w.z = pk2(silu_f(g1[0]) * u1[0], silu_f(g1[1]) * u1[1]); w.w = pk2(silu_f(g1[2]) * u1[2], silu_f(g1[3]) * u1[3]);
                *(u32x4*)(act + (size_t)row * DFF + col0) = w;
            }
    }
};
struct EpiStore {
    static constexpr bool PERM = true, AFTER_DRAIN = false;
    bf16_t* O; int ldc; const float* ssq;
    __device__ __forceinline__ void operator()(const f32x4 (&acc)[2][2][4][2], const Unit& u, int wr, int wc, int fr, int fq) const {
        const int row0 = u.pm * 256 + wr * 64 + fr, col0 = u.pn * 256 + wc * 32 + 8 * fq;
#pragma unroll
        for (int ai = 0; ai < 2; ++ai)
#pragma unroll
            for (int m = 0; m < 4; ++m) {
                const int row = row0 + ai * 128 + m * 16; const float rs = ssq ? rstd_of(ssq, row) : 1.0f;
#pragma unroll
                for (int bj = 0; bj < 2; ++bj) {
                    const f32x4 v0 = acc[ai][bj][m][0] * rs, v1 = acc[ai][bj][m][1] * rs;
                    u32x4 w; w.x = pk2(v0[0], v0[1]); w.y = pk2(v0[2], v0[3]); w.z = pk2(v1[0], v1[1]); w.w = pk2(v1[2], v1[3]);
                    *(u32x4*)(O + (size_t)row * ldc + col0 + bj * 128) = w;
                }
            }
    }
};
template <int MODE> struct EpiResid {
    static constexpr bool PERM = true, AFTER_DRAIN = false;
    const bf16_t* xi; bf16_t* xo; float* yout; float* ssq_next; float scale; const bf16_t* U; const float* ssq_cur;
    __device__ __forceinline__ void operator()(const f32x4 (&acc)[2][2][4][2], const Unit& u, int wr, int wc, int fr, int fq) const {
        const int row0 = u.pm * 256 + wr * 64 + fr, col0 = u.pn * 256 + wc * 32 + 8 * fq;
#pragma unroll
        for (int ai = 0; ai < 2; ++ai)
#pragma unroll
            for (int m = 0; m < 4; ++m) {
                const int row = row0 + ai * 128 + m * 16; const size_t off = (size_t)row * DM + col0;
                const float rs = (MODE == 1) ? rstd_of(ssq_cur, row) : 0.f; float ss = 0.f;
#pragma unroll
                for (int bj = 0; bj < 2; ++bj) {
                    const u32x4 xw = *(const u32x4*)(xi + off + bj * 128);
                    f32x4 a0 = acc[ai][bj][m][0], a1 = acc[ai][bj][m][1];
                    if (MODE == 1) {
                        const u32x4 uu = *(const u32x4*)(U + off + bj * 128);
                        a0[0] = sigm_f(a0[0] * rs) * bflo(uu.x); a0[1] = sigm_f(a0[1] * rs) * bfhi(uu.x); a0[2] = sigm_f(a0[2] * rs) * bflo(uu.y); a0[3] = sigm_f(a0[3] * rs) * bfhi(uu.y);
                        a1[0] = sigm_f(a1[0] * rs) * bflo(uu.z); a1[1] = sigm_f(a1[1] * rs) * bfhi(uu.z); a1[2] = sigm_f(a1[2] * rs) * bflo(uu.w); a1[3] = sigm_f(a1[3] * rs) * bfhi(uu.w);
                    } else { a0 = a0 * scale; a1 = a1 * scale; }
                    const f32x4 v0 = (f32x4){bflo(xw.x), bfhi(xw.x), bflo(xw.y), bfhi(xw.y)} + a0, v1 = (f32x4){bflo(xw.z), bfhi(xw.z), bflo(xw.w), bfhi(xw.w)} + a1;
                    if (yout) { *(f32x4*)(yout + off + bj * 128) = v0; *(f32x4*)(yout + off + bj * 128 + 4) = v1; }
                    else {
                        u32x4 w; w.x = pk2(v0[0], v0[1]); w.y = pk2(v0[2], v0[3]); w.z = pk2(v1[0], v1[1]); w.w = pk2(v1[2], v1[3]);
                        *(u32x4*)(xo + off + bj * 128) = w;
                        ss += (v0[0] * v0[0] + v0[1] * v0[1]) + (v0[2] * v0[2] + v0[3] * v0[3]) + (v1[0] * v1[0] + v1[1] * v1[1]) + (v1[2] * v1[2] + v1[3] * v1[3]);
                    }
                }
                if (!yout) { ss += __shfl_xor(ss, 16); ss += __shfl_xor(ss, 32);
                    if (fq == 0) __hip_atomic_fetch_add(ssq_next + row, ss, __ATOMIC_RELAXED, __HIP_MEMORY_SCOPE_AGENT); }
                if (m & 1) asm volatile("" ::: "memory");
            }
    }
};

__device__ __forceinline__ void transpose_item(const float* W, int K, int N, bf16_t* WT, const float* gk, int mode, LAS float* scr_, int item, int lane) {
    LAS unsigned* scr = (LAS unsigned*)scr_;
    const int nblk = N / 64, kb = item / nblk, nb = item % nblk, k0 = 64 * kb, n0 = 64 * nb;
    const int sc = (mode == 1) ? (((n0 >> 7) & 1) * DFF + (n0 >> 8) * 128 + (n0 & 127)) : n0;
    const float* src = W + (size_t)k0 * N + sc + lane;
    float va[32], vb[32];
#pragma unroll
    for (int kp = 0; kp < 32; ++kp) { va[kp] = src[(size_t)(2 * kp) * N]; vb[kp] = src[(size_t)(2 * kp + 1) * N]; }
#pragma unroll
    for (int kp = 0; kp < 32; ++kp) {
        float a = va[kp], b = vb[kp];
        if (gk) { a *= gk[k0 + 2 * kp]; b *= gk[k0 + 2 * kp + 1]; }
        scr[kp * 65 + lane] = pk2(a, b);
    }
    asm volatile("s_waitcnt lgkmcnt(0)" ::: "memory");
    const int c = lane & 7;
#pragma unroll
    for (int j = 0; j < 8; ++j) { const int r = (lane >> 3) + 8 * j; const LAS unsigned* q = scr + (4 * c) * 65 + r;
        u32x4 o; o.x = q[0]; o.y = q[65]; o.z = q[130]; o.w = q[195];
        *(u32x4*)(WT + (size_t)(n0 + r) * K + k0 + 8 * c) = o; }
    asm volatile("s_waitcnt lgkmcnt(0)" ::: "memory");
}
__device__ __forceinline__ float rope_inv(int i) {
    return i == 0 ? 1.0f : i == 1 ? 0.1939227432012558f : i == 2 ? 0.03760603070259094f : i == 3 ? 0.007292664609849453f : i == 4 ? 0.0014142135623842478f : i == 5 ? 0.00027424818836152554f : i == 6 ? 5.3182957344688475e-05f : 1.0313385246263351e-05f;
}
__device__ __forceinline__ void sincos_d(float angf, float& c, float& s) {
    const double a = (double)angf; const double n = __builtin_rint(a * 0.63661977236758134308);
    const double r = __builtin_fma(-n, 1.5707963267948966192, a) - n * 6.123233995736766e-17; const double r2 = r * r;
    double sp = -7.6471637318198164759e-13; sp = sp * r2 + 1.6059043836821614599e-10; sp = sp * r2 - 2.5052108385441718775e-8; sp = sp * r2 + 2.7557319223985890653e-6; sp = sp * r2 - 1.9841269841269841270e-4; sp = sp * r2 + 8.3333333333333333333e-3; sp = sp * r2 - 1.6666666666666666667e-1;
    const double sn = r + r * r2 * sp;
    double cp = 4.7794773323873852974e-14; cp = cp * r2 - 1.1470745597729724714e-11; cp = cp * r2 + 2.0876756987868098979e-9; cp = cp * r2 - 2.7557319223985890653e-7; cp = cp * r2 + 2.4801587301587301587e-5; cp = cp * r2 - 1.3888888888888888889e-3; cp = cp * r2 + 4.1666666666666666667e-2; cp = cp * r2 - 0.5;
    const double cs = 1.0 + r2 * cp;
    const int q = ((int)n) & 3;
    const double cc = (q == 0) ? cs : (q == 1) ? -sn : (q == 2) ? -cs : sn;
    const double ss = (q == 0) ? sn : (q == 1) ? cs : (q == 2) ? -sn : -cs;
    c = (float)cc; s = (float)ss;
}
__device__ __forceinline__ void prologue(const Params& p, LAS unsigned char* L, int wv) {
    const int tid = tid_of(wv), lane = tid & 63, wave = __builtin_amdgcn_readfirstlane(tid >> 6);
    const int G = gridDim.x, gw = blockIdx.x * 8 + wave, NGW = G * 8; const int gt = blockIdx.x * 512 + tid, NGT = G * 512;
    LAS float* scr = (LAS float*)(L + wave * 16384);
    unsigned char* ws = p.ws;
    constexpr int I_FI = 16 * 88, I_FO = 44 * 16, I_IN = 16 * 20, I_O = 16 * 16, I_PG = 16 * 16, I_PU = 4 * 16;
    constexpr int PER_LAYER = 2 * I_FI + 2 * I_FO + I_IN + I_O + I_PG + I_PU;
    for (int it = gw; it < NLAYER * PER_LAYER; it += NGW) {
        const int l = it / PER_LAYER; int r = it % PER_LAYER; unsigned char* wl = ws + WS_W + (size_t)l * WL_STRIDE;
        if (r < I_FI) { transpose_item(p.in[I_WFFA_IN] + (size_t)l * DM * NFF2, DM, NFF2, (bf16_t*)(wl + WL_FFA_IN), p.in[I_NFFA] + l * DM, 1, scr, r, lane); continue; } r -= I_FI;
        if (r < I_FI) { transpose_item(p.in[I_WFFB_IN] + (size_t)l * DM * NFF2, DM, NFF2, (bf16_t*)(wl + WL_FFB_IN), p.in[I_NFFB] + l * DM, 1, scr, r, lane); continue; } r -= I_FI;
        if (r < I_FO) { transpose_item(p.in[I_WFFA_OUT] + (size_t)l * DFF * DM, DFF, DM, (bf16_t*)(wl + WL_FFA_OUT), nullptr, 0, scr, r, lane); continue; } r -= I_FO;
        if (r < I_FO) { transpose_item(p.in[I_WFFB_OUT] + (size_t)l * DFF * DM, DFF, DM, (bf16_t*)(wl + WL_FFB_OUT), nullptr, 0, scr, r, lane); continue; } r -= I_FO;
        if (r < I_IN) { transpose_item(p.in[I_WIN] + (size_t)l * DM * NIN, DM, NIN, (bf16_t*)(wl + WL_IN), p.in[I_NMIX] + l * DM, 0, scr, r, lane); continue; } r -= I_IN;
        if (r < I_O) { transpose_item(p.in[I_WOUT] + (size_t)l * DM * DM, DM, DM, (bf16_t*)(wl + WL_OUT), nullptr, 0, scr, r, lane); continue; } r -= I_O;
        if (r < I_PG) { transpose_item(p.in[I_WPEG] + (size_t)l * DM * DM, DM, DM, (bf16_t*)(wl + WL_PEG), p.in[I_NPE] + l * DM, 0, scr, r, lane); continue; } r -= I_PG;
        transpose_item(p.in[I_WPEU] + (size_t)l * PED * DM, PED, DM, (bf16_t*)(wl + WL_PEU), nullptr, 0, scr, r, lane);
    }
    for (int t = gt; t < NLAYER * 4 * 128 * 16; t += NGT) {
        const int ko = t & 15, n = (t >> 4) & 127, g = (t >> 11) & 3, l = t >> 13;
        const float* src = p.in[I_WPOOL] + ((size_t)(l * 4 + g) * 128 + 8 * ko) * 128 + n; const float sc = p.in[I_PSCALE][l * 512 + g * 128 + n];
        u32x4 o; o.x = pk2(src[0] * sc, src[128] * sc); o.y = pk2(src[256] * sc, src[384] * sc); o.z = pk2(src[512] * sc, src[640] * sc); o.w = pk2(src[768] * sc, src[896] * sc);
        *(u32x4*)((bf16_t*)(ws + WS_W + (size_t)l * WL_STRIDE + WL_POOL) + ((size_t)g * 128 + n) * 128 + 8 * ko) = o;
    }
    bf16_t* xb = (bf16_t*)(ws + WS_XB); float* ssq = (float*)(ws + WS_SSQ);
    for (int m0 = 4 * gw; m0 < MT; m0 += 4 * NGW) {
        const float* xr = (m0 < MP) ? p.in[I_XP] + (size_t)m0 * DM : p.in[I_XS] + (size_t)(m0 - MP) * DM;
        f32x4 v[4][4];
#pragma unroll
        for (int r = 0; r < 4; ++r)
#pragma unroll
            for (int j = 0; j < 4; ++j) v[r][j] = *((const f32x4*)(xr + (size_t)r * DM) + lane + 64 * j);
#pragma unroll
        for (int r = 0; r < 4; ++r) {
            float sq = 0.f;
#pragma unroll
            for (int j = 0; j < 4; ++j) sq += (v[r][j][0] * v[r][j][0] + v[r][j][1] * v[r][j][1]) + (v[r][j][2] * v[r][j][2] + v[r][j][3] * v[r][j][3]);
            sq = wave_sum(sq);
#pragma unroll
            for (int j = 0; j < 4; ++j) { u32x2 o; o.x = pk2(v[r][j][0], v[r][j][1]); o.y = pk2(v[r][j][2], v[r][j][3]); *((u32x2*)(xb + (size_t)(m0 + r) * DM) + lane + 64 * j) = o; }
            if (lane == 0) ssq[m0 + r] = sq;
        }
    }
    for (int t = gt; t < 8 * MT / 4; t += NGT) *((f32x4*)(ssq + MT) + t) = (f32x4){0.f, 0.f, 0.f, 0.f};
    bf16_t* pb = (bf16_t*)(ws + WS_PB);
    for (int t0 = gt; t0 < NLAYER * MT * 32; t0 += 4 * NGT) {
        f32x4 a[4], b[4]; size_t dsto[4];
#pragma unroll
        for (int u = 0; u < 4; ++u) {
            const int t = min(t0 + u * NGT, NLAYER * MT * 32 - 1);
            const int o8 = t & 31, m = (t >> 5) % MT, l = (t >> 5) / MT;
            const float* src = ((m < MP) ? p.in[I_PP] + ((size_t)l * MP + m) * PED : p.in[I_PS] + ((size_t)l * MS + (m - MP)) * PED) + 8 * o8;
            a[u] = *(const f32x4*)src; b[u] = *(const f32x4*)(src + 4); dsto[u] = ((size_t)l * MT + m) * PED + 8 * o8;
        }
#pragma unroll
        for (int u = 0; u < 4; ++u) { u32x4 o; o.x = pk2(a[u][0], a[u][1]); o.y = pk2(a[u][2], a[u][3]); o.z = pk2(b[u][0], b[u][1]); o.w = pk2(b[u][2], b[u][3]); *(u32x4*)(pb + dsto[u]) = o; }
    }
    float* rope = (float*)(ws + WS_ROPE);
    for (int t = gt; t < 2112 * 8; t += NGT) {
        const int i = t & 7, idx = t >> 3, pos = idx < 2048 ? idx : 4096 + idx - 2048;
        const float ang = (float)pos * rope_inv(i); float c, s; sincos_d(ang, c, s);
        rope[idx * 16 + i] = c; rope[idx * 16 + 8 + i] = s;
    }
}

constexpr int KROW = 72, DROW = 520;
constexpr int LK_OFF = 0, LV_OFF = 2 * 192 * KROW * 2, LMIX_END = 2 * LV_OFF;
static_assert(LMIX_END <= 131072 && 64 * DROW * 2 <= 131072, "mixer LDS");
typedef short v4i16_t __attribute__((ext_vector_type(4)));
__device__ __forceinline__ u32x2 tr_read(const LAS unsigned char* q) { const v4i16_t r = __builtin_amdgcn_ds_read_tr16_b64_v4i16((LAS v4i16_t*)q); return __builtin_bit_cast(u32x2, r); }
__device__ __forceinline__ bf16x8 pack8(const float* v) { u32x4 w; w.x = pk2(v[0], v[1]); w.y = pk2(v[2], v[3]); w.z = pk2(v[4], v[5]); w.w = pk2(v[6], v[7]); return __builtin_bit_cast(bf16x8, w); }
__device__ __forceinline__ void unpack8(u32x4 w, float* v) { v[0] = bflo(w.x); v[1] = bfhi(w.x); v[2] = bflo(w.y); v[3] = bfhi(w.y); v[4] = bflo(w.z); v[5] = bfhi(w.z); v[6] = bflo(w.w); v[7] = bfhi(w.w); }

template <int W> __device__ __forceinline__ void pool_stage(const Params& p, const bf16_t* z, int layer, bool is_s, int b, int c, int tok0, int g, int half, int lane, LAS unsigned char* L) {
    const int oct = lane & 15, tq = lane >> 4, c0 = 128 * g + 8 * oct, t0 = 32 * half + 8 * tq;
    const float* sp = p.in[I_SP] + ((size_t)layer * NB + b) * 15 * 512 + c0;
    u32x4 raw[W + 7];
#pragma unroll
    for (int j = 0; j < W + 7; ++j) {
        const int t = t0 - (W - 1) + j;
        u32x4 r = {0u, 0u, 0u, 0u};
        if (t >= 0 || (!is_s && c * 64 + t >= 0)) r = *(const u32x4*)(z + (size_t)(tok0 + t) * NIN + 768 + c0);
        else if (is_s) { const f32x4 a = *(const f32x4*)(sp + (15 + t) * 512), bb = *(const f32x4*)(sp + (15 + t) * 512 + 4); r.x = pk2(a[0], a[1]); r.y = pk2(a[2], a[3]); r.z = pk2(bb[0], bb[1]); r.w = pk2(bb[2], bb[3]); }
        raw[j] = r;
    }
    float sum[8];
#pragma unroll
    for (int i = 0; i < 8; ++i) sum[i] = 0.f;
#pragma unroll
    for (int j = 0; j < W - 1; ++j) { float u[8]; unpack8(raw[j], u);
#pragma unroll
        for (int i = 0; i < 8; ++i) sum[i] += u[i]; }
#pragma unroll
    for (int ti = 0; ti < 8; ++ti) {
        const int t = t0 + ti; float u[8], ul[8], d[8]; unpack8(raw[W - 1 + ti], u); unpack8(raw[ti], ul);
        const int cnt = is_s ? W : min(c * 64 + t + 1, W); const float rc = 1.0f / (float)cnt;
#pragma unroll
        for (int i = 0; i < 8; ++i) { sum[i] += u[i]; d[i] = sum[i] * rc - u[i]; sum[i] -= ul[i]; }
        *(LAS bf16x8*)(L + (t * DROW + c0) * 2) = pack8(d);
        if (t >= 49 && (is_s || c == 31)) { float* o = p.out + (is_s ? O_US : O_UP) + (((size_t)layer * NB + b) * 15 + (t - 49)) * 512 + c0;
            *(f32x4*)o = (f32x4){u[0], u[1], u[2], u[3]}; *(f32x4*)(o + 4) = (f32x4){u[4], u[5], u[6], u[7]}; }
    }
}

__device__ __forceinline__ void mixer_unit(const Params& p, int layer, int cu, LAS unsigned char* L, int wv) {
    int tid_ = tid_of(wv); asm volatile("" : "+v"(tid_));
    const int tid = tid_, lane = tid & 63, wave = __builtin_amdgcn_readfirstlane(tid >> 6);
    const bool is_s = cu >= 1024;
    const int b = is_s ? cu - 1024 : (cu >> 5), c = is_s ? 0 : (cu & 31);
    const int tok0 = is_s ? MP + b * 64 : b * SEQ + c * 64;
    const int kstart = is_s ? 0 : (c >= 2 ? 0 : (2 - c) * 64);
    const int pidx0 = is_s ? 2048 : c * 64;
    const bf16_t* z = (const bf16_t*)(p.ws + WS_Z); bf16_t* mix = (bf16_t*)(p.ws + WS_MIX);
    const float* rope = (const float*)(p.ws + WS_ROPE);
    const int q16 = lane & 15, quad = lane >> 4, h = wave, kvhq = h >> 2;
    const int piece = tid & 31, rsub = tid >> 5, sub = piece & 7, kvh = (piece >> 3) & 1; const bool isK = piece < 16;
    const int klo = is_s ? 128 : kstart, npass = (192 - klo) >> 4;
    u32x4 raw[12], qraw[4][2];
#pragma unroll
    for (int ps = 0; ps < 12; ++ps) if (ps < npass) raw[ps] = *(const u32x4*)(z + (size_t)(tok0 + klo + 16 * ps + rsub - 128) * NIN + 512 + piece * 8);
    if (is_s) {
#pragma unroll 1
        for (int ps = 0; ps < 8; ++ps) {
            const int kk = 16 * ps + rsub; const size_t o = ((((size_t)layer * NB + b) * 128 + kk) * 2 + kvh) * 64 + sub * 8;
            const float* src = (isK ? p.in[I_CK] : p.in[I_CV]) + o;
            const f32x4 a0 = *(const f32x4*)src, a1 = *(const f32x4*)(src + 4);
            float v[8] = {a0[0], a0[1], a0[2], a0[3], a1[0], a1[1], a1[2], a1[3]};
            *(LAS bf16x8*)(L + (isK ? LK_OFF : LV_OFF) + ((kvh * 192 + kk) * KROW + sub * 8) * 2) = pack8(v);
            if (kk >= 64) { float* dst = p.out + (isK ? O_KS : O_VS) + ((((size_t)layer * NB + b) * 128 + (kk - 64)) * 2 + kvh) * 64 + sub * 8; *(f32x4*)dst = a0; *(f32x4*)(dst + 4) = a1; }
        }
    }
    {
        float kn[8];
#pragma unroll
        for (int i = 0; i < 8; ++i) kn[i] = p.in[I_KN][layer * 64 + sub * 8 + i];
#pragma unroll
        for (int ps = 0; ps < 12; ++ps) if (ps < npass) {
            const int kk = klo + 16 * ps + rsub;
            float v[8]; unpack8(raw[ps], v);
            float ss = 0.f;
#pragma unroll
            for (int i = 0; i < 8; ++i) ss += v[i] * v[i];
            ss += __shfl_xor(ss, 1); ss += __shfl_xor(ss, 2); ss += __shfl_xor(ss, 4);
            const float rs = __builtin_amdgcn_rsqf(ss * (1.0f / 64.0f) + EPS);
            float pv[8];
#pragma unroll
            for (int i = 0; i < 8; ++i) { if (isK) v[i] = v[i] * rs * kn[i]; pv[i] = __shfl_xor(v[i], 1); }
            if (isK && sub < 2) {
                const float* rt = rope + (size_t)(pidx0 + kk - 128) * 16;
                const f32x4 c0 = *(const f32x4*)rt, c1 = *(const f32x4*)(rt + 4), s0 = *(const f32x4*)(rt + 8), s1 = *(const f32x4*)(rt + 12);
#pragma unroll
                for (int i = 0; i < 8; ++i) { const float cs = i < 4 ? c0[i & 3] : c1[i & 3], sn = i < 4 ? s0[i & 3] : s1[i & 3]; v[i] = (sub == 0) ? v[i] * cs - pv[i] * sn : v[i] * cs + pv[i] * sn; }
            }
            *(LAS bf16x8*)(L + (isK ? LK_OFF : LV_OFF) + ((kvh * 192 + kk) * KROW + sub * 8) * 2) = pack8(v);
            int orow = -1;
            if (is_s) orow = kk - 64; else if (c >= 30 && kk >= 128) orow = (c - 30) * 64 + (kk - 128);
            if (orow >= 0) {
                float* dst = p.out + (isK ? (is_s ? O_KS : O_KP) : (is_s ? O_VS : O_VP)) + ((((size_t)layer * NB + b) * 128 + orow) * 2 + kvh) * 64 + sub * 8;
                *(f32x4*)dst = (f32x4){v[0], v[1], v[2], v[3]}; *(f32x4*)(dst + 4) = (f32x4){v[4], v[5], v[6], v[7]};
            }
        }
    }
#pragma unroll
    for (int qb = 0; qb < 4; ++qb) { const bf16_t* qp = z + (size_t)(tok0 + 16 * qb + q16) * NIN + h * 64 + 8 * quad; qraw[qb][0] = *(const u32x4*)qp; qraw[qb][1] = *(const u32x4*)(qp + 32); }
    bf16x8 qf[4][2];
    {
        float gq0[8], gq1[8];
#pragma unroll
        for (int i = 0; i < 8; ++i) { gq0[i] = p.in[I_QN][layer * 64 + 8 * quad + i]; gq1[i] = p.in[I_QN][layer * 64 + 32 + 8 * quad + i]; }
        constexpr float QS = 0.125f * LOG2E;
#pragma unroll
        for (int qb = 0; qb < 4; ++qb) {
            float v0[8], v1[8]; unpack8(qraw[qb][0], v0); unpack8(qraw[qb][1], v1);
            float ss = 0.f;
#pragma unroll
            for (int i = 0; i < 8; ++i) ss += v0[i] * v0[i] + v1[i] * v1[i];
            ss += __shfl_xor(ss, 16); ss += __shfl_xor(ss, 32);
            const float rs = __builtin_amdgcn_rsqf(ss * (1.0f / 64.0f) + EPS);
            float pv[8];
#pragma unroll
            for (int i = 0; i < 8; ++i) { v0[i] = v0[i] * rs * gq0[i]; v1[i] = v1[i] * rs * gq1[i] * QS; pv[i] = __shfl_xor(v0[i], 16); }
            if (quad < 2) {
                const float* rt = rope + (size_t)(pidx0 + 16 * qb + q16) * 16;
                const f32x4 c0 = *(const f32x4*)rt, c1 = *(const f32x4*)(rt + 4), s0 = *(const f32x4*)(rt + 8), s1 = *(const f32x4*)(rt + 12);
#pragma unroll
                for (int i = 0; i < 8; ++i) { const float cs = i < 4 ? c0[i & 3] : c1[i & 3], sn = i < 4 ? s0[i & 3] : s1[i & 3]; v0[i] = (quad == 0) ? v0[i] * cs - pv[i] * sn : v0[i] * cs + pv[i] * sn; }
            }
#pragma unroll
            for (int i = 0; i < 8; ++i) v0[i] *= QS;
            qf[qb][0] = pack8(v0); qf[qb][1] = pack8(v1);
        }
    }
    __syncthreads();
    {
        const float sinkv = p.in[I_SINK][layer * 8 + h] * LOG2E;
        const LAS unsigned char* Kb = L + LK_OFF + ((kvhq * 192 + q16) * KROW + 8 * quad) * 2;
        const LAS unsigned char* Vb = L + LV_OFF + ((kvhq * 192 + 4 * quad + (q16 >> 2)) * KROW + 4 * (q16 & 3)) * 2;
#pragma unroll
        for (int pr = 0; pr < 2; ++pr) {
            f32x4 s[2][12];
#pragma unroll
            for (int kt = 0; kt < 12; ++kt) {
                if (16 * kt >= kstart) {
                    const bf16x8 k0 = *(const LAS bf16x8*)(Kb + kt * 16 * KROW * 2), k1 = *(const LAS bf16x8*)(Kb + kt * 16 * KROW * 2 + 64);
#pragma unroll
                    for (int e = 0; e < 2; ++e) { s[e][kt] = __builtin_amdgcn_mfma_f32_16x16x32_bf16(k0, qf[2 * pr + e][0], (f32x4){0.f, 0.f, 0.f, 0.f}, 0, 0, 0);
                        s[e][kt] = __builtin_amdgcn_mfma_f32_16x16x32_bf16(k1, qf[2 * pr + e][1], s[e][kt], 0, 0, 0); }
                } else { s[0][kt] = (f32x4){-1e30f, -1e30f, -1e30f, -1e30f}; s[1][kt] = s[0][kt]; }
            }
            float inv[2];
#pragma unroll
            for (int e = 0; e < 2; ++e) {
                float mx = sinkv;
#pragma unroll
                for (int kt = 0; kt < 12; ++kt) mx = fmaxf(fmaxf(mx, fmaxf(s[e][kt][0], s[e][kt][1])), fmaxf(s[e][kt][2], s[e][kt][3]));
                mx = fmaxf(mx, __shfl_xor(mx, 16)); mx = fmaxf(mx, __shfl_xor(mx, 32));
                float l = 0.f;
#pragma unroll
                for (int kt = 0; kt < 12; ++kt)
#pragma unroll
                    for (int j = 0; j < 4; ++j) { s[e][kt][j] = __builtin_amdgcn_exp2f(s[e][kt][j] - mx); l += s[e][kt][j]; }
                l += __shfl_xor(l, 16); l += __shfl_xor(l, 32);
                l += __builtin_amdgcn_exp2f(sinkv - mx);
                inv[e] = 1.0f / l;
            }
            f32x4 o[2][4];
#pragma unroll
            for (int e = 0; e < 2; ++e)
#pragma unroll
                for (int dt = 0; dt < 4; ++dt) o[e][dt] = (f32x4){0.f, 0.f, 0.f, 0.f};
#pragma unroll
            for (int si = 0; si < 6; ++si) {
                if (32 * si >= kstart) {
                    bf16x8 pf[2];
#pragma unroll
                    for (int e = 0; e < 2; ++e) { u32x4 pw; pw.x = pk2(s[e][2 * si][0], s[e][2 * si][1]); pw.y = pk2(s[e][2 * si][2], s[e][2 * si][3]); pw.z = pk2(s[e][2 * si + 1][0], s[e][2 * si + 1][1]); pw.w = pk2(s[e][2 * si + 1][2], s[e][2 * si + 1][3]); pf[e] = __builtin_bit_cast(bf16x8, pw); }
#pragma unroll
                    for (int dt = 0; dt < 4; ++dt) {
                        const u32x2 a = tr_read(Vb + ((32 * si) * KROW + 16 * dt) * 2), bq = tr_read(Vb + ((32 * si + 16) * KROW + 16 * dt) * 2);
                        const u32x4 vw = {a.x, a.y, bq.x, bq.y}; const bf16x8 vf = __builtin_bit_cast(bf16x8, vw);
#pragma unroll
                        for (int e = 0; e < 2; ++e) o[e][dt] = __builtin_amdgcn_mfma_f32_16x16x32_bf16(vf, pf[e], o[e][dt], 0, 0, 0);
                    }
                }
            }
#pragma unroll
            for (int e = 0; e < 2; ++e) { const int row = tok0 + 16 * (2 * pr + e) + q16;
#pragma unroll
                for (int dt = 0; dt < 4; ++dt) { u32x2 w; w.x = pk2(o[e][dt][0] * inv[e], o[e][dt][1] * inv[e]); w.y = pk2(o[e][dt][2] * inv[e], o[e][dt][3] * inv[e]);
                    *(u32x2*)(mix + (size_t)row * DM + h * 64 + 16 * dt + 4 * quad) = w; } }
        }
    }
    __syncthreads();
    {
        const int g = wave >> 1, half = wave & 1;
        if (g == 0) pool_stage<2>(p, z, layer, is_s, b, c, tok0, g, half, lane, L);
        else if (g == 1) pool_stage<4>(p, z, layer, is_s, b, c, tok0, g, half, lane, L);
        else if (g == 2) pool_stage<8>(p, z, layer, is_s, b, c, tok0, g, half, lane, L);
        else pool_stage<16>(p, z, layer, is_s, b, c, tok0, g, half, lane, L);
    }
    __syncthreads();
    {
        const int g = wave >> 1, th = wave & 1;
        bf16x8 dfr[2][4];
#pragma unroll
        for (int tb = 0; tb < 2; ++tb)
#pragma unroll
            for (int ks = 0; ks < 4; ++ks) dfr[tb][ks] = *(const LAS bf16x8*)(L + ((32 * th + 16 * tb + q16) * DROW + 128 * g + 32 * ks + 8 * quad) * 2);
        const bf16_t* wp = (const bf16_t*)(p.ws + WS_W + (size_t)layer * WL_STRIDE + WL_POOL) + (size_t)g * 128 * 128;
#pragma unroll 2
        for (int nt = 0; nt < 8; ++nt) {
            bf16x8 wf[4];
#pragma unroll
            for (int ks = 0; ks < 4; ++ks) wf[ks] = *(const bf16x8*)(wp + (16 * nt + q16) * 128 + 32 * ks + 8 * quad);
#pragma unroll
            for (int tb = 0; tb < 2; ++tb) {
                f32x4 o = (f32x4){0.f, 0.f, 0.f, 0.f};
#pragma unroll
                for (int ks = 0; ks < 4; ++ks) o = __builtin_amdgcn_mfma_f32_16x16x32_bf16(wf[ks], dfr[tb][ks], o, 0, 0, 0);
                u32x2 ww; ww.x = pk2(o[0], o[1]); ww.y = pk2(o[2], o[3]);
                *(u32x2*)(mix + (size_t)(tok0 + 32 * th + 16 * tb + q16) * DM + 512 + 128 * g + 16 * nt + 4 * quad) = ww;
            }
        }
    }
    __syncthreads();
}

#define XB_TMO      128
#define XB_XCNT(j)  (256  + 64 * (j))
#define XB_XSUB(j)  (1280 + 64 * (j))
#define XB_XGEN(j)  (2304 + 64 * (j))
#define XB_TOP      3328
#define XB_TOPGEN   3392
#define XCD_BAR_WORDS 3456
#define XB_SPIN_CAP (1u << 18)

__device__ __forceinline__ unsigned xb_ld(unsigned* p)              { return __hip_atomic_load(p, __ATOMIC_RELAXED, __HIP_MEMORY_SCOPE_AGENT); }
__device__ __forceinline__ unsigned xb_add(unsigned* p, unsigned v) { return __hip_atomic_fetch_add(p, v, __ATOMIC_RELAXED, __HIP_MEMORY_SCOPE_AGENT); }
__device__ __forceinline__ unsigned xb_xcc_id() { return (unsigned)__builtin_amdgcn_s_getreg((3 << 11) | 20) & 0xFu; }
#define XB_SPIN(cond, bar) do { unsigned _sp = 0; while (cond) { __builtin_amdgcn_s_sleep(1); \
    if ((++_sp & 255u) == 0u) { if (xb_ld(&(bar)[XB_TMO])) break; if (_sp > XB_SPIN_CAP) { atomicAdd(&(bar)[XB_TMO], 1u); break; } } } } while (0)

struct XcdBarrier {
    unsigned* bar; unsigned x;
    volatile LAS unsigned* st;
};

__device__ __forceinline__ XcdBarrier xcd_barrier_post(unsigned* bar, volatile LAS unsigned* st) {
    XcdBarrier b; b.bar = bar; b.x = xb_xcc_id(); b.st = st;
    if (threadIdx.x == 0) (void)xb_add(&bar[XB_XCNT(b.x)], 1u);
    return b;
}
__device__ __forceinline__ void xcd_barrier_complete(unsigned* bar, unsigned x, unsigned& nloc, unsigned& nx) {
    const unsigned G = gridDim.x * gridDim.y * gridDim.z;
    unsigned sum, cnt, mine, sp = 0u;
    for (;;) {
        sum = 0u; cnt = 0u; mine = 0u;
#pragma unroll
        for (unsigned j = 0; j < 16; ++j) { const unsigned c = xb_ld(&bar[XB_XCNT(j)]); sum += c; cnt += (c > 0u) ? 1u : 0u; mine = (j == x) ? c : mine; }
        if (sum == G) break;
        __builtin_amdgcn_s_sleep(1);
        if ((++sp & 255u) == 0u) { if (xb_ld(&bar[XB_TMO])) break; if (sp > XB_SPIN_CAP) { atomicAdd(&bar[XB_TMO], 1u); break; } }
    }
    nloc = mine > 0u ? mine : 1u; nx = cnt > 0u ? cnt : 1u;
}

__device__ __forceinline__ void xcd_barrier(const XcdBarrier& b, bool t0) {
    asm volatile("s_waitcnt vmcnt(0)" ::: "memory");
    __syncthreads();
    if (t0) {
        unsigned* bar = b.bar;
        __builtin_amdgcn_s_waitcnt(0);
        unsigned nloc = b.st[0], nx = b.st[1];
        if (nloc == 0u) { xcd_barrier_complete(bar, b.x, nloc, nx); b.st[0] = nloc; b.st[1] = nx; }
        const unsigned old = xb_add(&bar[XB_XSUB(b.x)], 1u);
        const unsigned gen = old / nloc;
        if (old + 1u == (gen + 1u) * nloc) {
            __builtin_amdgcn_fence(__ATOMIC_RELEASE, "agent");
            asm volatile("s_waitcnt vmcnt(0)" ::: "memory");
            const unsigned og = xb_add(&bar[XB_TOP], 1u);
            const unsigned tg = og / nx;
            if (og + 1u == (tg + 1u) * nx) xb_add(&bar[XB_TOPGEN], 1u);
            else XB_SPIN(xb_ld(&bar[XB_TOPGEN]) == tg, bar);
            __builtin_amdgcn_fence(__ATOMIC_ACQUIRE, "agent");
            xb_add(&bar[XB_XGEN(b.x)], 1u);
            asm volatile("s_waitcnt vmcnt(0)" ::: "memory");
        } else {
            XB_SPIN(xb_ld(&bar[XB_XGEN(b.x)]) == gen, bar);
            __builtin_amdgcn_fence(__ATOMIC_ACQUIRE, "agent");
            asm volatile("s_waitcnt vmcnt(0)" ::: "memory");
        }
    }
    __syncthreads();
}

constexpr int LDS_BYTES = 131072 + 4096;
__global__ void __launch_bounds__(512, 2) hymba_fwd(Params p) {
    extern __shared__ __attribute__((aligned(16))) unsigned char lds_raw[];
    LAS unsigned char* L = (LAS unsigned char*)lds_raw;
    cg::grid_group grid = cg::this_grid();
    const int wv = __builtin_amdgcn_readfirstlane((int)threadIdx.x >> 6);
#define PHASE_VARS size_t oz_ = 0; int ly = layer; asm volatile("" : "+s"(oz_), "+s"(ly)); unsigned char* ws = p.ws + oz_; bf16_t* xb = (bf16_t*)(ws + WS_XB); bf16_t* act = (bf16_t*)(ws + WS_ACT); bf16_t* zb = (bf16_t*)(ws + WS_Z); bf16_t* mixb = (bf16_t*)(ws + WS_MIX); bf16_t* ub = (bf16_t*)(ws + WS_U); \
        float* xres = p.out + O_Y; unsigned char* wl = ws + WS_W + (size_t)ly * WL_STRIDE; float* sq = (float*)(ws + WS_SSQ) + (size_t)ly * 4 * MT; (void)xb; (void)act; (void)zb; (void)mixb; (void)ub; (void)xres; (void)wl; (void)sq;
    const int G = gridDim.x, c = blockIdx.x;
#define XBAR() do { XcdBarrier bar_; bar_.bar = (unsigned*)(p.ws + WS_BAR); bar_.x = xb_xcc_id(); bar_.st = (volatile LAS unsigned*)(L + 131072 + 64); int t_ = tid_of(wv); asm volatile("" : "+v"(t_)); xcd_barrier(bar_, t_ == 0); } while (0)
    volatile LAS unsigned* bst = (volatile LAS unsigned*)(L + 131072 + 64);
    if (threadIdx.x == 0) { bst[0] = 0u; bst[1] = 0u; }
    __syncthreads();
    (void)xcd_barrier_post((unsigned*)(p.ws + WS_BAR), bst);
    prologue(p, L, wv);
    grid.sync();
#pragma unroll 1
    for (int layer = 0; layer < NLAYER; ++layer) {
        { PHASE_VARS pg8::Gemm g{ly == 0 ? xb : (const bf16_t*)(ws + WS_XB2), (const bf16_t*)(wl + WL_FFA_IN), MT, NFF2, DM}; pg8::StaticOrder S; S.init(MT, NFF2, G, c); EpiSwiglu E{act, sq};
          pg8::gemm_phase<EpiSwiglu, pg8::StaticOrder, true, true>(L, g, S, E, wv); }
        XBAR();
        { PHASE_VARS pg8::Gemm g{act, (const bf16_t*)(wl + WL_FFA_OUT), MT, DM, DFF}; pg8::StaticOrder S; S.init(MT, DM, G, c);
          EpiResid<0> E{ly == 0 ? xb : (const bf16_t*)(ws + WS_XB2), xb, nullptr, sq + MT, 0.5f, nullptr, nullptr};
          pg8::gemm_phase<EpiResid<0>, pg8::StaticOrder, true, true>(L, g, S, E, wv); }
        XBAR();
        { PHASE_VARS pg8::Gemm g{xb, (const bf16_t*)(wl + WL_IN), MT, NIN, DM}; pg8::StaticOrder S; S.init(MT, NIN, G, c); EpiStore E{zb, NIN, sq + MT};
          pg8::gemm_phase<EpiStore, pg8::StaticOrder, true, true>(L, g, S, E, wv); }
        XBAR();
#pragma unroll 1
        for (int cu = c; cu < 1056; cu += G) { int Gl = G; asm volatile("" : "+s"(Gl)); const int un = (Gl == 256 && cu < 1024) ? ((cu & 255) << 2) + (cu >> 8) : cu; mixer_unit(p, layer, un, L, wv); }
        XBAR();
        { PHASE_VARS pg8::Gemm g{mixb, (const bf16_t*)(wl + WL_OUT), MT, DM, DM}; pg8::StaticOrder S; S.init(MT, DM, G, c);
          EpiResid<0> E{xb, xb, nullptr, sq + 2 * MT, 1.0f, nullptr, nullptr};
          pg8::gemm_phase<EpiResid<0>, pg8::StaticOrder, true, true>(L, g, S, E, wv); }
        XBAR();
        { PHASE_VARS pg8::Gemm g{xb, (const bf16_t*)(wl + WL_FFB_IN), MT, NFF2, DM}; pg8::StaticOrder S; S.init(MT, NFF2, G, c); EpiSwiglu E{act, sq + 2 * MT};
          pg8::gemm_phase<EpiSwiglu, pg8::StaticOrder, true, true>(L, g, S, E, wv); }
        XBAR();
        { PHASE_VARS pg8::Gemm g{act, (const bf16_t*)(wl + WL_FFB_OUT), MT, DM, DFF}; pg8::StaticOrder S; S.init(MT, DM, G, c);
          EpiResid<0> E{xb, xb, nullptr, sq + 3 * MT, 0.5f, nullptr, nullptr};
          pg8::gemm_phase<EpiResid<0>, pg8::StaticOrder, true, true>(L, g, S, E, wv); }
        int Gf = G, cf = c; asm volatile("" : "+s"(Gf), "+s"(cf));
        if (Gf == 256 ? cf >= 32 : true) { PHASE_VARS pg8::Gemm g{(const bf16_t*)(ws + WS_PB) + (size_t)ly * MT * PED, (const bf16_t*)(wl + WL_PEU), MT, DM, PED}; pg8::StaticOrder S;
          if (Gf == 256) S.init(MT, DM, 224, cf - 32); else S.init(MT, DM, Gf, cf);
          EpiStore E{(bf16_t*)(ws + WS_U2), DM, nullptr};
          pg8::gemm_phase<EpiStore, pg8::StaticOrder, true, true>(L, g, S, E, wv); }
        XBAR();
        { PHASE_VARS pg8::Gemm g{xb, (const bf16_t*)(wl + WL_PEG), MT, DM, DM}; pg8::StaticOrder S; S.init(MT, DM, G, c);
          EpiResid<1> E{xb, (bf16_t*)(ws + WS_XB2), ly + 1 < NLAYER ? nullptr : xres, sq + 4 * MT, 1.0f, (const bf16_t*)(ws + WS_U2), sq + 3 * MT};
          pg8::gemm_phase<EpiResid<1>, pg8::StaticOrder, true, true>(L, g, S, E, wv); }
        if (layer + 1 < NLAYER) XBAR();
    }
}

extern "C" void kernel_launch(void* const* d_in, const int* in_sizes, int n_in, void* d_out, int out_size, void* d_ws, size_t ws_size, hipStream_t stream) {
    static int grid = 0;
    if (grid == 0) {
        if (n_in != 24 || in_sizes[0] != MP * DM || (size_t)out_size != O_END || ws_size < WS_END) { fprintf(stderr, "kernel_launch: unexpected shapes (n_in %d, in0 %d, out %d, ws %zu)\n", n_in, n_in > 0 ? in_sizes[0] : -1, out_size, ws_size); grid = -1; return; }
        int dev = 0, cus = 0, per_cu = 0;
        if (hipGetDevice(&dev) != hipSuccess || hipDeviceGetAttribute(&cus, hipDeviceAttributeMultiprocessorCount, dev) != hipSuccess) { grid = -1; return; }
        if (hipFuncSetAttribute((const void*)hymba_fwd, hipFuncAttributeMaxDynamicSharedMemorySize, LDS_BYTES) != hipSuccess) { fprintf(stderr, "kernel_launch: hipFuncSetAttribute failed\n"); grid = -1; return; }
        if (hipOccupancyMaxActiveBlocksPerMultiprocessor(&per_cu, (const void*)hymba_fwd, 512, LDS_BYTES) != hipSuccess || per_cu < 1) { fprintf(stderr, "kernel_launch: occupancy query says %d\n", per_cu); per_cu = 1; }
        (void)hipGetLastError();
        grid = cus * 1;
    }
    if (grid < 0) return;
    if (hipMemsetAsync((char*)d_ws + WS_BAR, 0, 16384, stream) != hipSuccess) { fprintf(stderr, "kernel_launch: memset of the barrier words failed\n"); return; }
    Params p{};
    for (int i = 0; i < 24; ++i) p.in[i] = (const float*)d_in[i];
    p.out = (float*)d_out; p.ws = (unsigned char*)d_ws;
    void* args[] = {&p};
    hipError_t e = hipLaunchCooperativeKernel((const void*)hymba_fwd, dim3(grid), dim3(512), args, LDS_BYTES, stream);
    if (e != hipSuccess) fprintf(stderr, "kernel_launch: cooperative launch failed: %s (grid %d)\n", hipGetErrorString(e), grid);
}
```

```cpp
#include <hip/hip_runtime.h>
#include <hip/hip_cooperative_groups.h>
#include <cstdio>
#include <cstdint>
namespace cg = cooperative_groups;
__device__ __forceinline__ int tid_of(int wv) { return wv * 64 + (int)__builtin_amdgcn_mbcnt_hi(~0u, __builtin_amdgcn_mbcnt_lo(~0u, 0u)); }
namespace pg8 {
#define PG8_LAS __attribute__((address_space(3)))
typedef unsigned short bf16_t;
typedef short bf16x8 __attribute__((ext_vector_type(8)));
typedef float f32x4 __attribute__((ext_vector_type(4)));
typedef unsigned u32x4 __attribute__((ext_vector_type(4)));
constexpr int BM = 256, BK = 64, HALF = 128, HTB = HALF * BK * 2  , STAGE_BYTES = 8 * HTB, NXCD = 8, WGM = 8;

__host__ __device__ __forceinline__ int lds_byte(int r, int c) { const int st = (r >> 4) * 2 + (c >> 5), rr = r & 15, cc = c & 31, ob = rr * 64 + cc * 2; return st * 1024 + (ob ^ (((ob >> 9) & 1) << 5)); }
__host__ __device__ __forceinline__ void stage_rc(int b, int& R, int& C) { const int st = b / 1024, sb = b % 1024, swz = sb ^ (((sb >> 9) & 1) << 5); R = (st >> 1) * 16 + swz / 64; C = (st & 1) * 32 + (swz % 64) / 2; }
__host__ __device__ __forceinline__ int perm32(int rho) { const int n = rho >> 4, i = rho & 15; return 8 * (i >> 2) + 4 * n + (i & 3); }

struct Unit { int pm, pn; };
struct Gemm { const bf16_t* A; const bf16_t* Bt; int M, N, K; };

struct StaticOrder {
    int nM, nN, nwg, G, c;
    __host__ __device__ void init(int M, int N, int G_, int c_) { nM = M / BM; nN = N / BM; nwg = nM * nN; G = G_; c = c_; }
    __host__ __device__ bool next(int i, Unit& u) const {
        const int L = i * G + c; if (L >= nwg) return false;
        int wgid = L; { const int q = nwg / NXCD, r = nwg % NXCD, xcd = wgid % NXCD, off = wgid / NXCD; wgid = (xcd < r ? xcd * (q + 1) : r * (q + 1) + (xcd - r) * q) + off; }
        const int nig = WGM * nN, gid = wgid / nig, fm = gid * WGM, gsz = (nM - fm) < WGM ? (nM - fm) : WGM;
        u.pm = fm + ((wgid % nig) % gsz); u.pn = (wgid % nig) / gsz; return true;
    }
    __device__ __forceinline__ void a_ready(const Unit&) const {}
    __device__ __forceinline__ void done(const Unit&) const {}
};
__device__ __forceinline__ unsigned cvt_pk_bf16(float lo, float hi) { unsigned r; asm volatile("v_cvt_pk_bf16_f32 %0, %1, %2" : "=v"(r) : "v"(lo), "v"(hi)); return r; }
typedef float f32x2 __attribute__((ext_vector_type(2)));
template <class Epi, class Sched, bool ALIGN_EPI = false, bool SP2 = false>
__device__ __forceinline__ void gemm_phase(PG8_LAS unsigned char* lds, const Gemm g, const Sched& S, const Epi& E, int wv) {
    int tid_ = tid_of(wv); asm volatile("" : "+v"(tid_));
    const int tid = tid_, wid = __builtin_amdgcn_readfirstlane(tid >> 6), lane = tid & 63, wr = wid >> 2, wc = wid & 3, fr = lane & 15, fq = lane >> 4;
    const int K = g.K, nt = K / BK;
    unsigned voffA[2], voffB[2];
#pragma unroll
    for (int i = 0; i < 2; ++i) { int R, C; stage_rc(tid * 16 + i * 8192, R, C); const int Rb = Epi::PERM ? ((R & ~31) + perm32(R & 31)) : R;
        voffA[i] = (unsigned)(R * K + C) * 2u; voffB[i] = (unsigned)(Rb * K + C) * 2u; }
    const size_t kstep = (size_t)(BK * 2);
    const size_t hstep = (size_t)HALF * K * 2;
    const size_t tstep = 2 * hstep;
    const unsigned ldsw = (unsigned)wid * 1024u;
    const int aoff = lds_byte(wr * 64 + fr, fq * 8), boff = lds_byte(wc * 32 + fr, fq * 8);
#define PG8_SA(b, h) (((b) * 2 + (h)) * HTB)
#define PG8_SB(b, h) ((4 + (b) * 2 + (h)) * HTB)
#define PG8_STAGE(bufoff, gbase, voff) do { _Pragma("unroll") for (int _i = 0; _i < 2; ++_i) \
        __builtin_amdgcn_global_load_lds((const unsigned*)((const char*)(gbase) + (voff)[_i]), (PG8_LAS unsigned*)(lds + (bufoff) + ldsw + _i * 8192), 16, 0, 0); } while (0)
#define PG8_LDA(dst, b, h) do { _Pragma("unroll") for (int m = 0; m < 4; ++m) _Pragma("unroll") for (int k = 0; k < 2; ++k) dst[m][k] = *(const PG8_LAS bf16x8*)(lds + PG8_SA(b, h) + aoff + m * 2048 + k * 1024); } while (0)
#define PG8_LDB(dst, b, h) do { _Pragma("unroll") for (int n = 0; n < 2; ++n) _Pragma("unroll") for (int k = 0; k < 2; ++k) dst[n][k] = *(const PG8_LAS bf16x8*)(lds + PG8_SB(b, h) + boff + n * 2048 + k * 1024); } while (0)
#define PG8_MMA(ai, bj, At, Bt) do { __builtin_amdgcn_s_setprio(1); _Pragma("unroll") for (int m = 0; m < 4; ++m) _Pragma("unroll") for (int n = 0; n < 2; ++n) _Pragma("unroll") for (int k = 0; k < 2; ++k) \
        acc[ai][bj][m][n] = __builtin_amdgcn_mfma_f32_16x16x32_bf16(Bt[n][k], At[m][k], acc[ai][bj][m][n], 0, 0, 0); __builtin_amdgcn_s_setprio(0); } while (0)
#define PG8_WAIT_V(n) asm volatile("s_waitcnt vmcnt(" #n ")" ::: "memory")
#define PG8_WAIT_L(n) asm volatile("s_waitcnt lgkmcnt(" #n ")" ::: "memory")
#define PG8_BAR __builtin_amdgcn_s_barrier()
#define PG8_SCHED __builtin_amdgcn_sched_barrier(0)
    Unit cur, nxt; int ui = 0;
    if (!S.next(0, cur)) return;
    f32x4 acc[2][2][4][2];
#pragma unroll
    for (int a = 0; a < 2; ++a)
#pragma unroll
        for (int b = 0; b < 2; ++b)
#pragma unroll
            for (int m = 0; m < 4; ++m)
#pragma unroll
                for (int n = 0; n < 2; ++n) acc[a][b][m][n] = (f32x4){0.f, 0.f, 0.f, 0.f};
    bf16x8 At[4][2], B0[2][2], B1[2][2];
    const char* cA = (const char*)g.A + (size_t)cur.pm * tstep; const char* cB = (const char*)g.Bt + (size_t)cur.pn * tstep;
    S.a_ready(cur);
    if constexpr (SP2) {
        PG8_STAGE(PG8_SB(0, 0), cB, voffB); PG8_STAGE(PG8_SB(0, 1), cB + hstep, voffB); PG8_STAGE(PG8_SA(0, 0), cA, voffA); PG8_STAGE(PG8_SA(0, 1), cA + hstep, voffA);
        if (wr == 1) PG8_BAR;
        PG8_WAIT_V(2); PG8_BAR;
        PG8_STAGE(PG8_SB(1, 0), cB + kstep, voffB); PG8_STAGE(PG8_SA(1, 0), cA + kstep, voffA); PG8_STAGE(PG8_SB(1, 1), cB + hstep + kstep, voffB);
        PG8_WAIT_V(6); PG8_BAR;
    } else {
        PG8_STAGE(PG8_SB(0, 0), cB, voffB); PG8_STAGE(PG8_SA(0, 0), cA, voffA); PG8_STAGE(PG8_SB(0, 1), cB + hstep, voffB); PG8_STAGE(PG8_SA(0, 1), cA + hstep, voffA);
        if (wr == 1) PG8_BAR;
        PG8_WAIT_V(4); PG8_BAR;
        PG8_STAGE(PG8_SB(1, 0), cB + kstep, voffB); PG8_STAGE(PG8_SA(1, 0), cA + kstep, voffA); PG8_STAGE(PG8_SB(1, 1), cB + hstep + kstep, voffB);
        PG8_WAIT_V(6); PG8_BAR;
    }
    for (;;) {
        const bool has_next = S.next(ui + 1, nxt);
        const char* nA = has_next ? (const char*)g.A + (size_t)nxt.pm * tstep : cA; const char* nB = has_next ? (const char*)g.Bt + (size_t)nxt.pn * tstep : cB;
        for (int t = 0; t < nt; t += 2) {
            const bool last = (t == nt - 2);
            const char* a1 = cA + (size_t)(t + 1) * kstep;
            const char* a2 = last ? nA : cA + (size_t)(t + 2) * kstep; const char* b2 = last ? nB : cB + (size_t)(t + 2) * kstep;
            const char* a3 = a2 + kstep; const char* b3 = b2 + kstep;
            if (last && has_next) S.a_ready(nxt);
            if constexpr (SP2) {
            PG8_LDB(B0, 0, 0); PG8_LDB(B1, 0, 1); PG8_SCHED; PG8_LDA(At, 0, 0); PG8_STAGE(PG8_SA(1, 1), a1 + hstep, voffA);
            PG8_WAIT_V(8); PG8_WAIT_L(0); PG8_BAR; PG8_MMA(0, 0, At, B0); PG8_MMA(0, 1, At, B1); PG8_BAR; PG8_SCHED;
            PG8_LDA(At, 0, 1); PG8_STAGE(PG8_SB(0, 0), b2, voffB); PG8_STAGE(PG8_SB(0, 1), b2 + hstep, voffB); PG8_STAGE(PG8_SA(0, 0), a2, voffA);
            PG8_WAIT_V(8); PG8_WAIT_L(0); PG8_BAR; PG8_MMA(1, 0, At, B0); PG8_MMA(1, 1, At, B1); PG8_BAR; PG8_SCHED;
            PG8_LDB(B0, 1, 0); PG8_LDB(B1, 1, 1); PG8_SCHED; PG8_LDA(At, 1, 0); PG8_STAGE(PG8_SA(0, 1), a2 + hstep, voffA);
            PG8_WAIT_V(8); PG8_WAIT_L(0); PG8_BAR; PG8_MMA(0, 0, At, B0); PG8_MMA(0, 1, At, B1); PG8_BAR; PG8_SCHED;
            PG8_LDA(At, 1, 1); PG8_STAGE(PG8_SB(1, 0), b3, voffB); PG8_STAGE(PG8_SB(1, 1), b3 + hstep, voffB); PG8_STAGE(PG8_SA(1, 0), a3, voffA);
            PG8_WAIT_V(8); PG8_WAIT_L(0); PG8_BAR; PG8_MMA(1, 0, At, B0); PG8_MMA(1, 1, At, B1); PG8_BAR; PG8_SCHED;
            } else {
            PG8_LDB(B0, 0, 0); PG8_SCHED; PG8_LDA(At, 0, 0); PG8_STAGE(PG8_SA(1, 1), a1 + hstep, voffA);
            PG8_WAIT_L(8); PG8_BAR; PG8_WAIT_L(0); PG8_MMA(0, 0, At, B0); PG8_BAR; PG8_SCHED;
            PG8_LDB(B1, 0, 1); PG8_STAGE(PG8_SB(0, 0), b2, voffB);
            PG8_BAR; PG8_WAIT_L(0); PG8_MMA(0, 1, At, B1); PG8_BAR;
            PG8_LDA(At, 0, 1); PG8_STAGE(PG8_SA(0, 0), a2, voffA);
            PG8_BAR; PG8_WAIT_L(0); PG8_MMA(1, 0, At, B0); PG8_BAR; PG8_SCHED;
            PG8_STAGE(PG8_SB(0, 1), b2 + hstep, voffB);
            PG8_WAIT_V(6); PG8_BAR; PG8_MMA(1, 1, At, B1); PG8_BAR;
            PG8_LDB(B0, 1, 0); PG8_SCHED; PG8_LDA(At, 1, 0); PG8_STAGE(PG8_SA(0, 1), a2 + hstep, voffA);
            PG8_WAIT_L(8); PG8_BAR; PG8_WAIT_L(0); PG8_MMA(0, 0, At, B0); PG8_BAR; PG8_SCHED;
            PG8_LDB(B1, 1, 1); PG8_STAGE(PG8_SB(1, 0), b3, voffB);
            PG8_BAR; PG8_WAIT_L(0); PG8_MMA(0, 1, At, B1); PG8_BAR;
            PG8_LDA(At, 1, 1); PG8_STAGE(PG8_SA(1, 0), a3, voffA);
            PG8_BAR; PG8_WAIT_L(0); PG8_MMA(1, 0, At, B0); PG8_BAR; PG8_SCHED;
            PG8_STAGE(PG8_SB(1, 1), b3 + hstep, voffB);
            PG8_WAIT_V(6); PG8_BAR; PG8_MMA(1, 1, At, B1); PG8_BAR;
            }
        }
        if constexpr (ALIGN_EPI) { if (wr == 0) PG8_BAR; }
        if constexpr (!Epi::AFTER_DRAIN) { E(acc, cur, wr, wc, fr, fq); S.done(cur); }
        if (!has_next) break;
#pragma unroll
        for (int a = 0; a < 2; ++a)
#pragma unroll
            for (int b = 0; b < 2; ++b)
#pragma unroll
                for (int m = 0; m < 4; ++m)
#pragma unroll
                    for (int n = 0; n < 2; ++n) acc[a][b][m][n] = (f32x4){0.f, 0.f, 0.f, 0.f};
        cur = nxt; cA = nA; cB = nB; ++ui;
        if constexpr (ALIGN_EPI) { if (wr == 1) PG8_BAR; }
    }
    PG8_WAIT_V(0);
    if constexpr (!ALIGN_EPI) { if (wr == 0) PG8_BAR; }
    PG8_BAR;
    if constexpr (Epi::AFTER_DRAIN) { E.fused(acc, cur, wr, wc, fr, fq, lds, wid, lane); S.done(cur); }
#undef PG8_SA
#undef PG8_SB
#undef PG8_STAGE
#undef PG8_LDA
#undef PG8_LDB
#undef PG8_MMA
#undef PG8_WAIT_V
#undef PG8_WAIT_L
#undef PG8_BAR
#undef PG8_SCHED
}
}

#define LAS __attribute__((address_space(3)))
using pg8::f32x4; using pg8::u32x4; using pg8::bf16_t; using pg8::bf16x8; using pg8::Unit;
typedef float f32x2 __attribute__((ext_vector_type(2)));
typedef __bf16 bf16x2_t __attribute__((ext_vector_type(2)));
typedef unsigned u32x2 __attribute__((ext_vector_type(2)));
constexpr int DM = 1024, DFF = 2816, NFF2 = 5632, NIN = 1280, PED = 256;
constexpr int MP = 65536, MS = 2048, MT = MP + MS;
constexpr int NB = 32, SEQ = 2048, DSEQ = 64, NLAYER = 2;
constexpr float EPS = 1e-6f, LOG2E = 1.4426950408889634f;
constexpr size_t MiB = 1u << 20;
constexpr size_t WL_FFA_IN = 0, WL_FFA_OUT = 11 * MiB, WL_IN = WL_FFA_OUT + 5 * MiB + MiB / 2, WL_OUT = WL_IN + 2 * MiB + MiB / 2, WL_FFB_IN = WL_OUT + 2 * MiB,
                 WL_FFB_OUT = WL_FFB_IN + 11 * MiB, WL_PEG = WL_FFB_OUT + 5 * MiB + MiB / 2, WL_PEU = WL_PEG + 2 * MiB, WL_POOL = WL_PEU + MiB / 2, WL_STRIDE = 41 * MiB;
static_assert(WL_POOL + 131072 <= WL_STRIDE, "weights map");
constexpr size_t WS_W = 0, WS_XB = 82 * MiB, WS_ACT = 214 * MiB, WS_Z = WS_ACT, WS_MIX = WS_ACT + 165 * MiB, WS_U = WS_ACT, WS_PB = 577 * MiB, WS_SSQ = 643 * MiB, WS_ROPE = 646 * MiB, WS_BAR = 646 * MiB + 512 * 1024, WS_XB2 = 647 * MiB, WS_U2 = 779 * MiB, WS_END = 911 * MiB;
static_assert((size_t)MT * DM * 2 == 132 * MiB && (size_t)MT * DFF * 2 == 363 * MiB && (size_t)MT * NIN * 2 == 165 * MiB && (size_t)2 * MT * PED * 2 == 66 * MiB, "buffer sizes");
constexpr size_t O_Y = 0, O_KP = (size_t)MT * DM, O_VP = O_KP + 1048576, O_UP = O_VP + 1048576, O_KS = O_UP + 491520, O_VS = O_KS + 1048576, O_US = O_VS + 1048576, O_END = O_US + 491520;

__device__ __forceinline__ unsigned long long ldp_(__attribute__((address_space(3))) unsigned char* L, int i) {
    unsigned z_ = 0u; asm volatile("" : "+v"(z_));
    const unsigned long long v = *(volatile __attribute__((address_space(3))) unsigned long long*)(L + 131072 + 256 + 8 * i + z_);
    const unsigned lo = __builtin_amdgcn_readfirstlane((unsigned)v), hi = __builtin_amdgcn_readfirstlane((unsigned)(v >> 32));
    return ((unsigned long long)hi << 32) | lo;
}
#define PIN(i) ((const float*)ldp_(L, (i)))
#define PWS ((unsigned char*)ldp_(L, 24))
#define POUT ((float*)ldp_(L, 25))
struct Params {
    const float* in[24]; float* out; unsigned char* ws;
};
enum { I_XP = 0, I_XS, I_PP, I_PS, I_CK, I_CV, I_SP, I_NFFA, I_WFFA_IN, I_WFFA_OUT, I_NMIX, I_WIN, I_QN, I_KN, I_SINK, I_WPOOL, I_PSCALE, I_WOUT, I_NFFB, I_WFFB_IN, I_WFFB_OUT, I_NPE, I_WPEG, I_WPEU };

__device__ __forceinline__ unsigned pk2(float lo, float hi) { f32x2 v = {lo, hi}; bf16x2_t b = __builtin_convertvector(v, bf16x2_t); return __builtin_bit_cast(unsigned, b); }
__device__ __forceinline__ float bflo(unsigned w) { return __uint_as_float(w << 16); }
__device__ __forceinline__ float bfhi(unsigned w) { return __uint_as_float(w & 0xffff0000u); }
__device__ __forceinline__ float rstd_of(const float* ssq, int row) { return __builtin_amdgcn_rsqf(ssq[row] * (1.0f / 1024.0f) + EPS); }
__device__ __forceinline__ float silu_f(float g) { return g * __builtin_amdgcn_rcpf(1.0f + __builtin_amdgcn_exp2f(-LOG2E * g)); }
__device__ __forceinline__ float sigm_f(float g) { return __builtin_amdgcn_rcpf(1.0f + __builtin_amdgcn_exp2f(-LOG2E * g)); }
__device__ __forceinline__ float wave_sum(float v) {
#pragma unroll
    for (int o = 1; o < 64; o <<= 1) v += __shfl_xor(v, o);
    return v;
}

struct EpiSwiglu {
    static constexpr bool PERM = true, AFTER_DRAIN = false;
    bf16_t* act; const float* ssq;
    __device__ __forceinline__ void operator()(const f32x4 (&acc)[2][2][4][2], const Unit& u, int wr, int wc, int fr_, int fq_) const {
        int l_ = (int)__builtin_amdgcn_mbcnt_hi(~0u, __builtin_amdgcn_mbcnt_lo(~0u, 0u)); asm volatile("" : "+v"(l_)); const int fr = l_ & 15, fq = l_ >> 4; (void)fr_; (void)fq_;
        const int row0 = u.pm * 256 + wr * 64 + fr, col0 = u.pn * 128 + wc * 32 + 8 * fq;
#pragma unroll
        for (int ai = 0; ai < 2; ++ai)
#pragma unroll
            for (int m = 0; m < 4; ++m) {
                const int row = row0 + ai * 128 + m * 16; const float rs = rstd_of(ssq, row);
                const f32x4 g0 = acc[ai][0][m][0] * rs, g1 = acc[ai][0][m][1] * rs, u0 = acc[ai][1][m][0] * rs, u1 = acc[ai][1][m][1] * rs;
                u32x4 w;
                w.x = pk2(silu_f(g0[0]) * u0[0], silu_f(g0[1]) * u0[1]); w.y = pk2(silu_f(g0[2]) * u0[2], silu_f(g0[3]) * u0[3]);
                w.z = pk2(silu_f(g1[0]) * u1[0], silu_f(g1[1]) * u1[1]); w.w = pk2(silu_f(g1[2]) * u1[2], silu_f(g1[3]) * u1[3]);
                *(u32x4*)(act + (size_t)row * DFF + col0) = w;
            }
    }
};
struct EpiStore {
    static constexpr bool PERM = true, AFTER_DRAIN = false;
    bf16_t* O; int ldc; const float* ssq;
    __device__ __forceinline__ void operator()(const f32x4 (&acc)[2][2][4][2], const Unit& u, int wr, int wc, int fr_, int fq_) const {
        int l_ = (int)__builtin_amdgcn_mbcnt_hi(~0u, __builtin_amdgcn_mbcnt_lo(~0u, 0u)); asm volatile("" : "+v"(l_)); const int fr = l_ & 15, fq = l_ >> 4; (void)fr_; (void)fq_;
        const int row0 = u.pm * 256 + wr * 64 + fr, col0 = u.pn * 256 + wc * 32 + 8 * fq;
#pragma unroll
        for (int ai = 0; ai < 2; ++ai)
#pragma unroll
            for (int m = 0; m < 4; ++m) {
                const int row = row0 + ai * 128 + m * 16; const float rs = ssq ? rstd_of(ssq, row) : 1.0f;
#pragma unroll
                for (int bj = 0; bj < 2; ++bj) {
                    const f32x4 v0 = acc[ai][bj][m][0] * rs, v1 = acc[ai][bj][m][1] * rs;
                    u32x4 w; w.x = pk2(v0[0], v0[1]); w.y = pk2(v0[2], v0[3]); w.z = pk2(v1[0], v1[1]); w.w = pk2(v1[2], v1[3]);
                    *(u32x4*)(O + (size_t)row * ldc + col0 + bj * 128) = w;
                }
            }
    }
};
template <int MODE> struct EpiResid {
    static constexpr bool PERM = true, AFTER_DRAIN = false;
    const bf16_t* xi; bf16_t* xo; float* yout; float* ssq_next; float scale; const bf16_t* U; const float* ssq_cur;
    __device__ __forceinline__ void operator()(const f32x4 (&acc)[2][2][4][2], const Unit& u, int wr, int wc, int fr_, int fq_) const {
        int l_ = (int)__builtin_amdgcn_mbcnt_hi(~0u, __builtin_amdgcn_mbcnt_lo(~0u, 0u)); asm volatile("" : "+v"(l_)); const int fr = l_ & 15, fq = l_ >> 4; (void)fr_; (void)fq_;
        const int row0 = u.pm * 256 + wr * 64 + fr, col0 = u.pn * 256 + wc * 32 + 8 * fq;
#pragma unroll
        for (int ai = 0; ai < 2; ++ai)
#pragma unroll
            for (int m = 0; m < 4; ++m) {
                const int row = row0 + ai * 128 + m * 16; const size_t off = (size_t)row * DM + col0;
                const float rs = (MODE == 1) ? rstd_of(ssq_cur, row) : 0.f; float ss = 0.f;
#pragma unroll
                for (int bj = 0; bj < 2; ++bj) {
                    const u32x4 xw = *(const u32x4*)(xi + off + bj * 128);
                    f32x4 a0 = acc[ai][bj][m][0], a1 = acc[ai][bj][m][1];
                    if (MODE == 1) {
                        const u32x4 uu = *(const u32x4*)(U + off + bj * 128);
                        a0[0] = sigm_f(a0[0] * rs) * bflo(uu.x); a0[1] = sigm_f(a0[1] * rs) * bfhi(uu.x); a0[2] = sigm_f(a0[2] * rs) * bflo(uu.y); a0[3] = sigm_f(a0[3] * rs) * bfhi(uu.y);
                        a1[0] = sigm_f(a1[0] * rs) * bflo(uu.z); a1[1] = sigm_f(a1[1] * rs) * bfhi(uu.z); a1[2] = sigm_f(a1[2] * rs) * bflo(uu.w); a1[3] = sigm_f(a1[3] * rs) * bfhi(uu.w);
                    } else { a0 = a0 * scale; a1 = a1 * scale; }
                    const f32x4 v0 = (f32x4){bflo(xw.x), bfhi(xw.x), bflo(xw.y), bfhi(xw.y)} + a0, v1 = (f32x4){bflo(xw.z), bfhi(xw.z), bflo(xw.w), bfhi(xw.w)} + a1;
                    if (yout) { *(f32x4*)(yout + off + bj * 128) = v0; *(f32x4*)(yout + off + bj * 128 + 4) = v1; }
                    else {
                        u32x4 w; w.x = pk2(v0[0], v0[1]); w.y = pk2(v0[2], v0[3]); w.z = pk2(v1[0], v1[1]); w.w = pk2(v1[2], v1[3]);
                        *(u32x4*)(xo + off + bj * 128) = w;
                        ss += (v0[0] * v0[0] + v0[1] * v0[1]) + (v0[2] * v0[2] + v0[3] * v0[3]) + (v1[0] * v1[0] + v1[1] * v1[1]) + (v1[2] * v1[2] + v1[3] * v1[3]);
                    }
                }
                if (!yout) { ss += __shfl_xor(ss, 16); ss += __shfl_xor(ss, 32);
                    if (fq == 0) __hip_atomic_fetch_add(ssq_next + row, ss, __ATOMIC_RELAXED, __HIP_MEMORY_SCOPE_AGENT); }
                if (m & 1) asm volatile("" ::: "memory");
            }
    }
};

__device__ __forceinline__ void transpose_item(const float* W, int K, int N, bf16_t* WT, const float* gk, int mode, LAS float* scr_, int item, int lane) {
    LAS unsigned* scr = (LAS unsigned*)scr_;
    const int nblk = N / 64, kb = item / nblk, nb = item % nblk, k0 = 64 * kb, n0 = 64 * nb;
    const int sc = (mode == 1) ? (((n0 >> 7) & 1) * DFF + (n0 >> 8) * 128 + (n0 & 127)) : n0;
    const float* src = W + (size_t)k0 * N + sc + lane;
    float va[32], vb[32];
#pragma unroll
    for (int kp = 0; kp < 32; ++kp) { va[kp] = src[(size_t)(2 * kp) * N]; vb[kp] = src[(size_t)(2 * kp + 1) * N]; }
#pragma unroll
    for (int kp = 0; kp < 32; ++kp) {
        float a = va[kp], b = vb[kp];
        if (gk) { a *= gk[k0 + 2 * kp]; b *= gk[k0 + 2 * kp + 1]; }
        scr[kp * 65 + lane] = pk2(a, b);
    }
    asm volatile("s_waitcnt lgkmcnt(0)" ::: "memory");
    const int c = lane & 7;
#pragma unroll
    for (int j = 0; j < 8; ++j) { const int r = (lane >> 3) + 8 * j; const LAS unsigned* q = scr + (4 * c) * 65 + r;
        u32x4 o; o.x = q[0]; o.y = q[65]; o.z = q[130]; o.w = q[195];
        *(u32x4*)(WT + (size_t)(n0 + r) * K + k0 + 8 * c) = o; }
    asm volatile("s_waitcnt lgkmcnt(0)" ::: "memory");
}
__device__ __forceinline__ float rope_inv(int i) {
    return i == 0 ? 1.0f : i == 1 ? 0.1939227432012558f : i == 2 ? 0.03760603070259094f : i == 3 ? 0.007292664609849453f : i == 4 ? 0.0014142135623842478f : i == 5 ? 0.00027424818836152554f : i == 6 ? 5.3182957344688475e-05f : 1.0313385246263351e-05f;
}
__device__ __forceinline__ void sincos_d(float angf, float& c, float& s) {
    const double a = (double)angf; const double n = __builtin_rint(a * 0.63661977236758134308);
    const double r = __builtin_fma(-n, 1.5707963267948966192, a) - n * 6.123233995736766e-17; const double r2 = r * r;
    double sp = -7.6471637318198164759e-13; sp = sp * r2 + 1.6059043836821614599e-10; sp = sp * r2 - 2.5052108385441718775e-8; sp = sp * r2 + 2.7557319223985890653e-6; sp = sp * r2 - 1.9841269841269841270e-4; sp = sp * r2 + 8.3333333333333333333e-3; sp = sp * r2 - 1.6666666666666666667e-1;
    const double sn = r + r * r2 * sp;
    double cp = 4.7794773323873852974e-14; cp = cp * r2 - 1.1470745597729724714e-11; cp = cp * r2 + 2.0876756987868098979e-9; cp = cp * r2 - 2.7557319223985890653e-7; cp = cp * r2 + 2.4801587301587301587e-5; cp = cp * r2 - 1.3888888888888888889e-3; cp = cp * r2 + 4.1666666666666666667e-2; cp = cp * r2 - 0.5;
    const double cs = 1.0 + r2 * cp;
    const int q = ((int)n) & 3;
    const double cc = (q == 0) ? cs : (q == 1) ? -sn : (q == 2) ? -cs : sn;
    const double ss = (q == 0) ? sn : (q == 1) ? cs : (q == 2) ? -sn : -cs;
    c = (float)cc; s = (float)ss;
}
enum { PM_FFA_IN = 1, PM_FFB_IN = 2, PM_FFA_OUT = 4, PM_FFB_OUT = 8, PM_WIN = 16, PM_WOUT = 32, PM_PEG = 64, PM_PEU = 128, PM_POOL = 256, PM_P = 512, PM_ROPE = 1024, PM_X = 2048, PM_ALLW = 1023 };
__device__ __forceinline__ void prep(const Params& p, LAS unsigned char* L, int wv, int vb, int nvb, int l, int mask) {
    int tid_ = tid_of(wv); asm volatile("" : "+v"(tid_));
    const int tid = tid_, lane = tid & 63, wave = __builtin_amdgcn_readfirstlane(tid >> 6);
    const int gw = vb * 8 + wave, NGW = nvb * 8; const int gt = vb * 512 + tid, NGT = nvb * 512;
    LAS float* scr = (LAS float*)(L + wave * 16384);
    unsigned char* ws = PWS; unsigned char* wl = ws + WS_W + (size_t)l * WL_STRIDE;
#define PREP_CONV(bit, SRC, Kd, Nd, DST, GK, MODE) if (mask & (bit)) { for (int it = gw; it < ((Kd) / 64) * ((Nd) / 64); it += NGW) transpose_item((SRC), (Kd), (Nd), (bf16_t*)(wl + (DST)), (GK), (MODE), scr, it, lane); }
    PREP_CONV(PM_FFA_IN, PIN(I_WFFA_IN) + (size_t)l * DM * NFF2, DM, NFF2, WL_FFA_IN, PIN(I_NFFA) + l * DM, 1)
    PREP_CONV(PM_FFA_OUT, PIN(I_WFFA_OUT) + (size_t)l * DFF * DM, DFF, DM, WL_FFA_OUT, nullptr, 0)
    PREP_CONV(PM_WIN, PIN(I_WIN) + (size_t)l * DM * NIN, DM, NIN, WL_IN, PIN(I_NMIX) + l * DM, 0)
    PREP_CONV(PM_WOUT, PIN(I_WOUT) + (size_t)l * DM * DM, DM, DM, WL_OUT, nullptr, 0)
    PREP_CONV(PM_FFB_IN, PIN(I_WFFB_IN) + (size_t)l * DM * NFF2, DM, NFF2, WL_FFB_IN, PIN(I_NFFB) + l * DM, 1)
    PREP_CONV(PM_FFB_OUT, PIN(I_WFFB_OUT) + (size_t)l * DFF * DM, DFF, DM, WL_FFB_OUT, nullptr, 0)
    PREP_CONV(PM_PEG, PIN(I_WPEG) + (size_t)l * DM * DM, DM, DM, WL_PEG, PIN(I_NPE) + l * DM, 0)
    PREP_CONV(PM_PEU, PIN(I_WPEU) + (size_t)l * PED * DM, PED, DM, WL_PEU, nullptr, 0)
#undef PREP_CONV
    if (mask & PM_POOL) {
        for (int t = gt; t < 4 * 128 * 16; t += NGT) {
            const int ko = t & 15, n = (t >> 4) & 127, g = (t >> 11) & 3;
            const float* src = PIN(I_WPOOL) + ((size_t)(l * 4 + g) * 128 + 8 * ko) * 128 + n; const float sc = PIN(I_PSCALE)[l * 512 + g * 128 + n];
            u32x4 o; o.x = pk2(src[0] * sc, src[128] * sc); o.y = pk2(src[256] * sc, src[384] * sc); o.z = pk2(src[512] * sc, src[640] * sc); o.w = pk2(src[768] * sc, src[896] * sc);
            *(u32x4*)((bf16_t*)(wl + WL_POOL) + ((size_t)g * 128 + n) * 128 + 8 * ko) = o;
        }
    }
    if (mask & PM_P) {
        bf16_t* pb = (bf16_t*)(ws + WS_PB) + (size_t)l * MT * PED;
        for (int t0 = gt; t0 < MT * 32; t0 += 4 * NGT) {
            f32x4 a[4], b[4]; size_t dsto[4];
#pragma unroll
            for (int u = 0; u < 4; ++u) {
                const int t = min(t0 + u * NGT, MT * 32 - 1);
                const int o8 = t & 31, m = t >> 5;
                const float* src = ((m < MP) ? PIN(I_PP) + ((size_t)l * MP + m) * PED : PIN(I_PS) + ((size_t)l * MS + (m - MP)) * PED) + 8 * o8;
                a[u] = *(const f32x4*)src; b[u] = *(const f32x4*)(src + 4); dsto[u] = (size_t)m * PED + 8 * o8;
            }
#pragma unroll
            for (int u = 0; u < 4; ++u) { u32x4 o; o.x = pk2(a[u][0], a[u][1]); o.y = pk2(a[u][2], a[u][3]); o.z = pk2(b[u][0], b[u][1]); o.w = pk2(b[u][2], b[u][3]); *(u32x4*)(pb + dsto[u]) = o; }
        }
    }
    if (mask & PM_ROPE) {
        float* rope = (float*)(ws + WS_ROPE);
        for (int t = gt; t < 2112 * 8; t += NGT) {
            const int i = t & 7, idx = t >> 3, pos = idx < 2048 ? idx : 4096 + idx - 2048;
            const float ang = (float)pos * rope_inv(i); float c, s; sincos_d(ang, c, s);
            rope[idx * 16 + i] = c; rope[idx * 16 + 8 + i] = s;
        }
    }
    if (mask & PM_X) {
        bf16_t* xb = (bf16_t*)(ws + WS_XB); float* ssq = (float*)(ws + WS_SSQ);
        for (int m0 = 4 * gw; m0 < MT; m0 += 4 * NGW) {
            const float* xr = (m0 < MP) ? PIN(I_XP) + (size_t)m0 * DM : PIN(I_XS) + (size_t)(m0 - MP) * DM;
            f32x4 v[4][4];
#pragma unroll
            for (int r = 0; r < 4; ++r)
#pragma unroll
                for (int j = 0; j < 4; ++j) v[r][j] = *((const f32x4*)(xr + (size_t)r * DM) + lane + 64 * j);
#pragma unroll
            for (int r = 0; r < 4; ++r) {
                float sq = 0.f;
#pragma unroll
                for (int j = 0; j < 4; ++j) sq += (v[r][j][0] * v[r][j][0] + v[r][j][1] * v[r][j][1]) + (v[r][j][2] * v[r][j][2] + v[r][j][3] * v[r][j][3]);
                sq = wave_sum(sq);
#pragma unroll
                for (int j = 0; j < 4; ++j) { u32x2 o; o.x = pk2(v[r][j][0], v[r][j][1]); o.y = pk2(v[r][j][2], v[r][j][3]); *((u32x2*)(xb + (size_t)(m0 + r) * DM) + lane + 64 * j) = o; }
                if (lane == 0) ssq[m0 + r] = sq;
            }
        }
        for (int t = gt; t < 8 * MT / 4; t += NGT) *((f32x4*)(ssq + MT) + t) = (f32x4){0.f, 0.f, 0.f, 0.f};
    }
}

constexpr int KROW = 72, DROW = 520;
constexpr int LK_OFF = 0, LV_OFF = 2 * 192 * KROW * 2, LMIX_END = 2 * LV_OFF;
static_assert(LMIX_END <= 131072 && 64 * DROW * 2 <= 131072, "mixer LDS");
typedef short v4i16_t __attribute__((ext_vector_type(4)));
__device__ __forceinline__ u32x2 tr_read(const LAS unsigned char* q) { const v4i16_t r = __builtin_amdgcn_ds_read_tr16_b64_v4i16((LAS v4i16_t*)q); return __builtin_bit_cast(u32x2, r); }
__device__ __forceinline__ bf16x8 pack8(const float* v) { u32x4 w; w.x = pk2(v[0], v[1]); w.y = pk2(v[2], v[3]); w.z = pk2(v[4], v[5]); w.w = pk2(v[6], v[7]); return __builtin_bit_cast(bf16x8, w); }
__device__ __forceinline__ void unpack8(u32x4 w, float* v) { v[0] = bflo(w.x); v[1] = bfhi(w.x); v[2] = bflo(w.y); v[3] = bfhi(w.y); v[4] = bflo(w.z); v[5] = bfhi(w.z); v[6] = bflo(w.w); v[7] = bfhi(w.w); }

template <int W> __device__ __forceinline__ void pool_stage(const Params& p, const bf16_t* z, int layer, bool is_s, int b, int c, int tok0, int g, int half, int lane, LAS unsigned char* L) {
    const int oct = lane & 15, tq = lane >> 4, c0 = 128 * g + 8 * oct, t0 = 32 * half + 8 * tq;
    const float* sp = PIN(I_SP) + ((size_t)layer * NB + b) * 15 * 512 + c0;
    u32x4 raw[W + 7];
#pragma unroll
    for (int j = 0; j < W + 7; ++j) {
        const int t = t0 - (W - 1) + j;
        u32x4 r = {0u, 0u, 0u, 0u};
        if (t >= 0 || (!is_s && c * 64 + t >= 0)) r = *(const u32x4*)(z + (size_t)(tok0 + t) * NIN + 768 + c0);
        else if (is_s) { const f32x4 a = *(const f32x4*)(sp + (15 + t) * 512), bb = *(const f32x4*)(sp + (15 + t) * 512 + 4); r.x = pk2(a[0], a[1]); r.y = pk2(a[2], a[3]); r.z = pk2(bb[0], bb[1]); r.w = pk2(bb[2], bb[3]); }
        raw[j] = r;
    }
    float sum[8];
#pragma unroll
    for (int i = 0; i < 8; ++i) sum[i] = 0.f;
#pragma unroll
    for (int j = 0; j < W - 1; ++j) { float u[8]; unpack8(raw[j], u);
#pragma unroll
        for (int i = 0; i < 8; ++i) sum[i] += u[i]; }
#pragma unroll
    for (int ti = 0; ti < 8; ++ti) {
        const int t = t0 + ti; float u[8], ul[8], d[8]; unpack8(raw[W - 1 + ti], u); unpack8(raw[ti], ul);
        const int cnt = is_s ? W : min(c * 64 + t + 1, W); const float rc = 1.0f / (float)cnt;
#pragma unroll
        for (int i = 0; i < 8; ++i) { sum[i] += u[i]; d[i] = sum[i] * rc - u[i]; sum[i] -= ul[i]; }
        *(LAS bf16x8*)(L + (t * DROW + c0) * 2) = pack8(d);
        if (t >= 49 && (is_s || c == 31)) { float* o = POUT + (is_s ? O_US : O_UP) + (((size_t)layer * NB + b) * 15 + (t - 49)) * 512 + c0;
            *(f32x4*)o = (f32x4){u[0], u[1], u[2], u[3]}; *(f32x4*)(o + 4) = (f32x4){u[4], u[5], u[6], u[7]}; }
    }
}

__device__ __forceinline__ void mixer_unit(const Params& p, int layer, int cu, LAS unsigned char* L, int wv) {
    int tid_ = tid_of(wv); asm volatile("" : "+v"(tid_));
    const int tid = tid_, lane = tid & 63, wave = __builtin_amdgcn_readfirstlane(tid >> 6);
    const bool is_s = cu >= 1024;
    const int b = is_s ? cu - 1024 : (cu >> 5), c = is_s ? 0 : (cu & 31);
    const int tok0 = is_s ? MP + b * 64 : b * SEQ + c * 64;
    const int kstart = is_s ? 0 : (c >= 2 ? 0 : (2 - c) * 64);
    const int pidx0 = is_s ? 2048 : c * 64;
    const bf16_t* z = (const bf16_t*)(PWS + WS_Z); bf16_t* mix = (bf16_t*)(PWS + WS_MIX);
    const float* rope = (const float*)(PWS + WS_ROPE);
    const int q16 = lane & 15, quad = lane >> 4, h = wave, kvhq = h >> 2;
    const int piece = tid & 31, rsub = tid >> 5, sub = piece & 7, kvh = (piece >> 3) & 1; const bool isK = piece < 16;
    const int klo = is_s ? 128 : kstart, npass = (192 - klo) >> 4;
    u32x4 raw[12], qraw[4][2];
#pragma unroll
    for (int ps = 0; ps < 12; ++ps) if (ps < npass) raw[ps] = *(const u32x4*)(z + (size_t)(tok0 + klo + 16 * ps + rsub - 128) * NIN + 512 + piece * 8);
    if (is_s) {
#pragma unroll 1
        for (int ps = 0; ps < 8; ++ps) {
            const int kk = 16 * ps + rsub; const size_t o = ((((size_t)layer * NB + b) * 128 + kk) * 2 + kvh) * 64 + sub * 8;
            const float* src = (isK ? PIN(I_CK) : PIN(I_CV)) + o;
            const f32x4 a0 = *(const f32x4*)src, a1 = *(const f32x4*)(src + 4);
            float v[8] = {a0[0], a0[1], a0[2], a0[3], a1[0], a1[1], a1[2], a1[3]};
            *(LAS bf16x8*)(L + (isK ? LK_OFF : LV_OFF) + ((kvh * 192 + kk) * KROW + sub * 8) * 2) = pack8(v);
            if (kk >= 64) { float* dst = POUT + (isK ? O_KS : O_VS) + ((((size_t)layer * NB + b) * 128 + (kk - 64)) * 2 + kvh) * 64 + sub * 8; *(f32x4*)dst = a0; *(f32x4*)(dst + 4) = a1; }
        }
    }
    {
        float kn[8];
#pragma unroll
        for (int i = 0; i < 8; ++i) kn[i] = PIN(I_KN)[layer * 64 + sub * 8 + i];
#pragma unroll
        for (int ps = 0; ps < 12; ++ps) if (ps < npass) {
            const int kk = klo + 16 * ps + rsub;
            float v[8]; unpack8(raw[ps], v);
            float ss = 0.f;
#pragma unroll
            for (int i = 0; i < 8; ++i) ss += v[i] * v[i];
            ss += __shfl_xor(ss, 1); ss += __shfl_xor(ss, 2); ss += __shfl_xor(ss, 4);
            const float rs = __builtin_amdgcn_rsqf(ss * (1.0f / 64.0f) + EPS);
            float pv[8];
#pragma unroll
            for (int i = 0; i < 8; ++i) { if (isK) v[i] = v[i] * rs * kn[i]; pv[i] = __shfl_xor(v[i], 1); }
            if (isK && sub < 2) {
                const float* rt = rope + (size_t)(pidx0 + kk - 128) * 16;
                const f32x4 c0 = *(const f32x4*)rt, c1 = *(const f32x4*)(rt + 4), s0 = *(const f32x4*)(rt + 8), s1 = *(const f32x4*)(rt + 12);
#pragma unroll
                for (int i = 0; i < 8; ++i) { const float cs = i < 4 ? c0[i & 3] : c1[i & 3], sn = i < 4 ? s0[i & 3] : s1[i & 3]; v[i] = (sub == 0) ? v[i] * cs - pv[i] * sn : v[i] * cs + pv[i] * sn; }
            }
            *(LAS bf16x8*)(L + (isK ? LK_OFF : LV_OFF) + ((kvh * 192 + kk) * KROW + sub * 8) * 2) = pack8(v);
            int orow = -1;
            if (is_s) orow = kk - 64; else if (c >= 30 && kk >= 128) orow = (c - 30) * 64 + (kk - 128);
            if (orow >= 0) {
                float* dst = POUT + (isK ? (is_s ? O_KS : O_KP) : (is_s ? O_VS : O_VP)) + ((((size_t)layer * NB + b) * 128 + orow) * 2 + kvh) * 64 + sub * 8;
                *(f32x4*)dst = (f32x4){v[0], v[1], v[2], v[3]}; *(f32x4*)(dst + 4) = (f32x4){v[4], v[5], v[6], v[7]};
            }
        }
    }
#pragma unroll
    for (int qb = 0; qb < 4; ++qb) { const bf16_t* qp = z + (size_t)(tok0 + 16 * qb + q16) * NIN + h * 64 + 8 * quad; qraw[qb][0] = *(const u32x4*)qp; qraw[qb][1] = *(const u32x4*)(qp + 32); }
    bf16x8 qf[4][2];
    {
        float gq0[8], gq1[8];
#pragma unroll
        for (int i = 0; i < 8; ++i) { gq0[i] = PIN(I_QN)[layer * 64 + 8 * quad + i]; gq1[i] = PIN(I_QN)[layer * 64 + 32 + 8 * quad + i]; }
        constexpr float QS = 0.125f * LOG2E;
#pragma unroll
        for (int qb = 0; qb < 4; ++qb) {
            float v0[8], v1[8]; unpack8(qraw[qb][0], v0); unpack8(qraw[qb][1], v1);
            float ss = 0.f;
#pragma unroll
            for (int i = 0; i < 8; ++i) ss += v0[i] * v0[i] + v1[i] * v1[i];
            ss += __shfl_xor(ss, 16); ss += __shfl_xor(ss, 32);
            const float rs = __builtin_amdgcn_rsqf(ss * (1.0f / 64.0f) + EPS);
            float pv[8];
#pragma unroll
            for (int i = 0; i < 8; ++i) { v0[i] = v0[i] * rs * gq0[i]; v1[i] = v1[i] * rs * gq1[i] * QS; pv[i] = __shfl_xor(v0[i], 16); }
            if (quad < 2) {
                const float* rt = rope + (size_t)(pidx0 + 16 * qb + q16) * 16;
                const f32x4 c0 = *(const f32x4*)rt, c1 = *(const f32x4*)(rt + 4), s0 = *(const f32x4*)(rt + 8), s1 = *(const f32x4*)(rt + 12);
#pragma unroll
                for (int i = 0; i < 8; ++i) { const float cs = i < 4 ? c0[i & 3] : c1[i & 3], sn = i < 4 ? s0[i & 3] : s1[i & 3]; v0[i] = (quad == 0) ? v0[i] * cs - pv[i] * sn : v0[i] * cs + pv[i] * sn; }
            }
#pragma unroll
            for (int i = 0; i < 8; ++i) v0[i] *= QS;
            qf[qb][0] = pack8(v0); qf[qb][1] = pack8(v1);
        }
    }
    __syncthreads();
    {
        const float sinkv = PIN(I_SINK)[layer * 8 + h] * LOG2E;
        const LAS unsigned char* Kb = L + LK_OFF + ((kvhq * 192 + q16) * KROW + 8 * quad) * 2;
        const LAS unsigned char* Vb = L + LV_OFF + ((kvhq * 192 + 4 * quad + (q16 >> 2)) * KROW + 4 * (q16 & 3)) * 2;
#pragma unroll
        for (int pr = 0; pr < 2; ++pr) {
            f32x4 s[2][12];
#pragma unroll
            for (int kt = 0; kt < 12; ++kt) {
                if (16 * kt >= kstart) {
                    const bf16x8 k0 = *(const LAS bf16x8*)(Kb + kt * 16 * KROW * 2), k1 = *(const LAS bf16x8*)(Kb + kt * 16 * KROW * 2 + 64);
#pragma unroll
                    for (int e = 0; e < 2; ++e) { s[e][kt] = __builtin_amdgcn_mfma_f32_16x16x32_bf16(k0, qf[2 * pr + e][0], (f32x4){0.f, 0.f, 0.f, 0.f}, 0, 0, 0);
                        s[e][kt] = __builtin_amdgcn_mfma_f32_16x16x32_bf16(k1, qf[2 * pr + e][1], s[e][kt], 0, 0, 0); }
                } else { s[0][kt] = (f32x4){-1e30f, -1e30f, -1e30f, -1e30f}; s[1][kt] = s[0][kt]; }
            }
            float inv[2];
#pragma unroll
            for (int e = 0; e < 2; ++e) {
                float mx = sinkv;
#pragma unroll
                for (int kt = 0; kt < 12; ++kt) mx = fmaxf(fmaxf(mx, fmaxf(s[e][kt][0], s[e][kt][1])), fmaxf(s[e][kt][2], s[e][kt][3]));
                mx = fmaxf(mx, __shfl_xor(mx, 16)); mx = fmaxf(mx, __shfl_xor(mx, 32));
                float l = 0.f;
#pragma unroll
                for (int kt = 0; kt < 12; ++kt)
#pragma unroll
                    for (int j = 0; j < 4; ++j) { s[e][kt][j] = __builtin_amdgcn_exp2f(s[e][kt][j] - mx); l += s[e][kt][j]; }
                l += __shfl_xor(l, 16); l += __shfl_xor(l, 32);
                l += __builtin_amdgcn_exp2f(sinkv - mx);
                inv[e] = 1.0f / l;
            }
            f32x4 o[2][4];
#pragma unroll
            for (int e = 0; e < 2; ++e)
#pragma unroll
                for (int dt = 0; dt < 4; ++dt) o[e][dt] = (f32x4){0.f, 0.f, 0.f, 0.f};
#pragma unroll
            for (int si = 0; si < 6; ++si) {
                if (32 * si >= kstart) {
                    bf16x8 pf[2];
#pragma unroll
                    for (int e = 0; e < 2; ++e) { u32x4 pw; pw.x = pk2(s[e][2 * si][0], s[e][2 * si][1]); pw.y = pk2(s[e][2 * si][2], s[e][2 * si][3]); pw.z = pk2(s[e][2 * si + 1][0], s[e][2 * si + 1][1]); pw.w = pk2(s[e][2 * si + 1][2], s[e][2 * si + 1][3]); pf[e] = __builtin_bit_cast(bf16x8, pw); }
#pragma unroll
                    for (int dt = 0; dt < 4; ++dt) {
                        const u32x2 a = tr_read(Vb + ((32 * si) * KROW + 16 * dt) * 2), bq = tr_read(Vb + ((32 * si + 16) * KROW + 16 * dt) * 2);
                        const u32x4 vw = {a.x, a.y, bq.x, bq.y}; const bf16x8 vf = __builtin_bit_cast(bf16x8, vw);
#pragma unroll
                        for (int e = 0; e < 2; ++e) o[e][dt] = __builtin_amdgcn_mfma_f32_16x16x32_bf16(vf, pf[e], o[e][dt], 0, 0, 0);
                    }
                }
            }
#pragma unroll
            for (int e = 0; e < 2; ++e) { const int row = tok0 + 16 * (2 * pr + e) + q16;
#pragma unroll
                for (int dt = 0; dt < 4; ++dt) { u32x2 w; w.x = pk2(o[e][dt][0] * inv[e], o[e][dt][1] * inv[e]); w.y = pk2(o[e][dt][2] * inv[e], o[e][dt][3] * inv[e]);
                    *(u32x2*)(mix + (size_t)row * DM + h * 64 + 16 * dt + 4 * quad) = w; } }
        }
    }
    __syncthreads();
    {
        const int g = wave >> 1, half = wave & 1;
        if (g == 0) pool_stage<2>(p, z, layer, is_s, b, c, tok0, g, half, lane, L);
        else if (g == 1) pool_stage<4>(p, z, layer, is_s, b, c, tok0, g, half, lane, L);
        else if (g == 2) pool_stage<8>(p, z, layer, is_s, b, c, tok0, g, half, lane, L);
        else pool_stage<16>(p, z, layer, is_s, b, c, tok0, g, half, lane, L);
    }
    __syncthreads();
    {
        const int g = wave >> 1, th = wave & 1;
        bf16x8 dfr[2][4];
#pragma unroll
        for (int tb = 0; tb < 2; ++tb)
#pragma unroll
            for (int ks = 0; ks < 4; ++ks) dfr[tb][ks] = *(const LAS bf16x8*)(L + ((32 * th + 16 * tb + q16) * DROW + 128 * g + 32 * ks + 8 * quad) * 2);
        const bf16_t* wp = (const bf16_t*)(PWS + WS_W + (size_t)layer * WL_STRIDE + WL_POOL) + (size_t)g * 128 * 128;
#pragma unroll 2
        for (int nt = 0; nt < 8; ++nt) {
            bf16x8 wf[4];
#pragma unroll
            for (int ks = 0; ks < 4; ++ks) wf[ks] = *(const bf16x8*)(wp + (16 * nt + q16) * 128 + 32 * ks + 8 * quad);
#pragma unroll
            for (int tb = 0; tb < 2; ++tb) {
                f32x4 o = (f32x4){0.f, 0.f, 0.f, 0.f};
#pragma unroll
                for (int ks = 0; ks < 4; ++ks) o = __builtin_amdgcn_mfma_f32_16x16x32_bf16(wf[ks], dfr[tb][ks], o, 0, 0, 0);
                u32x2 ww; ww.x = pk2(o[0], o[1]); ww.y = pk2(o[2], o[3]);
                *(u32x2*)(mix + (size_t)(tok0 + 32 * th + 16 * tb + q16) * DM + 512 + 128 * g + 16 * nt + 4 * quad) = ww;
            }
        }
    }
    __syncthreads();
}

#define XB_TMO      128
#define XB_XCNT(j)  (256  + 64 * (j))
#define XB_XSUB(j)  (1280 + 64 * (j))
#define XB_XGEN(j)  (2304 + 64 * (j))
#define XB_TOP      3328
#define XB_TOPGEN   3392
#define XCD_BAR_WORDS 3456
#define XB_SPIN_CAP (1u << 18)

__device__ __forceinline__ unsigned xb_ld(unsigned* p)              { return __hip_atomic_load(p, __ATOMIC_RELAXED, __HIP_MEMORY_SCOPE_AGENT); }
__device__ __forceinline__ unsigned xb_add(unsigned* p, unsigned v) { return __hip_atomic_fetch_add(p, v, __ATOMIC_RELAXED, __HIP_MEMORY_SCOPE_AGENT); }
__device__ __forceinline__ unsigned xb_xcc_id() { return (unsigned)__builtin_amdgcn_s_getreg((3 << 11) | 20) & 0xFu; }
#define XB_SPIN(cond, bar) do { unsigned _sp = 0; while (cond) { __builtin_amdgcn_s_sleep(1); \
    if ((++_sp & 255u) == 0u) { if (xb_ld(&(bar)[XB_TMO])) break; if (_sp > XB_SPIN_CAP) { atomicAdd(&(bar)[XB_TMO], 1u); break; } } } } while (0)

struct XcdBarrier {
    unsigned* bar; unsigned x;
    volatile LAS unsigned* st;
};

__device__ __forceinline__ XcdBarrier xcd_barrier_post(unsigned* bar, volatile LAS unsigned* st) {
    XcdBarrier b; b.bar = bar; b.x = xb_xcc_id(); b.st = st;
    if (threadIdx.x == 0) (void)xb_add(&bar[XB_XCNT(b.x)], 1u);
    return b;
}
__device__ __forceinline__ void xcd_barrier_complete(unsigned* bar, unsigned x, unsigned& nloc, unsigned& nx) {
    const unsigned G = gridDim.x * gridDim.y * gridDim.z;
    unsigned sum, cnt, mine, sp = 0u;
    for (;;) {
        sum = 0u; cnt = 0u; mine = 0u;
#pragma unroll
        for (unsigned j = 0; j < 16; ++j) { const unsigned c = xb_ld(&bar[XB_XCNT(j)]); sum += c; cnt += (c > 0u) ? 1u : 0u; mine = (j == x) ? c : mine; }
        if (sum == G) break;
        __builtin_amdgcn_s_sleep(1);
        if ((++sp & 255u) == 0u) { if (xb_ld(&bar[XB_TMO])) break; if (sp > XB_SPIN_CAP) { atomicAdd(&bar[XB_TMO], 1u); break; } }
    }
    nloc = mine > 0u ? mine : 1u; nx = cnt > 0u ? cnt : 1u;
}

__device__ __forceinline__ void xcd_barrier(const XcdBarrier& b, bool t0) {
    asm volatile("s_waitcnt vmcnt(0)" ::: "memory");
    __syncthreads();
    if (t0) {
        unsigned* bar = b.bar;
        __builtin_amdgcn_s_waitcnt(0);
        unsigned nloc = b.st[0], nx = b.st[1];
        if (nloc == 0u) { xcd_barrier_complete(bar, b.x, nloc, nx); b.st[0] = nloc; b.st[1] = nx; }
        const unsigned old = xb_add(&bar[XB_XSUB(b.x)], 1u);
        const unsigned gen = old / nloc;
        if (old + 1u == (gen + 1u) * nloc) {
            __builtin_amdgcn_fence(__ATOMIC_RELEASE, "agent");
            asm volatile("s_waitcnt vmcnt(0)" ::: "memory");
            const unsigned og = xb_add(&bar[XB_TOP], 1u);
            const unsigned tg = og / nx;
            if (og + 1u == (tg + 1u) * nx) xb_add(&bar[XB_TOPGEN], 1u);
            else XB_SPIN(xb_ld(&bar[XB_TOPGEN]) == tg, bar);
            __builtin_amdgcn_fence(__ATOMIC_ACQUIRE, "agent");
            xb_add(&bar[XB_XGEN(b.x)], 1u);
            asm volatile("s_waitcnt vmcnt(0)" ::: "memory");
        } else {
            XB_SPIN(xb_ld(&bar[XB_XGEN(b.x)]) == gen, bar);
            __builtin_amdgcn_fence(__ATOMIC_ACQUIRE, "agent");
            asm volatile("s_waitcnt vmcnt(0)" ::: "memory");
        }
    }
    __syncthreads();
}

constexpr int LDS_BYTES = 131072 + 4096;
__global__ void __launch_bounds__(512, 2) hymba_fwd(Params p) {
    extern __shared__ __attribute__((aligned(16))) unsigned char lds_raw[];
    LAS unsigned char* L = (LAS unsigned char*)lds_raw;
    cg::grid_group grid = cg::this_grid();
    const int wv = __builtin_amdgcn_readfirstlane((int)threadIdx.x >> 6);
    if (threadIdx.x < 26) *(LAS unsigned long long*)(L + 131072 + 256 + 8 * threadIdx.x) = threadIdx.x < 24 ? (unsigned long long)p.in[threadIdx.x] : threadIdx.x == 24 ? (unsigned long long)p.ws : (unsigned long long)p.out;
#define PHASE_VARS size_t oz_ = 0; int ly = layer; asm volatile("" : "+s"(oz_), "+s"(ly)); unsigned char* ws = PWS + oz_; bf16_t* xb = (bf16_t*)(ws + WS_XB); bf16_t* act = (bf16_t*)(ws + WS_ACT); bf16_t* zb = (bf16_t*)(ws + WS_Z); bf16_t* mixb = (bf16_t*)(ws + WS_MIX); bf16_t* ub = (bf16_t*)(ws + WS_U); \
        float* xres = POUT + O_Y; unsigned char* wl = ws + WS_W + (size_t)ly * WL_STRIDE; float* sq = (float*)(ws + WS_SSQ) + (size_t)ly * 4 * MT; (void)xb; (void)act; (void)zb; (void)mixb; (void)ub; (void)xres; (void)wl; (void)sq;
    const int G = gridDim.x, c = blockIdx.x;
#define TAIL_PREP(first_idle, lyr, msk) do { int Gt_ = G, ct_ = c, lt_ = (lyr); asm volatile("" : "+s"(Gt_), "+s"(ct_), "+s"(lt_)); if (Gt_ == 256 && ct_ >= (first_idle) && lt_ < NLAYER) prep(p, L, wv, ct_ - (first_idle), 256 - (first_idle), lt_, (msk)); } while (0)
#define XBAR() do { XcdBarrier bar_; bar_.bar = (unsigned*)(PWS + WS_BAR); bar_.x = xb_xcc_id(); bar_.st = (volatile LAS unsigned*)(L + 131072 + 64); int t_ = tid_of(wv); asm volatile("" : "+v"(t_)); xcd_barrier(bar_, t_ == 0); } while (0)
    volatile LAS unsigned* bst = (volatile LAS unsigned*)(L + 131072 + 64);
    if (threadIdx.x == 0) { bst[0] = 0u; bst[1] = 0u; }
    __syncthreads();
    (void)xcd_barrier_post((unsigned*)(PWS + WS_BAR), bst);
    if (G == 256) prep(p, L, wv, c, G, 0, PM_X | PM_FFA_IN | PM_FFA_OUT);
    else { prep(p, L, wv, c, G, 0, PM_X | PM_ROPE | PM_ALLW); prep(p, L, wv, c, G, 1, PM_ALLW); }
    grid.sync();
#pragma unroll 1
    for (int layer = 0; layer < NLAYER; ++layer) {
        { PHASE_VARS pg8::Gemm g{ly == 0 ? xb : (const bf16_t*)(ws + WS_XB2), (const bf16_t*)(wl + WL_FFA_IN), MT, NFF2, DM}; pg8::StaticOrder S; S.init(MT, NFF2, G, c); EpiSwiglu E{act, sq};
          pg8::gemm_phase<EpiSwiglu, pg8::StaticOrder, true, true>(L, g, S, E, wv); }
        XBAR();
        { PHASE_VARS pg8::Gemm g{act, (const bf16_t*)(wl + WL_FFA_OUT), MT, DM, DFF}; pg8::StaticOrder S; S.init(MT, DM, G, c);
          EpiResid<0> E{ly == 0 ? xb : (const bf16_t*)(ws + WS_XB2), xb, nullptr, sq + MT, 0.5f, nullptr, nullptr};
          pg8::gemm_phase<EpiResid<0>, pg8::StaticOrder, true, true>(L, g, S, E, wv); }
        TAIL_PREP(32, layer == 0 ? 0 : NLAYER, PM_WIN | PM_POOL | PM_ROPE | PM_WOUT | PM_FFB_IN | PM_FFB_OUT | PM_PEG | PM_PEU | PM_P);
        XBAR();
        { PHASE_VARS pg8::Gemm g{xb, (const bf16_t*)(wl + WL_IN), MT, NIN, DM}; pg8::StaticOrder S; S.init(MT, NIN, G, c); EpiStore E{zb, NIN, sq + MT};
          pg8::gemm_phase<EpiStore, pg8::StaticOrder, true, true>(L, g, S, E, wv); }
        TAIL_PREP(40, layer + 1, PM_FFA_IN);
        XBAR();
#pragma unroll 1
        for (int cu = c; cu < 1056; cu += G) { int Gl = G; asm volatile("" : "+s"(Gl)); const int un = (Gl == 256 && cu < 1024) ? ((cu & 255) << 2) + (cu >> 8) : cu; mixer_unit(p, layer, un, L, wv); }
        TAIL_PREP(32, layer + 1, PM_FFA_OUT | PM_WIN | PM_POOL | PM_P);
        XBAR();
        { PHASE_VARS pg8::Gemm g{mixb, (const bf16_t*)(wl + WL_OUT), MT, DM, DM}; pg8::StaticOrder S; S.init(MT, DM, G, c);
          EpiResid<0> E{xb, xb, nullptr, sq + 2 * MT, 1.0f, nullptr, nullptr};
          pg8::gemm_phase<EpiResid<0>, pg8::StaticOrder, true, true>(L, g, S, E, wv); }
        TAIL_PREP(32, layer + 1, PM_FFB_IN);
        XBAR();
        { PHASE_VARS pg8::Gemm g{xb, (const bf16_t*)(wl + WL_FFB_IN), MT, NFF2, DM}; pg8::StaticOrder S; S.init(MT, NFF2, G, c); EpiSwiglu E{act, sq + 2 * MT};
          pg8::gemm_phase<EpiSwiglu, pg8::StaticOrder, true, true>(L, g, S, E, wv); }
        XBAR();
        { PHASE_VARS pg8::Gemm g{act, (const bf16_t*)(wl + WL_FFB_OUT), MT, DM, DFF}; pg8::StaticOrder S; S.init(MT, DM, G, c);
          EpiResid<0> E{xb, xb, nullptr, sq + 3 * MT, 0.5f, nullptr, nullptr};
          pg8::gemm_phase<EpiResid<0>, pg8::StaticOrder, true, true>(L, g, S, E, wv); }
        int Gf = G, cf = c; asm volatile("" : "+s"(Gf), "+s"(cf));
        if (Gf == 256 ? cf >= 32 : true) { PHASE_VARS pg8::Gemm g{(const bf16_t*)(ws + WS_PB) + (size_t)ly * MT * PED, (const bf16_t*)(wl + WL_PEU), MT, DM, PED}; pg8::StaticOrder S;
          if (Gf == 256) S.init(MT, DM, 224, cf - 32); else S.init(MT, DM, Gf, cf);
          EpiStore E{(bf16_t*)(ws + WS_U2), DM, nullptr};
          pg8::gemm_phase<EpiStore, pg8::StaticOrder, true, true>(L, g, S, E, wv); }
        XBAR();
        { PHASE_VARS pg8::Gemm g{xb, (const bf16_t*)(wl + WL_PEG), MT, DM, DM}; pg8::StaticOrder S; S.init(MT, DM, G, c);
          EpiResid<1> E{xb, (bf16_t*)(ws + WS_XB2), ly + 1 < NLAYER ? nullptr : xres, sq + 4 * MT, 1.0f, (const bf16_t*)(ws + WS_U2), sq + 3 * MT};
          pg8::gemm_phase<EpiResid<1>, pg8::StaticOrder, true, true>(L, g, S, E, wv); }
        TAIL_PREP(32, layer + 1, PM_FFB_OUT | PM_WOUT | PM_PEG | PM_PEU);
        if (layer + 1 < NLAYER) XBAR();
    }
}

extern "C" void kernel_launch(void* const* d_in, const int* in_sizes, int n_in, void* d_out, int out_size, void* d_ws, size_t ws_size, hipStream_t stream) {
    static int grid = 0;
    if (grid == 0) {
        if (n_in != 24 || in_sizes[0] != MP * DM || (size_t)out_size != O_END || ws_size < WS_END) { fprintf(stderr, "kernel_launch: unexpected shapes (n_in %d, in0 %d, out %d, ws %zu)\n", n_in, n_in > 0 ? in_sizes[0] : -1, out_size, ws_size); grid = -1; return; }
        int dev = 0, cus = 0, per_cu = 0;
        if (hipGetDevice(&dev) != hipSuccess || hipDeviceGetAttribute(&cus, hipDeviceAttributeMultiprocessorCount, dev) != hipSuccess) { grid = -1; return; }
        if (hipFuncSetAttribute((const void*)hymba_fwd, hipFuncAttributeMaxDynamicSharedMemorySize, LDS_BYTES) != hipSuccess) { fprintf(stderr, "kernel_launch: hipFuncSetAttribute failed\n"); grid = -1; return; }
        if (hipOccupancyMaxActiveBlocksPerMultiprocessor(&per_cu, (const void*)hymba_fwd, 512, LDS_BYTES) != hipSuccess || per_cu < 1) { fprintf(stderr, "kernel_launch: occupancy query says %d\n", per_cu); per_cu = 1; }
        (void)hipGetLastError();
        grid = cus * 1;
    }
    if (grid < 0) return;
    if (hipMemsetAsync((char*)d_ws + WS_BAR, 0, 16384, stream) != hipSuccess) { fprintf(stderr, "kernel_launch: memset of the barrier words failed\n"); return; }
    Params p{};
    for (int i = 0; i < 24; ++i) p.in[i] = (const float*)d_in[i];
    p.out = (float*)d_out; p.ws = (unsigned char*)d_ws;
    void* args[] = {&p};
    hipError_t e = hipLaunchCooperativeKernel((const void*)hymba_fwd, dim3(grid), dim3(512), args, LDS_BYTES, stream);
    if (e != hipSuccess) fprintf(stderr, "kernel_launch: cooperative launch failed: %s (grid %d)\n", hipGetErrorString(e), grid);
}
```

```cpp
#include <hip/hip_runtime.h>
#include <hip/hip_cooperative_groups.h>
#include <cstdio>
#include <cstdint>
namespace cg = cooperative_groups;
__device__ __forceinline__ int tid_of(int wv) { return wv * 64 + (int)__builtin_amdgcn_mbcnt_hi(~0u, __builtin_amdgcn_mbcnt_lo(~0u, 0u)); }
namespace pg8 {
#define PG8_LAS __attribute__((address_space(3)))
typedef unsigned short bf16_t;
typedef short bf16x8 __attribute__((ext_vector_type(8)));
typedef float f32x4 __attribute__((ext_vector_type(4)));
typedef unsigned u32x4 __attribute__((ext_vector_type(4)));
constexpr int BM = 256, BK = 64, HALF = 128, HTB = HALF * BK * 2  , STAGE_BYTES = 8 * HTB, NXCD = 8, WGM = 8;

__host__ __device__ __forceinline__ int lds_byte(int r, int c) { const int st = (r >> 4) * 2 + (c >> 5), rr = r & 15, cc = c & 31, ob = rr * 64 + cc * 2; return st * 1024 + (ob ^ (((ob >> 9) & 1) << 5)); }
__host__ __device__ __forceinline__ void stage_rc(int b, int& R, int& C) { const int st = b / 1024, sb = b % 1024, swz = sb ^ (((sb >> 9) & 1) << 5); R = (st >> 1) * 16 + swz / 64; C = (st & 1) * 32 + (swz % 64) / 2; }
__host__ __device__ __forceinline__ int perm32(int rho) { const int n = rho >> 4, i = rho & 15; return 8 * (i >> 2) + 4 * n + (i & 3); }

struct Unit { int pm, pn; };
struct Gemm { const bf16_t* A; const bf16_t* Bt; int M, N, K; };

struct StaticOrder {
    int nM, nN, nwg, G, c;
    __host__ __device__ void init(int M, int N, int G_, int c_) { nM = M / BM; nN = N / BM; nwg = nM * nN; G = G_; c = c_; }
    __host__ __device__ bool next(int i, Unit& u) const {
        const int L = i * G + c; if (L >= nwg) return false;
        int wgid = L; { const int q = nwg / NXCD, r = nwg % NXCD, xcd = wgid % NXCD, off = wgid / NXCD; wgid = (xcd < r ? xcd * (q + 1) : r * (q + 1) + (xcd - r) * q) + off; }
        const int nig = WGM * nN, gid = wgid / nig, fm = gid * WGM, gsz = (nM - fm) < WGM ? (nM - fm) : WGM;
        u.pm = fm + ((wgid % nig) % gsz); u.pn = (wgid % nig) / gsz; return true;
    }
    __device__ __forceinline__ void a_ready(const Unit&) const {}
    __device__ __forceinline__ void done(const Unit&) const {}
};
__device__ __forceinline__ unsigned cvt_pk_bf16(float lo, float hi) { unsigned r; asm volatile("v_cvt_pk_bf16_f32 %0, %1, %2" : "=v"(r) : "v"(lo), "v"(hi)); return r; }
typedef float f32x2 __attribute__((ext_vector_type(2)));
template <class Epi, class Sched, bool ALIGN_EPI = false, bool SP2 = false>
__device__ __forceinline__ void gemm_phase(PG8_LAS unsigned char* lds, const Gemm g, const Sched& S, const Epi& E, int wv) {
    int tid_ = tid_of(wv); asm volatile("" : "+v"(tid_));
    const int tid = tid_, wid = __builtin_amdgcn_readfirstlane(tid >> 6), lane = tid & 63, wr = wid >> 2, wc = wid & 3, fr = lane & 15, fq = lane >> 4;
    const int K = g.K, nt = K / BK;
    unsigned voffA[2], voffB[2];
#pragma unroll
    for (int i = 0; i < 2; ++i) { int R, C; stage_rc(tid * 16 + i * 8192, R, C); const int Rb = Epi::PERM ? ((R & ~31) + perm32(R & 31)) : R;
        voffA[i] = (unsigned)(R * K + C) * 2u; voffB[i] = (unsigned)(Rb * K + C) * 2u; }
    const size_t kstep = (size_t)(BK * 2);
    const size_t hstep = (size_t)HALF * K * 2;
    const size_t tstep = 2 * hstep;
    const unsigned ldsw = (unsigned)wid * 1024u;
    const int aoff = lds_byte(wr * 64 + fr, fq * 8), boff = lds_byte(wc * 32 + fr, fq * 8);
#define PG8_SA(b, h) (((b) * 2 + (h)) * HTB)
#define PG8_SB(b, h) ((4 + (b) * 2 + (h)) * HTB)
#define PG8_STAGE(bufoff, gbase, voff) do { _Pragma("unroll") for (int _i = 0; _i < 2; ++_i) \
        __builtin_amdgcn_global_load_lds((const unsigned*)((const char*)(gbase) + (voff)[_i]), (PG8_LAS unsigned*)(lds + (bufoff) + ldsw + _i * 8192), 16, 0, 0); } while (0)
#define PG8_LDA(dst, b, h) do { _Pragma("unroll") for (int m = 0; m < 4; ++m) _Pragma("unroll") for (int k = 0; k < 2; ++k) dst[m][k] = *(const PG8_LAS bf16x8*)(lds + PG8_SA(b, h) + aoff + m * 2048 + k * 1024); } while (0)
#define PG8_LDB(dst, b, h) do { _Pragma("unroll") for (int n = 0; n < 2; ++n) _Pragma("unroll") for (int k = 0; k < 2; ++k) dst[n][k] = *(const PG8_LAS bf16x8*)(lds + PG8_SB(b, h) + boff + n * 2048 + k * 1024); } while (0)
#define PG8_MMA(ai, bj, At, Bt) do { __builtin_amdgcn_s_setprio(1); _Pragma("unroll") for (int m = 0; m < 4; ++m) _Pragma("unroll") for (int n = 0; n < 2; ++n) _Pragma("unroll") for (int k = 0; k < 2; ++k) \
        acc[ai][bj][m][n] = __builtin_amdgcn_mfma_f32_16x16x32_bf16(Bt[n][k], At[m][k], acc[ai][bj][m][n], 0, 0, 0); __builtin_amdgcn_s_setprio(0); } while (0)
#define PG8_WAIT_V(n) asm volatile("s_waitcnt vmcnt(" #n ")" ::: "memory")
#define PG8_WAIT_L(n) asm volatile("s_waitcnt lgkmcnt(" #n ")" ::: "memory")
#define PG8_BAR __builtin_amdgcn_s_barrier()
#define PG8_SCHED __builtin_amdgcn_sched_barrier(0)
    Unit cur, nxt; int ui = 0;
    if (!S.next(0, cur)) return;
    f32x4 acc[2][2][4][2];
#pragma unroll
    for (int a = 0; a < 2; ++a)
#pragma unroll
        for (int b = 0; b < 2; ++b)
#pragma unroll
            for (int m = 0; m < 4; ++m)
#pragma unroll
                for (int n = 0; n < 2; ++n) acc[a][b][m][n] = (f32x4){0.f, 0.f, 0.f, 0.f};
    bf16x8 At[4][2], B0[2][2], B1[2][2];
    const char* cA = (const char*)g.A + (size_t)cur.pm * tstep; const char* cB = (const char*)g.Bt + (size_t)cur.pn * tstep;
    S.a_ready(cur);
    if constexpr (SP2) {
        PG8_STAGE(PG8_SB(0, 0), cB, voffB); PG8_STAGE(PG8_SB(0, 1), cB + hstep, voffB); PG8_STAGE(PG8_SA(0, 0), cA, voffA); PG8_STAGE(PG8_SA(0, 1), cA + hstep, voffA);
        if (wr == 1) PG8_BAR;
        PG8_WAIT_V(2); PG8_BAR;
        PG8_STAGE(PG8_SB(1, 0), cB + kstep, voffB); PG8_STAGE(PG8_SA(1, 0), cA + kstep, voffA); PG8_STAGE(PG8_SB(1, 1), cB + hstep + kstep, voffB);
        PG8_WAIT_V(6); PG8_BAR;
    } else {
        PG8_STAGE(PG8_SB(0, 0), cB, voffB); PG8_STAGE(PG8_SA(0, 0), cA, voffA); PG8_STAGE(PG8_SB(0, 1), cB + hstep, voffB); PG8_STAGE(PG8_SA(0, 1), cA + hstep, voffA);
        if (wr == 1) PG8_BAR;
        PG8_WAIT_V(4); PG8_BAR;
        PG8_STAGE(PG8_SB(1, 0), cB + kstep, voffB); PG8_STAGE(PG8_SA(1, 0), cA + kstep, voffA); PG8_STAGE(PG8_SB(1, 1), cB + hstep + kstep, voffB);
        PG8_WAIT_V(6); PG8_BAR;
    }
    for (;;) {
        const bool has_next = S.next(ui + 1, nxt);
        const char* nA = has_next ? (const char*)g.A + (size_t)nxt.pm * tstep : cA; const char* nB = has_next ? (const char*)g.Bt + (size_t)nxt.pn * tstep : cB;
        for (int t = 0; t < nt; t += 2) {
            const bool last = (t == nt - 2);
            const char* a1 = cA + (size_t)(t + 1) * kstep;
            const char* a2 = last ? nA : cA + (size_t)(t + 2) * kstep; const char* b2 = last ? nB : cB + (size_t)(t + 2) * kstep;
            const char* a3 = a2 + kstep; const char* b3 = b2 + kstep;
            if (last && has_next) S.a_ready(nxt);
            if constexpr (SP2) {
            PG8_LDB(B0, 0, 0); PG8_LDB(B1, 0, 1); PG8_SCHED; PG8_LDA(At, 0, 0); PG8_STAGE(PG8_SA(1, 1), a1 + hstep, voffA);
            PG8_WAIT_V(8); PG8_WAIT_L(0); PG8_BAR; PG8_MMA(0, 0, At, B0); PG8_MMA(0, 1, At, B1); PG8_BAR; PG8_SCHED;
            PG8_LDA(At, 0, 1); PG8_STAGE(PG8_SB(0, 0), b2, voffB); PG8_STAGE(PG8_SB(0, 1), b2 + hstep, voffB); PG8_STAGE(PG8_SA(0, 0), a2, voffA);
            PG8_WAIT_V(8); PG8_WAIT_L(0); PG8_BAR; PG8_MMA(1, 0, At, B0); PG8_MMA(1, 1, At, B1); PG8_BAR; PG8_SCHED;
            PG8_LDB(B0, 1, 0); PG8_LDB(B1, 1, 1); PG8_SCHED; PG8_LDA(At, 1, 0); PG8_STAGE(PG8_SA(0, 1), a2 + hstep, voffA);
            PG8_WAIT_V(8); PG8_WAIT_L(0); PG8_BAR; PG8_MMA(0, 0, At, B0); PG8_MMA(0, 1, At, B1); PG8_BAR; PG8_SCHED;
            PG8_LDA(At, 1, 1); PG8_STAGE(PG8_SB(1, 0), b3, voffB); PG8_STAGE(PG8_SB(1, 1), b3 + hstep, voffB); PG8_STAGE(PG8_SA(1, 0), a3, voffA);
            PG8_WAIT_V(8); PG8_WAIT_L(0); PG8_BAR; PG8_MMA(1, 0, At, B0); PG8_MMA(1, 1, At, B1); PG8_BAR; PG8_SCHED;
            } else {
            PG8_LDB(B0, 0, 0); PG8_SCHED; PG8_LDA(At, 0, 0); PG8_STAGE(PG8_SA(1, 1), a1 + hstep, voffA);
            PG8_WAIT_L(8); PG8_BAR; PG8_WAIT_L(0); PG8_MMA(0, 0, At, B0); PG8_BAR; PG8_SCHED;
            PG8_LDB(B1, 0, 1); PG8_STAGE(PG8_SB(0, 0), b2, voffB);
            PG8_BAR; PG8_WAIT_L(0); PG8_MMA(0, 1, At, B1); PG8_BAR;
            PG8_LDA(At, 0, 1); PG8_STAGE(PG8_SA(0, 0), a2, voffA);
            PG8_BAR; PG8_WAIT_L(0); PG8_MMA(1, 0, At, B0); PG8_BAR; PG8_SCHED;
            PG8_STAGE(PG8_SB(0, 1), b2 + hstep, voffB);
            PG8_WAIT_V(6); PG8_BAR; PG8_MMA(1, 1, At, B1); PG8_BAR;
            PG8_LDB(B0, 1, 0); PG8_SCHED; PG8_LDA(At, 1, 0); PG8_STAGE(PG8_SA(0, 1), a2 + hstep, voffA);
            PG8_WAIT_L(8); PG8_BAR; PG8_WAIT_L(0); PG8_MMA(0, 0, At, B0); PG8_BAR; PG8_SCHED;
            PG8_LDB(B1, 1, 1); PG8_STAGE(PG8_SB(1, 0), b3, voffB);
            PG8_BAR; PG8_WAIT_L(0); PG8_MMA(0, 1, At, B1); PG8_BAR;
            PG8_LDA(At, 1, 1); PG8_STAGE(PG8_SA(1, 0), a3, voffA);
            PG8_BAR; PG8_WAIT_L(0); PG8_MMA(1, 0, At, B0); PG8_BAR; PG8_SCHED;
            PG8_STAGE(PG8_SB(1, 1), b3 + hstep, voffB);
            PG8_WAIT_V(6); PG8_BAR; PG8_MMA(1, 1, At, B1); PG8_BAR;
            }
        }
        if constexpr (ALIGN_EPI) { if (wr == 0) PG8_BAR; }
        if constexpr (!Epi::AFTER_DRAIN) { E(acc, cur, wr, wc, fr, fq); S.done(cur); }
        if (!has_next) break;
#pragma unroll
        for (int a = 0; a < 2; ++a)
#pragma unroll
            for (int b = 0; b < 2; ++b)
#pragma unroll
                for (int m = 0; m < 4; ++m)
#pragma unroll
                    for (int n = 0; n < 2; ++n) acc[a][b][m][n] = (f32x4){0.f, 0.f, 0.f, 0.f};
        cur = nxt; cA = nA; cB = nB; ++ui;
        if constexpr (ALIGN_EPI) { if (wr == 1) PG8_BAR; }
    }
    PG8_WAIT_V(0);
    if constexpr (!ALIGN_EPI) { if (wr == 0) PG8_BAR; }
    PG8_BAR;
    if constexpr (Epi::AFTER_DRAIN) { E.fused(acc, cur, wr, wc, fr, fq, lds, wid, lane); S.done(cur); }
#undef PG8_SA
#undef PG8_SB
#undef PG8_STAGE
#undef PG8_LDA
#undef PG8_LDB
#undef PG8_MMA
#undef PG8_WAIT_V
#undef PG8_WAIT_L
#undef PG8_BAR
#undef PG8_SCHED
}
}

#define LAS __attribute__((address_space(3)))
using pg8::f32x4; using pg8::u32x4; using pg8::bf16_t; using pg8::bf16x8; using pg8::Unit;
typedef float f32x2 __attribute__((ext_vector_type(2)));
typedef __bf16 bf16x2_t __attribute__((ext_vector_type(2)));
typedef unsigned u32x2 __attribute__((ext_vector_type(2)));
constexpr int DM = 1024, DFF = 2816, NFF2 = 5632, NIN = 1280, PED = 256;
constexpr int MP = 65536, MS = 2048, MT = MP + MS;
constexpr int NB = 32, SEQ = 2048, DSEQ = 64, NLAYER = 2;
constexpr float EPS = 1e-6f, LOG2E = 1.4426950408889634f;
constexpr size_t MiB = 1u << 20;
constexpr size_t WL_FFA_IN = 0, WL_FFA_OUT = 11 * MiB, WL_IN = WL_FFA_OUT + 5 * MiB + MiB / 2, WL_OUT = WL_IN + 2 * MiB + MiB / 2, WL_FFB_IN = WL_OUT + 2 * MiB,
                 WL_FFB_OUT = WL_FFB_IN + 11 * MiB, WL_PEG = WL_FFB_OUT + 5 * MiB + MiB / 2, WL_PEU = WL_PEG + 2 * MiB, WL_POOL = WL_PEU + MiB / 2, WL_STRIDE = 41 * MiB;
static_assert(WL_POOL + 131072 <= WL_STRIDE, "weights map");
constexpr size_t WS_W = 0, WS_XB = 82 * MiB, WS_ACT = 214 * MiB, WS_Z = WS_ACT, WS_MIX = WS_ACT + 165 * MiB, WS_U = WS_ACT, WS_PB = 577 * MiB, WS_SSQ = 643 * MiB, WS_ROPE = 646 * MiB, WS_BAR = 646 * MiB + 512 * 1024, WS_XB2 = 647 * MiB, WS_U2 = 779 * MiB, WS_END = 911 * MiB;
static_assert((size_t)MT * DM * 2 == 132 * MiB && (size_t)MT * DFF * 2 == 363 * MiB && (size_t)MT * NIN * 2 == 165 * MiB && (size_t)2 * MT * PED * 2 == 66 * MiB, "buffer sizes");
constexpr size_t O_Y = 0, O_KP = (size_t)MT * DM, O_VP = O_KP + 1048576, O_UP = O_VP + 1048576, O_KS = O_UP + 491520, O_VS = O_KS + 1048576, O_US = O_VS + 1048576, O_END = O_US + 491520;

__device__ __forceinline__ unsigned long long ldp_(__attribute__((address_space(3))) unsigned char* L, int i) {
    unsigned z_ = 0u; asm volatile("" : "+v"(z_));
    const unsigned long long v = *(volatile __attribute__((address_space(3))) unsigned long long*)(L + 131072 + 256 + 8 * i + z_);
    const unsigned lo = __builtin_amdgcn_readfirstlane((unsigned)v), hi = __builtin_amdgcn_readfirstlane((unsigned)(v >> 32));
    return ((unsigned long long)hi << 32) | lo;
}
__device__ __forceinline__ void* ldq_(__attribute__((address_space(3))) unsigned char* L, int i) {
    __attribute__((address_space(1))) unsigned char* g = (__attribute__((address_space(1))) unsigned char*)ldp_(L, i); return (void*)g;
}
#define PIN(i) ((const float*)ldq_(L, (i)))
#define PWS ((unsigned char*)ldq_(L, 24))
#define POUT ((float*)ldq_(L, 25))
struct Params {
    const float* in[24]; float* out; unsigned char* ws;
};
enum { I_XP = 0, I_XS, I_PP, I_PS, I_CK, I_CV, I_SP, I_NFFA, I_WFFA_IN, I_WFFA_OUT, I_NMIX, I_WIN, I_QN, I_KN, I_SINK, I_WPOOL, I_PSCALE, I_WOUT, I_NFFB, I_WFFB_IN, I_WFFB_OUT, I_NPE, I_WPEG, I_WPEU };

__device__ __forceinline__ unsigned pk2(float lo, float hi) { f32x2 v = {lo, hi}; bf16x2_t b = __builtin_convertvector(v, bf16x2_t); return __builtin_bit_cast(unsigned, b); }
__device__ __forceinline__ float bflo(unsigned w) { return __uint_as_float(w << 16); }
__device__ __forceinline__ float bfhi(unsigned w) { return __uint_as_float(w & 0xffff0000u); }
__device__ __forceinline__ float rstd_of(const float* ssq, int row) { return __builtin_amdgcn_rsqf(ssq[row] * (1.0f / 1024.0f) + EPS); }
__device__ __forceinline__ float silu_f(float g) { return g * __builtin_amdgcn_rcpf(1.0f + __builtin_amdgcn_exp2f(-LOG2E * g)); }
__device__ __forceinline__ float sigm_f(float g) { return __builtin_amdgcn_rcpf(1.0f + __builtin_amdgcn_exp2f(-LOG2E * g)); }
__device__ __forceinline__ float wave_sum(float v) {
#pragma unroll
    for (int o = 1; o < 64; o <<= 1) v += __shfl_xor(v, o);
    return v;
}

#define GAS __attribute__((address_space(1)))
struct EpiSwiglu {
    static constexpr bool PERM = true, AFTER_DRAIN = false;
    bf16_t* act; const float* ssq;
    __device__ __forceinline__ void operator()(const f32x4 (&acc)[2][2][4][2], const Unit& u, int wr, int wc, int fr_, int fq_) const {
        int l_ = (int)__builtin_amdgcn_mbcnt_hi(~0u, __builtin_amdgcn_mbcnt_lo(~0u, 0u)); asm volatile("" : "+v"(l_)); const int fr = l_ & 15, fq = l_ >> 4; (void)fr_; (void)fq_;
        const int row0 = u.pm * 256 + wr * 64 + fr, col0 = u.pn * 128 + wc * 32 + 8 * fq;
        const GAS float* sq = (const GAS float*)ssq + row0; GAS bf16_t* ap = (GAS bf16_t*)act + (size_t)row0 * DFF + col0;
        float rsv[8];
#pragma unroll
        for (int j = 0; j < 8; ++j) rsv[j] = sq[(j >> 2) * 128 + (j & 3) * 16];
#pragma unroll
        for (int j = 0; j < 8; ++j) rsv[j] = __builtin_amdgcn_rsqf(rsv[j] * (1.0f / 1024.0f) + EPS);
#pragma unroll
        for (int ai = 0; ai < 2; ++ai)
#pragma unroll
            for (int m = 0; m < 4; ++m) {
                const float rs = rsv[ai * 4 + m];
                const f32x4 g0 = acc[ai][0][m][0] * rs, g1 = acc[ai][0][m][1] * rs, u0 = acc[ai][1][m][0] * rs, u1 = acc[ai][1][m][1] * rs;
                u32x4 w;
                w.x = pk2(silu_f(g0[0]) * u0[0], silu_f(g0[1]) * u0[1]); w.y = pk2(silu_f(g0[2]) * u0[2], silu_f(g0[3]) * u0[3]);
                w.z = pk2(silu_f(g1[0]) * u1[0], silu_f(g1[1]) * u1[1]); w.w = pk2(silu_f(g1[2]) * u1[2], silu_f(g1[3]) * u1[3]);
                *(GAS u32x4*)(ap + (size_t)(ai * 128 + m * 16) * DFF) = w;
            }
    }
};
struct EpiStore {
    static constexpr bool PERM = true, AFTER_DRAIN = false;
    bf16_t* O; int ldc; const float* ssq;
    __device__ __forceinline__ void operator()(const f32x4 (&acc)[2][2][4][2], const Unit& u, int wr, int wc, int fr_, int fq_) const {
        int l_ = (int)__builtin_amdgcn_mbcnt_hi(~0u, __builtin_amdgcn_mbcnt_lo(~0u, 0u)); asm volatile("" : "+v"(l_)); const int fr = l_ & 15, fq = l_ >> 4; (void)fr_; (void)fq_;
        const int row0 = u.pm * 256 + wr * 64 + fr, col0 = u.pn * 256 + wc * 32 + 8 * fq;
        GAS bf16_t* op = (GAS bf16_t*)O + (size_t)row0 * ldc + col0;
        float rsv[8];
        if (ssq) { const GAS float* sq = (const GAS float*)ssq + row0;
#pragma unroll
            for (int j = 0; j < 8; ++j) rsv[j] = sq[(j >> 2) * 128 + (j & 3) * 16];
#pragma unroll
            for (int j = 0; j < 8; ++j) rsv[j] = __builtin_amdgcn_rsqf(rsv[j] * (1.0f / 1024.0f) + EPS);
        } else {
#pragma unroll
            for (int j = 0; j < 8; ++j) rsv[j] = 1.0f; }
#pragma unroll
        for (int ai = 0; ai < 2; ++ai)
#pragma unroll
            for (int m = 0; m < 4; ++m) {
                const float rs = rsv[ai * 4 + m];
#pragma unroll
                for (int bj = 0; bj < 2; ++bj) {
                    const f32x4 v0 = acc[ai][bj][m][0] * rs, v1 = acc[ai][bj][m][1] * rs;
                    u32x4 w; w.x = pk2(v0[0], v0[1]); w.y = pk2(v0[2], v0[3]); w.z = pk2(v1[0], v1[1]); w.w = pk2(v1[2], v1[3]);
                    *(GAS u32x4*)(op + (size_t)(ai * 128 + m * 16) * ldc + bj * 128) = w;
                }
            }
    }
};
template <int MODE> struct EpiResid {
    static constexpr bool PERM = true, AFTER_DRAIN = false;
    const bf16_t* xi; bf16_t* xo; float* yout; float* ssq_next; float scale; const bf16_t* U; const float* ssq_cur;
    __device__ __forceinline__ void operator()(const f32x4 (&acc)[2][2][4][2], const Unit& u, int wr, int wc, int fr_, int fq_) const {
        int l_ = (int)__builtin_amdgcn_mbcnt_hi(~0u, __builtin_amdgcn_mbcnt_lo(~0u, 0u)); asm volatile("" : "+v"(l_)); const int fr = l_ & 15, fq = l_ >> 4; (void)fr_; (void)fq_;
        const int row0 = u.pm * 256 + wr * 64 + fr, col0 = u.pn * 256 + wc * 32 + 8 * fq;
        const size_t off0 = (size_t)row0 * DM + col0;
        const GAS bf16_t* xip = (const GAS bf16_t*)xi + off0; const GAS bf16_t* up = (const GAS bf16_t*)U + off0;
        GAS bf16_t* xop = (GAS bf16_t*)xo + off0; GAS float* yp = (GAS float*)yout + off0; GAS float* sn = (GAS float*)ssq_next + row0;
        float rsv[8];
        if (MODE == 1) { const GAS float* sq = (const GAS float*)ssq_cur + row0;
#pragma unroll
            for (int j = 0; j < 8; ++j) rsv[j] = sq[(j >> 2) * 128 + (j & 3) * 16]; }
        constexpr int MB = (MODE == 1) ? 2 : 4;
#pragma unroll
        for (int ab = 0; ab < 8 / MB; ++ab) {
            const int ai = (ab * MB) >> 2, mb0 = (ab * MB) & 3;
            u32x4 xw[MB][2], uw[MB][2];
#pragma unroll
            for (int mi = 0; mi < MB; ++mi)
#pragma unroll
                for (int bj = 0; bj < 2; ++bj) { xw[mi][bj] = *(const GAS u32x4*)(xip + (size_t)(ai * 128 + (mb0 + mi) * 16) * DM + bj * 128);
                    if (MODE == 1) uw[mi][bj] = *(const GAS u32x4*)(up + (size_t)(ai * 128 + (mb0 + mi) * 16) * DM + bj * 128); }
#pragma unroll
            for (int mi = 0; mi < MB; ++mi) {
                const int m = mb0 + mi;
                const size_t ro = (size_t)(ai * 128 + m * 16) * DM;
                const float rs = (MODE == 1) ? __builtin_amdgcn_rsqf(rsv[ai * 4 + m] * (1.0f / 1024.0f) + EPS) : 0.f; float ss = 0.f;
#pragma unroll
                for (int bj = 0; bj < 2; ++bj) {
                    const u32x4 xq = xw[mi][bj];
                    f32x4 a0 = acc[ai][bj][m][0], a1 = acc[ai][bj][m][1];
                    if (MODE == 1) {
                        const u32x4 uu = uw[mi][bj];
                        a0[0] = sigm_f(a0[0] * rs) * bflo(uu.x); a0[1] = sigm_f(a0[1] * rs) * bfhi(uu.x); a0[2] = sigm_f(a0[2] * rs) * bflo(uu.y); a0[3] = sigm_f(a0[3] * rs) * bfhi(uu.y);
                        a1[0] = sigm_f(a1[0] * rs) * bflo(uu.z); a1[1] = sigm_f(a1[1] * rs) * bfhi(uu.z); a1[2] = sigm_f(a1[2] * rs) * bflo(uu.w); a1[3] = sigm_f(a1[3] * rs) * bfhi(uu.w);
                    } else { a0 = a0 * scale; a1 = a1 * scale; }
                    const f32x4 v0 = (f32x4){bflo(xq.x), bfhi(xq.x), bflo(xq.y), bfhi(xq.y)} + a0, v1 = (f32x4){bflo(xq.z), bfhi(xq.z), bflo(xq.w), bfhi(xq.w)} + a1;
                    if (yout) { *(GAS f32x4*)(yp + ro + bj * 128) = v0; *(GAS f32x4*)(yp + ro + bj * 128 + 4) = v1; }
                    else {
                        u32x4 w; w.x = pk2(v0[0], v0[1]); w.y = pk2(v0[2], v0[3]); w.z = pk2(v1[0], v1[1]); w.w = pk2(v1[2], v1[3]);
                        *(GAS u32x4*)(xop + ro + bj * 128) = w;
                        ss += (v0[0] * v0[0] + v0[1] * v0[1]) + (v0[2] * v0[2] + v0[3] * v0[3]) + (v1[0] * v1[0] + v1[1] * v1[1]) + (v1[2] * v1[2] + v1[3] * v1[3]);
                    }
                }
                if (!yout) { ss += __shfl_xor(ss, 16); ss += __shfl_xor(ss, 32);
                    if (fq == 0) __hip_atomic_fetch_add(sn + ai * 128 + m * 16, ss, __ATOMIC_RELAXED, __HIP_MEMORY_SCOPE_AGENT); }
            }
        }
    }
};

__device__ __forceinline__ void transpose_item(const float* W, int K, int N, bf16_t* WT, const float* gk, int mode, LAS float* scr_, int item, int lane) {
    LAS unsigned* scr = (LAS unsigned*)scr_;
    const int nblk = N / 64, kb = item / nblk, nb = item % nblk, k0 = 64 * kb, n0 = 64 * nb;
    const int sc = (mode == 1) ? (((n0 >> 7) & 1) * DFF + (n0 >> 8) * 128 + (n0 & 127)) : n0;
    const float* src = W + (size_t)k0 * N + sc + lane;
    float va[32], vb[32];
#pragma unroll
    for (int kp = 0; kp < 32; ++kp) { va[kp] = src[(size_t)(2 * kp) * N]; vb[kp] = src[(size_t)(2 * kp + 1) * N]; }
#pragma unroll
    for (int kp = 0; kp < 32; ++kp) {
        float a = va[kp], b = vb[kp];
        if (gk) { a *= gk[k0 + 2 * kp]; b *= gk[k0 + 2 * kp + 1]; }
        scr[kp * 65 + lane] = pk2(a, b);
    }
    asm volatile("s_waitcnt lgkmcnt(0)" ::: "memory");
    const int c = lane & 7;
#pragma unroll
    for (int j = 0; j < 8; ++j) { const int r = (lane >> 3) + 8 * j; const LAS unsigned* q = scr + (4 * c) * 65 + r;
        u32x4 o; o.x = q[0]; o.y = q[65]; o.z = q[130]; o.w = q[195];
        *(u32x4*)(WT + (size_t)(n0 + r) * K + k0 + 8 * c) = o; }
    asm volatile("s_waitcnt lgkmcnt(0)" ::: "memory");
}
__device__ __forceinline__ float rope_inv(int i) {
    return i == 0 ? 1.0f : i == 1 ? 0.1939227432012558f : i == 2 ? 0.03760603070259094f : i == 3 ? 0.007292664609849453f : i == 4 ? 0.0014142135623842478f : i == 5 ? 0.00027424818836152554f : i == 6 ? 5.3182957344688475e-05f : 1.0313385246263351e-05f;
}
__device__ __forceinline__ void sincos_d(float angf, float& c, float& s) {
    double zd_ = 0.0; asm volatile("" : "+v"(zd_));
#define KD(x) ((x) + zd_)
    const double a = (double)angf; const double n = __builtin_rint(a * KD(0.63661977236758134308));
    const double r = __builtin_fma(-n, KD(1.5707963267948966192), a) - n * KD(6.123233995736766e-17); const double r2 = r * r;
    double sp = -KD(7.6471637318198164759e-13); sp = sp * r2 + KD(1.6059043836821614599e-10); sp = sp * r2 - KD(2.5052108385441718775e-8); sp = sp * r2 + KD(2.7557319223985890653e-6); sp = sp * r2 - KD(1.9841269841269841270e-4); sp = sp * r2 + KD(8.3333333333333333333e-3); sp = sp * r2 - KD(1.6666666666666666667e-1);
    const double sn = r + r * r2 * sp;
    double cp = KD(4.7794773323873852974e-14); cp = cp * r2 - KD(1.1470745597729724714e-11); cp = cp * r2 + KD(2.0876756987868098979e-9); cp = cp * r2 - KD(2.7557319223985890653e-7); cp = cp * r2 + KD(2.4801587301587301587e-5); cp = cp * r2 - KD(1.3888888888888888889e-3); cp = cp * r2 + KD(4.1666666666666666667e-2); cp = cp * r2 - KD(0.5);
    const double cs = KD(1.0) + r2 * cp;
    const int q = ((int)n) & 3;
    const double cc = (q == 0) ? cs : (q == 1) ? -sn : (q == 2) ? -cs : sn;
    const double ss = (q == 0) ? sn : (q == 1) ? cs : (q == 2) ? -sn : -cs;
    c = (float)cc; s = (float)ss;
}
#undef KD
enum { PM_FFA_IN = 1, PM_FFB_IN = 2, PM_FFA_OUT = 4, PM_FFB_OUT = 8, PM_WIN = 16, PM_WOUT = 32, PM_PEG = 64, PM_PEU = 128, PM_POOL = 256, PM_P = 512, PM_ROPE = 1024, PM_X = 2048, PM_ALLW = 1023 };
__device__ __forceinline__ void prep(const Params& p, LAS unsigned char* L, int wv, int vb, int nvb, int l, int mask) {
    int tid_ = tid_of(wv); asm volatile("" : "+v"(tid_));
    const int tid = tid_, lane = tid & 63, wave = __builtin_amdgcn_readfirstlane(tid >> 6);
    const int gw = vb * 8 + wave, NGW = nvb * 8; const int gt = vb * 512 + tid, NGT = nvb * 512;
    LAS float* scr = (LAS float*)(L + wave * 16384);
    unsigned char* ws = PWS; unsigned char* wl = ws + WS_W + (size_t)l * WL_STRIDE;
#define PREP_CONV(bit, SRC, Kd, Nd, DST, GK, MODE) if (mask & (bit)) { for (int it = gw; it < ((Kd) / 64) * ((Nd) / 64); it += NGW) transpose_item((SRC), (Kd), (Nd), (bf16_t*)(wl + (DST)), (GK), (MODE), scr, it, lane); }
    PREP_CONV(PM_FFA_IN, PIN(I_WFFA_IN) + (size_t)l * DM * NFF2, DM, NFF2, WL_FFA_IN, PIN(I_NFFA) + l * DM, 1)
    PREP_CONV(PM_FFA_OUT, PIN(I_WFFA_OUT) + (size_t)l * DFF * DM, DFF, DM, WL_FFA_OUT, nullptr, 0)
    PREP_CONV(PM_WIN, PIN(I_WIN) + (size_t)l * DM * NIN, DM, NIN, WL_IN, PIN(I_NMIX) + l * DM, 0)
    PREP_CONV(PM_WOUT, PIN(I_WOUT) + (size_t)l * DM * DM, DM, DM, WL_OUT, nullptr, 0)
    PREP_CONV(PM_FFB_IN, PIN(I_WFFB_IN) + (size_t)l * DM * NFF2, DM, NFF2, WL_FFB_IN, PIN(I_NFFB) + l * DM, 1)
    PREP_CONV(PM_FFB_OUT, PIN(I_WFFB_OUT) + (size_t)l * DFF * DM, DFF, DM, WL_FFB_OUT, nullptr, 0)
    PREP_CONV(PM_PEG, PIN(I_WPEG) + (size_t)l * DM * DM, DM, DM, WL_PEG, PIN(I_NPE) + l * DM, 0)
    PREP_CONV(PM_PEU, PIN(I_WPEU) + (size_t)l * PED * DM, PED, DM, WL_PEU, nullptr, 0)
#undef PREP_CONV
    if (mask & PM_POOL) {
        for (int t = gt; t < 4 * 128 * 16; t += NGT) {
            const int ko = t & 15, n = (t >> 4) & 127, g = (t >> 11) & 3;
            const float* src = PIN(I_WPOOL) + ((size_t)(l * 4 + g) * 128 + 8 * ko) * 128 + n; const float sc = PIN(I_PSCALE)[l * 512 + g * 128 + n];
            u32x4 o; o.x = pk2(src[0] * sc, src[128] * sc); o.y = pk2(src[256] * sc, src[384] * sc); o.z = pk2(src[512] * sc, src[640] * sc); o.w = pk2(src[768] * sc, src[896] * sc);
            *(u32x4*)((bf16_t*)(wl + WL_POOL) + ((size_t)g * 128 + n) * 128 + 8 * ko) = o;
        }
    }
    if (mask & PM_P) {
        bf16_t* pb = (bf16_t*)(ws + WS_PB) + (size_t)l * MT * PED;
        for (int t0 = gt; t0 < MT * 32; t0 += 4 * NGT) {
            f32x4 a[4], b[4]; size_t dsto[4];
#pragma unroll
            for (int u = 0; u < 4; ++u) {
                const int t = min(t0 + u * NGT, MT * 32 - 1);
                const int o8 = t & 31, m = t >> 5;
                const float* src = ((m < MP) ? PIN(I_PP) + ((size_t)l * MP + m) * PED : PIN(I_PS) + ((size_t)l * MS + (m - MP)) * PED) + 8 * o8;
                a[u] = *(const f32x4*)src; b[u] = *(const f32x4*)(src + 4); dsto[u] = (size_t)m * PED + 8 * o8;
            }
#pragma unroll
            for (int u = 0; u < 4; ++u) { u32x4 o; o.x = pk2(a[u][0], a[u][1]); o.y = pk2(a[u][2], a[u][3]); o.z = pk2(b[u][0], b[u][1]); o.w = pk2(b[u][2], b[u][3]); *(u32x4*)(pb + dsto[u]) = o; }
        }
    }
    if (mask & PM_ROPE) {
        float* rope = (float*)(ws + WS_ROPE);
        for (int t = gt; t < 2112 * 8; t += NGT) {
            const int i = t & 7, idx = t >> 3, pos = idx < 2048 ? idx : 4096 + idx - 2048;
            const float ang = (float)pos * rope_inv(i); float c, s; sincos_d(ang, c, s);
            rope[idx * 16 + i] = c; rope[idx * 16 + 8 + i] = s;
        }
    }
    if (mask & PM_X) {
        bf16_t* xb = (bf16_t*)(ws + WS_XB); float* ssq = (float*)(ws + WS_SSQ);
        for (int m0 = 4 * gw; m0 < MT; m0 += 4 * NGW) {
            const float* xr = (m0 < MP) ? PIN(I_XP) + (size_t)m0 * DM : PIN(I_XS) + (size_t)(m0 - MP) * DM;
            f32x4 v[4][4];
#pragma unroll
            for (int r = 0; r < 4; ++r)
#pragma unroll
                for (int j = 0; j < 4; ++j) v[r][j] = *((const f32x4*)(xr + (size_t)r * DM) + lane + 64 * j);
#pragma unroll
            for (int r = 0; r < 4; ++r) {
                float sq = 0.f;
#pragma unroll
                for (int j = 0; j < 4; ++j) sq += (v[r][j][0] * v[r][j][0] + v[r][j][1] * v[r][j][1]) + (v[r][j][2] * v[r][j][2] + v[r][j][3] * v[r][j][3]);
                sq = wave_sum(sq);
#pragma unroll
                for (int j = 0; j < 4; ++j) { u32x2 o; o.x = pk2(v[r][j][0], v[r][j][1]); o.y = pk2(v[r][j][2], v[r][j][3]); *((u32x2*)(xb + (size_t)(m0 + r) * DM) + lane + 64 * j) = o; }
                if (lane == 0) ssq[m0 + r] = sq;
            }
        }
        for (int t = gt; t < 8 * MT / 4; t += NGT) *((f32x4*)(ssq + MT) + t) = (f32x4){0.f, 0.f, 0.f, 0.f};
    }
}

constexpr int KROW = 72, DROW = 520;
constexpr int LK_OFF = 0, LV_OFF = 2 * 192 * KROW * 2, LMIX_END = 2 * LV_OFF;
static_assert(LMIX_END <= 131072 && 64 * DROW * 2 <= 131072, "mixer LDS");
typedef short v4i16_t __attribute__((ext_vector_type(4)));
__device__ __forceinline__ u32x2 tr_read(const LAS unsigned char* q) { const v4i16_t r = __builtin_amdgcn_ds_read_tr16_b64_v4i16((LAS v4i16_t*)q); return __builtin_bit_cast(u32x2, r); }
__device__ __forceinline__ bf16x8 pack8(const float* v) { u32x4 w; w.x = pk2(v[0], v[1]); w.y = pk2(v[2], v[3]); w.z = pk2(v[4], v[5]); w.w = pk2(v[6], v[7]); return __builtin_bit_cast(bf16x8, w); }
__device__ __forceinline__ void unpack8(u32x4 w, float* v) { v[0] = bflo(w.x); v[1] = bfhi(w.x); v[2] = bflo(w.y); v[3] = bfhi(w.y); v[4] = bflo(w.z); v[5] = bfhi(w.z); v[6] = bflo(w.w); v[7] = bfhi(w.w); }

template <int W> __device__ __forceinline__ void pool_stage(const Params& p, const bf16_t* z, int layer, bool is_s, int b, int c, int tok0, int g, int half, int lane, LAS unsigned char* L) {
    const int oct = lane & 15, tq = lane >> 4, c0 = 128 * g + 8 * oct, t0 = 32 * half + 8 * tq;
    const float* sp = PIN(I_SP) + ((size_t)layer * NB + b) * 15 * 512 + c0;
    u32x4 raw[W + 7];
#pragma unroll
    for (int j = 0; j < W + 7; ++j) {
        const int t = t0 - (W - 1) + j;
        u32x4 r = {0u, 0u, 0u, 0u};
        if (t >= 0 || (!is_s && c * 64 + t >= 0)) r = *(const u32x4*)(z + (size_t)(tok0 + t) * NIN + 768 + c0);
        else if (is_s) { const f32x4 a = *(const f32x4*)(sp + (15 + t) * 512), bb = *(const f32x4*)(sp + (15 + t) * 512 + 4); r.x = pk2(a[0], a[1]); r.y = pk2(a[2], a[3]); r.z = pk2(bb[0], bb[1]); r.w = pk2(bb[2], bb[3]); }
        raw[j] = r;
    }
    float sum[8];
#pragma unroll
    for (int i = 0; i < 8; ++i) sum[i] = 0.f;
#pragma unroll
    for (int j = 0; j < W - 1; ++j) { float u[8]; unpack8(raw[j], u);
#pragma unroll
        for (int i = 0; i < 8; ++i) sum[i] += u[i]; }
#pragma unroll
    for (int ti = 0; ti < 8; ++ti) {
        const int t = t0 + ti; float u[8], ul[8], d[8]; unpack8(raw[W - 1 + ti], u); unpack8(raw[ti], ul);
        const int cnt = is_s ? W : min(c * 64 + t + 1, W); const float rc = 1.0f / (float)cnt;
#pragma unroll
        for (int i = 0; i < 8; ++i) { sum[i] += u[i]; d[i] = sum[i] * rc - u[i]; sum[i] -= ul[i]; }
        *(LAS bf16x8*)(L + (t * DROW + c0) * 2) = pack8(d);
        if (t >= 49 && (is_s || c == 31)) { float* o = POUT + (is_s ? O_US : O_UP) + (((size_t)layer * NB + b) * 15 + (t - 49)) * 512 + c0;
            *(f32x4*)o = (f32x4){u[0], u[1], u[2], u[3]}; *(f32x4*)(o + 4) = (f32x4){u[4], u[5], u[6], u[7]}; }
    }
}

__device__ __forceinline__ void mixer_unit(const Params& p, int layer, int cu, LAS unsigned char* L, int wv) {
    int tid_ = tid_of(wv); asm volatile("" : "+v"(tid_));
    const int tid = tid_, lane = tid & 63, wave = __builtin_amdgcn_readfirstlane(tid >> 6);
    const bool is_s = cu >= 1024;
    const int b = is_s ? cu - 1024 : (cu >> 5), c = is_s ? 0 : (cu & 31);
    const int tok0 = is_s ? MP + b * 64 : b * SEQ + c * 64;
    const int kstart = is_s ? 0 : (c >= 2 ? 0 : (2 - c) * 64);
    const int pidx0 = is_s ? 2048 : c * 64;
    const bf16_t* z = (const bf16_t*)(PWS + WS_Z); bf16_t* mix = (bf16_t*)(PWS + WS_MIX);
    const float* rope = (const float*)(PWS + WS_ROPE);
    const int q16 = lane & 15, quad = lane >> 4, h = wave, kvhq = h >> 2;
    const int piece = tid & 31, rsub = tid >> 5, sub = piece & 7, kvh = (piece >> 3) & 1; const bool isK = piece < 16;
    const int klo = is_s ? 128 : kstart, npass = (192 - klo) >> 4;
    u32x4 raw[12], qraw[4][2];
#pragma unroll
    for (int ps = 0; ps < 12; ++ps) if (ps < npass) raw[ps] = *(const u32x4*)(z + (size_t)(tok0 + klo + 16 * ps + rsub - 128) * NIN + 512 + piece * 8);
    if (is_s) {
#pragma unroll 1
        for (int ps = 0; ps < 8; ++ps) {
            const int kk = 16 * ps + rsub; const size_t o = ((((size_t)layer * NB + b) * 128 + kk) * 2 + kvh) * 64 + sub * 8;
            const float* src = (isK ? PIN(I_CK) : PIN(I_CV)) + o;
            const f32x4 a0 = *(const f32x4*)src, a1 = *(const f32x4*)(src + 4);
            float v[8] = {a0[0], a0[1], a0[2], a0[3], a1[0], a1[1], a1[2], a1[3]};
            *(LAS bf16x8*)(L + (isK ? LK_OFF : LV_OFF) + ((kvh * 192 + kk) * KROW + sub * 8) * 2) = pack8(v);
            if (kk >= 64) { float* dst = POUT + (isK ? O_KS : O_VS) + ((((size_t)layer * NB + b) * 128 + (kk - 64)) * 2 + kvh) * 64 + sub * 8; *(f32x4*)dst = a0; *(f32x4*)(dst + 4) = a1; }
        }
    }
    {
        float kn[8];
#pragma unroll
        for (int i = 0; i < 8; ++i) kn[i] = PIN(I_KN)[layer * 64 + sub * 8 + i];
#pragma unroll
        for (int ps = 0; ps < 12; ++ps) if (ps < npass) {
            const int kk = klo + 16 * ps + rsub;
            float v[8]; unpack8(raw[ps], v);
            float ss = 0.f;
#pragma unroll
            for (int i = 0; i < 8; ++i) ss += v[i] * v[i];
            ss += __shfl_xor(ss, 1); ss += __shfl_xor(ss, 2); ss += __shfl_xor(ss, 4);
            const float rs = __builtin_amdgcn_rsqf(ss * (1.0f / 64.0f) + EPS);
            float pv[8];
#pragma unroll
            for (int i = 0; i < 8; ++i) { if (isK) v[i] = v[i] * rs * kn[i]; pv[i] = __shfl_xor(v[i], 1); }
            if (isK && sub < 2) {
                const float* rt = rope + (size_t)(pidx0 + kk - 128) * 16;
                const f32x4 c0 = *(const f32x4*)rt, c1 = *(const f32x4*)(rt + 4), s0 = *(const f32x4*)(rt + 8), s1 = *(const f32x4*)(rt + 12);
#pragma unroll
                for (int i = 0; i < 8; ++i) { const float cs = i < 4 ? c0[i & 3] : c1[i & 3], sn = i < 4 ? s0[i & 3] : s1[i & 3]; v[i] = (sub == 0) ? v[i] * cs - pv[i] * sn : v[i] * cs + pv[i] * sn; }
            }
            *(LAS bf16x8*)(L + (isK ? LK_OFF : LV_OFF) + ((kvh * 192 + kk) * KROW + sub * 8) * 2) = pack8(v);
            int orow = -1;
            if (is_s) orow = kk - 64; else if (c >= 30 && kk >= 128) orow = (c - 30) * 64 + (kk - 128);
            if (orow >= 0) {
                float* dst = POUT + (isK ? (is_s ? O_KS : O_KP) : (is_s ? O_VS : O_VP)) + ((((size_t)layer * NB + b) * 128 + orow) * 2 + kvh) * 64 + sub * 8;
                *(f32x4*)dst = (f32x4){v[0], v[1], v[2], v[3]}; *(f32x4*)(dst + 4) = (f32x4){v[4], v[5], v[6], v[7]};
            }
        }
    }
#pragma unroll
    for (int qb = 0; qb < 4; ++qb) { const bf16_t* qp = z + (size_t)(tok0 + 16 * qb + q16) * NIN + h * 64 + 8 * quad; qraw[qb][0] = *(const u32x4*)qp; qraw[qb][1] = *(const u32x4*)(qp + 32); }
    bf16x8 qf[4][2];
    {
        float gq0[8], gq1[8];
#pragma unroll
        for (int i = 0; i < 8; ++i) { gq0[i] = PIN(I_QN)[layer * 64 + 8 * quad + i]; gq1[i] = PIN(I_QN)[layer * 64 + 32 + 8 * quad + i]; }
        constexpr float QS = 0.125f * LOG2E;
#pragma unroll
        for (int qb = 0; qb < 4; ++qb) {
            float v0[8], v1[8]; unpack8(qraw[qb][0], v0); unpack8(qraw[qb][1], v1);
            float ss = 0.f;
#pragma unroll
            for (int i = 0; i < 8; ++i) ss += v0[i] * v0[i] + v1[i] * v1[i];
            ss += __shfl_xor(ss, 16); ss += __shfl_xor(ss, 32);
            const float rs = __builtin_amdgcn_rsqf(ss * (1.0f / 64.0f) + EPS);
            float pv[8];
#pragma unroll
            for (int i = 0; i < 8; ++i) { v0[i] = v0[i] * rs * gq0[i]; v1[i] = v1[i] * rs * gq1[i] * QS; pv[i] = __shfl_xor(v0[i], 16); }
            if (quad < 2) {
                const float* rt = rope + (size_t)(pidx0 + 16 * qb + q16) * 16;
                const f32x4 c0 = *(const f32x4*)rt, c1 = *(const f32x4*)(rt + 4), s0 = *(const f32x4*)(rt + 8), s1 = *(const f32x4*)(rt + 12);
#pragma unroll
                for (int i = 0; i < 8; ++i) { const float cs = i < 4 ? c0[i & 3] : c1[i & 3], sn = i < 4 ? s0[i & 3] : s1[i & 3]; v0[i] = (quad == 0) ? v0[i] * cs - pv[i] * sn : v0[i] * cs + pv[i] * sn; }
            }
#pragma unroll
            for (int i = 0; i < 8; ++i) v0[i] *= QS;
            qf[qb][0] = pack8(v0); qf[qb][1] = pack8(v1);
        }
    }
    __syncthreads();
    {
        const float sinkv = PIN(I_SINK)[layer * 8 + h] * LOG2E;
        const LAS unsigned char* Kb = L + LK_OFF + ((kvhq * 192 + q16) * KROW + 8 * quad) * 2;
        const LAS unsigned char* Vb = L + LV_OFF + ((kvhq * 192 + 4 * quad + (q16 >> 2)) * KROW + 4 * (q16 & 3)) * 2;
#pragma unroll
        for (int pr = 0; pr < 2; ++pr) {
            f32x4 s[2][12];
#pragma unroll
            for (int kt = 0; kt < 12; ++kt) {
                if (16 * kt >= kstart) {
                    const bf16x8 k0 = *(const LAS bf16x8*)(Kb + kt * 16 * KROW * 2), k1 = *(const LAS bf16x8*)(Kb + kt * 16 * KROW * 2 + 64);
#pragma unroll
                    for (int e = 0; e < 2; ++e) { s[e][kt] = __builtin_amdgcn_mfma_f32_16x16x32_bf16(k0, qf[2 * pr + e][0], (f32x4){0.f, 0.f, 0.f, 0.f}, 0, 0, 0);
                        s[e][kt] = __builtin_amdgcn_mfma_f32_16x16x32_bf16(k1, qf[2 * pr + e][1], s[e][kt], 0, 0, 0); }
                } else { s[0][kt] = (f32x4){-1e30f, -1e30f, -1e30f, -1e30f}; s[1][kt] = s[0][kt]; }
            }
            float inv[2];
#pragma unroll
            for (int e = 0; e < 2; ++e) {
                float mx = sinkv;
#pragma unroll
                for (int kt = 0; kt < 12; ++kt) mx = fmaxf(fmaxf(mx, fmaxf(s[e][kt][0], s[e][kt][1])), fmaxf(s[e][kt][2], s[e][kt][3]));
                mx = fmaxf(mx, __shfl_xor(mx, 16)); mx = fmaxf(mx, __shfl_xor(mx, 32));
                float l = 0.f;
#pragma unroll
                for (int kt = 0; kt < 12; ++kt)
#pragma unroll
                    for (int j = 0; j < 4; ++j) { s[e][kt][j] = __builtin_amdgcn_exp2f(s[e][kt][j] - mx); l += s[e][kt][j]; }
                l += __shfl_xor(l, 16); l += __shfl_xor(l, 32);
                l += __builtin_amdgcn_exp2f(sinkv - mx);
                inv[e] = 1.0f / l;
            }
            f32x4 o[2][4];
#pragma unroll
            for (int e = 0; e < 2; ++e)
#pragma unroll
                for (int dt = 0; dt < 4; ++dt) o[e][dt] = (f32x4){0.f, 0.f, 0.f, 0.f};
#pragma unroll
            for (int si = 0; si < 6; ++si) {
                if (32 * si >= kstart) {
                    bf16x8 pf[2];
#pragma unroll
                    for (int e = 0; e < 2; ++e) { u32x4 pw; pw.x = pk2(s[e][2 * si][0], s[e][2 * si][1]); pw.y = pk2(s[e][2 * si][2], s[e][2 * si][3]); pw.z = pk2(s[e][2 * si + 1][0], s[e][2 * si + 1][1]); pw.w = pk2(s[e][2 * si + 1][2], s[e][2 * si + 1][3]); pf[e] = __builtin_bit_cast(bf16x8, pw); }
#pragma unroll
                    for (int dt = 0; dt < 4; ++dt) {
                        const u32x2 a = tr_read(Vb + ((32 * si) * KROW + 16 * dt) * 2), bq = tr_read(Vb + ((32 * si + 16) * KROW + 16 * dt) * 2);
                        const u32x4 vw = {a.x, a.y, bq.x, bq.y}; const bf16x8 vf = __builtin_bit_cast(bf16x8, vw);
#pragma unroll
                        for (int e = 0; e < 2; ++e) o[e][dt] = __builtin_amdgcn_mfma_f32_16x16x32_bf16(vf, pf[e], o[e][dt], 0, 0, 0);
                    }
                }
            }
#pragma unroll
            for (int e = 0; e < 2; ++e) { const int row = tok0 + 16 * (2 * pr + e) + q16;
#pragma unroll
                for (int dt = 0; dt < 4; ++dt) { u32x2 w; w.x = pk2(o[e][dt][0] * inv[e], o[e][dt][1] * inv[e]); w.y = pk2(o[e][dt][2] * inv[e], o[e][dt][3] * inv[e]);
                    *(u32x2*)(mix + (size_t)row * DM + h * 64 + 16 * dt + 4 * quad) = w; } }
        }
    }
    __syncthreads();
    {
        const int g = wave >> 1, half = wave & 1;
        if (g == 0) pool_stage<2>(p, z, layer, is_s, b, c, tok0, g, half, lane, L);
        else if (g == 1) pool_stage<4>(p, z, layer, is_s, b, c, tok0, g, half, lane, L);
        else if (g == 2) pool_stage<8>(p, z, layer, is_s, b, c, tok0, g, half, lane, L);
        else pool_stage<16>(p, z, layer, is_s, b, c, tok0, g, half, lane, L);
    }
    __syncthreads();
    {
        const int g = wave >> 1, th = wave & 1;
        bf16x8 dfr[2][4];
#pragma unroll
        for (int tb = 0; tb < 2; ++tb)
#pragma unroll
            for (int ks = 0; ks < 4; ++ks) dfr[tb][ks] = *(const LAS bf16x8*)(L + ((32 * th + 16 * tb + q16) * DROW + 128 * g + 32 * ks + 8 * quad) * 2);
        const bf16_t* wp = (const bf16_t*)(PWS + WS_W + (size_t)layer * WL_STRIDE + WL_POOL) + (size_t)g * 128 * 128;
#pragma unroll 2
        for (int nt = 0; nt < 8; ++nt) {
            bf16x8 wf[4];
#pragma unroll
            for (int ks = 0; ks < 4; ++ks) wf[ks] = *(const bf16x8*)(wp + (16 * nt + q16) * 128 + 32 * ks + 8 * quad);
#pragma unroll
            for (int tb = 0; tb < 2; ++tb) {
                f32x4 o = (f32x4){0.f, 0.f, 0.f, 0.f};
#pragma unroll
                for (int ks = 0; ks < 4; ++ks) o = __builtin_amdgcn_mfma_f32_16x16x32_bf16(wf[ks], dfr[tb][ks], o, 0, 0, 0);
                u32x2 ww; ww.x = pk2(o[0], o[1]); ww.y = pk2(o[2], o[3]);
                *(u32x2*)(mix + (size_t)(tok0 + 32 * th + 16 * tb + q16) * DM + 512 + 128 * g + 16 * nt + 4 * quad) = ww;
            }
        }
    }
    __syncthreads();
}

#define XB_TMO      128
#define XB_XCNT(j)  (256  + 64 * (j))
#define XB_XSUB(j)  (1280 + 64 * (j))
#define XB_XGEN(j)  (2304 + 64 * (j))
#define XB_TOP      3328
#define XB_TOPGEN   3392
#define XCD_BAR_WORDS 3456
#define XB_SPIN_CAP (1u << 18)

__device__ __forceinline__ unsigned xb_ld(unsigned* p)              { return __hip_atomic_load(p, __ATOMIC_RELAXED, __HIP_MEMORY_SCOPE_AGENT); }
__device__ __forceinline__ unsigned xb_add(unsigned* p, unsigned v) { return __hip_atomic_fetch_add(p, v, __ATOMIC_RELAXED, __HIP_MEMORY_SCOPE_AGENT); }
__device__ __forceinline__ unsigned xb_xcc_id() { return (unsigned)__builtin_amdgcn_s_getreg((3 << 11) | 20) & 0xFu; }
#define XB_SPIN(cond, bar) do { unsigned _sp = 0; while (cond) { __builtin_amdgcn_s_sleep(1); \
    if ((++_sp & 255u) == 0u) { if (xb_ld(&(bar)[XB_TMO])) break; if (_sp > XB_SPIN_CAP) { atomicAdd(&(bar)[XB_TMO], 1u); break; } } } } while (0)

struct XcdBarrier {
    unsigned* bar; unsigned x;
    volatile LAS unsigned* st;
};

__device__ __forceinline__ XcdBarrier xcd_barrier_post(unsigned* bar, volatile LAS unsigned* st) {
    XcdBarrier b; b.bar = bar; b.x = xb_xcc_id(); b.st = st;
    if (threadIdx.x == 0) (void)xb_add(&bar[XB_XCNT(b.x)], 1u);
    return b;
}
__device__ __forceinline__ void xcd_barrier_complete(unsigned* bar, unsigned x, unsigned& nloc, unsigned& nx) {
    const unsigned G = gridDim.x * gridDim.y * gridDim.z;
    unsigned sum, cnt, mine, sp = 0u;
    for (;;) {
        sum = 0u; cnt = 0u; mine = 0u;
#pragma unroll
        for (unsigned j = 0; j < 16; ++j) { const unsigned c = xb_ld(&bar[XB_XCNT(j)]); sum += c; cnt += (c > 0u) ? 1u : 0u; mine = (j == x) ? c : mine; }
        if (sum == G) break;
        __builtin_amdgcn_s_sleep(1);
        if ((++sp & 255u) == 0u) { if (xb_ld(&bar[XB_TMO])) break; if (sp > XB_SPIN_CAP) { atomicAdd(&bar[XB_TMO], 1u); break; } }
    }
    nloc = mine > 0u ? mine : 1u; nx = cnt > 0u ? cnt : 1u;
}

__device__ __forceinline__ void xcd_barrier(const XcdBarrier& b, bool t0) {
    asm volatile("s_waitcnt vmcnt(0)" ::: "memory");
    __syncthreads();
    if (t0) {
        unsigned* bar = b.bar;
        __builtin_amdgcn_s_waitcnt(0);
        unsigned nloc = b.st[0], nx = b.st[1];
        if (nloc == 0u) { xcd_barrier_complete(bar, b.x, nloc, nx); b.st[0] = nloc; b.st[1] = nx; }
        const unsigned old = xb_add(&bar[XB_XSUB(b.x)], 1u);
        const unsigned gen = old / nloc;
        if (old + 1u == (gen + 1u) * nloc) {
            __builtin_amdgcn_fence(__ATOMIC_RELEASE, "agent");
            asm volatile("s_waitcnt vmcnt(0)" ::: "memory");
            const unsigned og = xb_add(&bar[XB_TOP], 1u);
            const unsigned tg = og / nx;
            if (og + 1u == (tg + 1u) * nx) xb_add(&bar[XB_TOPGEN], 1u);
            else XB_SPIN(xb_ld(&bar[XB_TOPGEN]) == tg, bar);
            __builtin_amdgcn_fence(__ATOMIC_ACQUIRE, "agent");
            xb_add(&bar[XB_XGEN(b.x)], 1u);
            asm volatile("s_waitcnt vmcnt(0)" ::: "memory");
        } else {
            XB_SPIN(xb_ld(&bar[XB_XGEN(b.x)]) == gen, bar);
            __builtin_amdgcn_fence(__ATOMIC_ACQUIRE, "agent");
            asm volatile("s_waitcnt vmcnt(0)" ::: "memory");
        }
    }
    __syncthreads();
}

constexpr int LDS_BYTES = 131072 + 4096;
__global__ void __launch_bounds__(512, 2) hymba_fwd(Params p) {
    extern __shared__ __attribute__((aligned(16))) unsigned char lds_raw[];
    LAS unsigned char* L = (LAS unsigned char*)lds_raw;
    cg::grid_group grid = cg::this_grid();
    const int wv = __builtin_amdgcn_readfirstlane((int)threadIdx.x >> 6);
    if (threadIdx.x < 26) *(LAS unsigned long long*)(L + 131072 + 256 + 8 * threadIdx.x) = threadIdx.x < 24 ? (unsigned long long)p.in[threadIdx.x] : threadIdx.x == 24 ? (unsigned long long)p.ws : (unsigned long long)p.out;
#define PHASE_VARS size_t oz_ = 0; int ly = layer; asm volatile("" : "+s"(oz_), "+s"(ly)); unsigned char* ws = PWS + oz_; bf16_t* xb = (bf16_t*)(ws + WS_XB); bf16_t* act = (bf16_t*)(ws + WS_ACT); bf16_t* zb = (bf16_t*)(ws + WS_Z); bf16_t* mixb = (bf16_t*)(ws + WS_MIX); bf16_t* ub = (bf16_t*)(ws + WS_U); \
        float* xres = POUT + O_Y; unsigned char* wl = ws + WS_W + (size_t)ly * WL_STRIDE; float* sq = (float*)(ws + WS_SSQ) + (size_t)ly * 4 * MT; (void)xb; (void)act; (void)zb; (void)mixb; (void)ub; (void)xres; (void)wl; (void)sq;
    const int G = gridDim.x, c = blockIdx.x;
#define TAIL_PREP(first_idle, lyr, msk) do { int Gt_ = G, ct_ = c, lt_ = (lyr); asm volatile("" : "+s"(Gt_), "+s"(ct_), "+s"(lt_)); if (Gt_ == 256 && ct_ >= (first_idle) && lt_ < NLAYER) prep(p, L, wv, ct_ - (first_idle), 256 - (first_idle), lt_, (msk)); } while (0)
#define XBAR() do { XcdBarrier bar_; bar_.bar = (unsigned*)(PWS + WS_BAR); bar_.x = xb_xcc_id(); bar_.st = (volatile LAS unsigned*)(L + 131072 + 64); int t_ = tid_of(wv); asm volatile("" : "+v"(t_)); xcd_barrier(bar_, t_ == 0); } while (0)
    volatile LAS unsigned* bst = (volatile LAS unsigned*)(L + 131072 + 64);
    if (threadIdx.x == 0) { bst[0] = 0u; bst[1] = 0u; }
    __syncthreads();
    (void)xcd_barrier_post((unsigned*)(PWS + WS_BAR), bst);
    if (G == 256) prep(p, L, wv, c, G, 0, PM_X | PM_FFA_IN | PM_FFA_OUT);
    else { prep(p, L, wv, c, G, 0, PM_X | PM_ROPE | PM_ALLW); prep(p, L, wv, c, G, 1, PM_ALLW); }
    grid.sync();
#pragma unroll 1
    for (int layer = 0; layer < NLAYER; ++layer) {
        { PHASE_VARS pg8::Gemm g{ly == 0 ? xb : (const bf16_t*)(ws + WS_XB2), (const bf16_t*)(wl + WL_FFA_IN), MT, NFF2, DM}; pg8::StaticOrder S; S.init(MT, NFF2, G, c); EpiSwiglu E{act, sq};
          pg8::gemm_phase<EpiSwiglu, pg8::StaticOrder, true, true>(L, g, S, E, wv); }
        XBAR();
        { PHASE_VARS pg8::Gemm g{act, (const bf16_t*)(wl + WL_FFA_OUT), MT, DM, DFF}; pg8::StaticOrder S; S.init(MT, DM, G, c);
          EpiResid<0> E{ly == 0 ? xb : (const bf16_t*)(ws + WS_XB2), xb, nullptr, sq + MT, 0.5f, nullptr, nullptr};
          pg8::gemm_phase<EpiResid<0>, pg8::StaticOrder, true, true>(L, g, S, E, wv); }
        TAIL_PREP(32, layer == 0 ? 0 : NLAYER, PM_WIN | PM_POOL | PM_ROPE | PM_WOUT | PM_FFB_IN | PM_FFB_OUT | PM_PEG | PM_PEU | PM_P);
        XBAR();
        { PHASE_VARS pg8::Gemm g{xb, (const bf16_t*)(wl + WL_IN), MT, NIN, DM}; pg8::StaticOrder S; S.init(MT, NIN, G, c); EpiStore E{zb, NIN, sq + MT};
          pg8::gemm_phase<EpiStore, pg8::StaticOrder, true, true>(L, g, S, E, wv); }
        TAIL_PREP(40, layer + 1, PM_FFA_IN);
        XBAR();
#pragma unroll 1
        for (int cu = c; cu < 1056; cu += G) { int Gl = G; asm volatile("" : "+s"(Gl)); const int un = (Gl == 256 && cu < 1024) ? ((cu & 255) << 2) + (cu >> 8) : cu; mixer_unit(p, layer, un, L, wv); }
        TAIL_PREP(32, layer + 1, PM_FFA_OUT | PM_WIN | PM_POOL | PM_P);
        XBAR();
        { PHASE_VARS pg8::Gemm g{mixb, (const bf16_t*)(wl + WL_OUT), MT, DM, DM}; pg8::StaticOrder S; S.init(MT, DM, G, c);
          EpiResid<0> E{xb, xb, nullptr, sq + 2 * MT, 1.0f, nullptr, nullptr};
          pg8::gemm_phase<EpiResid<0>, pg8::StaticOrder, true, true>(L, g, S, E, wv); }
        TAIL_PREP(32, layer + 1, PM_FFB_IN);
        XBAR();
        { PHASE_VARS pg8::Gemm g{xb, (const bf16_t*)(wl + WL_FFB_IN), MT, NFF2, DM}; pg8::StaticOrder S; S.init(MT, NFF2, G, c); EpiSwiglu E{act, sq + 2 * MT};
          pg8::gemm_phase<EpiSwiglu, pg8::StaticOrder, true, true>(L, g, S, E, wv); }
        XBAR();
        { PHASE_VARS pg8::Gemm g{act, (const bf16_t*)(wl + WL_FFB_OUT), MT, DM, DFF}; pg8::StaticOrder S; S.init(MT, DM, G, c);
          EpiResid<0> E{xb, xb, nullptr, sq + 3 * MT, 0.5f, nullptr, nullptr};
          pg8::gemm_phase<EpiResid<0>, pg8::StaticOrder, true, true>(L, g, S, E, wv); }
        int Gf = G, cf = c; asm volatile("" : "+s"(Gf), "+s"(cf));
        if (Gf == 256 ? cf >= 32 : true) { PHASE_VARS pg8::Gemm g{(const bf16_t*)(ws + WS_PB) + (size_t)ly * MT * PED, (const bf16_t*)(wl + WL_PEU), MT, DM, PED}; pg8::StaticOrder S;
          if (Gf == 256) S.init(MT, DM, 224, cf - 32); else S.init(MT, DM, Gf, cf);
          EpiStore E{(bf16_t*)(ws + WS_U2), DM, nullptr};
          pg8::gemm_phase<EpiStore, pg8::StaticOrder, true, true>(L, g, S, E, wv); }
        XBAR();
        { PHASE_VARS pg8::Gemm g{xb, (const bf16_t*)(wl + WL_PEG), MT, DM, DM}; pg8::StaticOrder S; S.init(MT, DM, G, c);
          EpiResid<1> E{xb, (bf16_t*)(ws + WS_XB2), ly + 1 < NLAYER ? nullptr : xres, sq + 4 * MT, 1.0f, (const bf16_t*)(ws + WS_U2), sq + 3 * MT};
          pg8::gemm_phase<EpiResid<1>, pg8::StaticOrder, true, true>(L, g, S, E, wv); }
        TAIL_PREP(32, layer + 1, PM_FFB_OUT | PM_WOUT | PM_PEG | PM_PEU);
        if (layer + 1 < NLAYER) XBAR();
    }
}

extern "C" void kernel_launch(void* const* d_in, const int* in_sizes, int n_in, void* d_out, int out_size, void* d_ws, size_t ws_size, hipStream_t stream) {
    static int grid = 0;
    if (grid == 0) {
        if (n_in != 24 || in_sizes[0] != MP * DM || (size_t)out_size != O_END || ws_size < WS_END) { fprintf(stderr, "kernel_launch: unexpected shapes (n_in %d, in0 %d, out %d, ws %zu)\n", n_in, n_in > 0 ? in_sizes[0] : -1, out_size, ws_size); grid = -1; return; }
        int dev = 0, cus = 0, per_cu = 0;
        if (hipGetDevice(&dev) != hipSuccess || hipDeviceGetAttribute(&cus, hipDeviceAttributeMultiprocessorCount, dev) != hipSuccess) { grid = -1; return; }
        if (hipFuncSetAttribute((const void*)hymba_fwd, hipFuncAttributeMaxDynamicSharedMemorySize, LDS_BYTES) != hipSuccess) { fprintf(stderr, "kernel_launch: hipFuncSetAttribute failed\n"); grid = -1; return; }
        if (hipOccupancyMaxActiveBlocksPerMultiprocessor(&per_cu, (const void*)hymba_fwd, 512, LDS_BYTES) != hipSuccess || per_cu < 1) { fprintf(stderr, "kernel_launch: occupancy query says %d\n", per_cu); per_cu = 1; }
        (void)hipGetLastError();
        grid = cus * 1;
    }
    if (grid < 0) return;
    if (hipMemsetAsync((char*)d_ws + WS_BAR, 0, 16384, stream) != hipSuccess) { fprintf(stderr, "kernel_launch: memset of the barrier words failed\n"); return; }
    Params p{};
    for (int i = 0; i < 24; ++i) p.in[i] = (const float*)d_in[i];
    p.out = (float*)d_out; p.ws = (unsigned char*)d_ws;
    void* args[] = {&p};
    hipError_t e = hipLaunchCooperativeKernel((const void*)hymba_fwd, dim3(grid), dim3(512), args, LDS_BYTES, stream);
    if (e != hipSuccess) fprintf(stderr, "kernel_launch: cooperative launch failed: %s (grid %d)\n", hipGetErrorString(e), grid);
}
```
